# Optimizing an MI355X kernel written in HIP

```python
import jax
import jax.numpy as jnp
from jax import lax
import numpy as np

D_MODEL = 1024
BATCH = 8
SEQ = 4096
DEPTH = 1

HEAD_DIM = 64
N_SB_HEADS = 8
N_FOX_HEADS = 8
SB_WIDTH = N_SB_HEADS * HEAD_DIM
FOX_WIDTH = N_FOX_HEADS * HEAD_DIM
MIX_WIDTH = SB_WIDTH + FOX_WIDTH
IN_WIDTH = 3 * SB_WIDTH + 3 * FOX_WIDTH + N_FOX_HEADS
D_FF = 2816
BLOCK_Q = 128
N_MOD = 9
EPS = 1e-6

kernel_name = 'hymba_stickbreak_fox_macaron_adaln'


def rms_norm(x, gain):
    xf = x.astype(jnp.float32)
    y = xf * lax.rsqrt(jnp.mean(xf * xf, axis=-1, keepdims=True) + EPS)
    return (y * gain.astype(jnp.float32)).astype(x.dtype)


def modulate(h, shift, scale):
    return h * (1 + scale[:, None, :]) + shift[:, None, :]


def swiglu(h, w_gate, w_up, w_down):
    return (jax.nn.silu(h @ w_gate) * (h @ w_up)) @ w_down


def split_heads(t, n_heads):
    b, s, _ = t.shape
    return t.reshape(b, s, n_heads, HEAD_DIM).transpose(0, 2, 1, 3)


def stick_breaking_attention(q, k, v):
    seq = q.shape[2]
    scale = HEAD_DIM ** -0.5
    outs = []
    for start in range(0, seq, BLOCK_Q):
        end = start + BLOCK_Q
        z = jnp.einsum('bhqd,bhkd->bhqk', q[:, :, start:end], k[:, :, :end]).astype(jnp.float32) * scale
        mask = jnp.arange(end)[None, :] < jnp.arange(start, end)[:, None]
        log_beta = jax.nn.log_sigmoid(z)
        log_keep = jnp.where(mask, jax.nn.log_sigmoid(-z), 0.0)
        later = lax.cumsum(log_keep, axis=3, reverse=True) - log_keep
        w = jnp.where(mask, jnp.exp(log_beta + later), 0.0)
        outs.append(jnp.einsum('bhqk,bhkd->bhqd', w.astype(v.dtype), v[:, :, :end]))
    return jnp.concatenate(outs, axis=2)


def forgetting_attention(q, k, v, log_f_cum):
    seq = q.shape[2]
    scale = HEAD_DIM ** -0.5
    outs = []
    for start in range(0, seq, BLOCK_Q):
        end = start + BLOCK_Q
        z = jnp.einsum('bhqd,bhkd->bhqk', q[:, :, start:end], k[:, :, :end]).astype(jnp.float32) * scale
        z = z + log_f_cum[:, :, start:end, None] - log_f_cum[:, :, None, :end]
        mask = jnp.arange(end)[None, :] <= jnp.arange(start, end)[:, None]
        p = jax.nn.softmax(jnp.where(mask, z, -jnp.inf), axis=-1)
        outs.append(jnp.einsum('bhqk,bhkd->bhqd', p.astype(v.dtype), v[:, :, :end]))
    return jnp.concatenate(outs, axis=2)


def hybrid_mixer(h, w_in, b_f, g_q, g_k, w_o):
    proj = h @ w_in
    splits = [SB_WIDTH, 2 * SB_WIDTH, 3 * SB_WIDTH,
              3 * SB_WIDTH + FOX_WIDTH, 3 * SB_WIDTH + 2 * FOX_WIDTH, 3 * SB_WIDTH + 3 * FOX_WIDTH]
    sb_q, sb_k, sb_v, fox_q, fox_k, fox_v, fox_f = jnp.split(proj, splits, axis=-1)
    sb_out = stick_breaking_attention(split_heads(sb_q, N_SB_HEADS), split_heads(sb_k, N_SB_HEADS),
                                      split_heads(sb_v, N_SB_HEADS))
    fq = rms_norm(split_heads(fox_q, N_FOX_HEADS), g_q[None, :, None, :])
    fk = rms_norm(split_heads(fox_k, N_FOX_HEADS), g_k[None, :, None, :])
    log_f = jax.nn.log_sigmoid((fox_f + b_f).astype(jnp.float32))
    log_f_cum = jnp.cumsum(log_f, axis=1).transpose(0, 2, 1)
    fox_out = forgetting_attention(fq, fk, split_heads(fox_v, N_FOX_HEADS), log_f_cum)
    heads = jnp.concatenate([sb_out, fox_out], axis=1)
    b, _, s, _ = heads.shape
    return heads.transpose(0, 2, 1, 3).reshape(b, s, MIX_WIDTH) @ w_o


def setup_inputs(seed: int = 0) -> dict:
    key = jax.random.key(seed)
    ks = jax.random.split(key, 20)
    nrm = jax.random.normal
    d_s = D_MODEL ** -0.5
    return {
        'x': nrm(ks[0], (BATCH, SEQ, D_MODEL), jnp.float32),
        'c': nrm(ks[1], (BATCH, D_MODEL), jnp.float32),
        'w_mod': nrm(ks[2], (DEPTH, D_MODEL, N_MOD * D_MODEL), jnp.float32) * (0.1 * d_s),
        'b_mod': nrm(ks[3], (DEPTH, N_MOD * D_MODEL), jnp.float32) * 0.01,
        'g_ffn1': 1.0 + 0.02 * nrm(ks[4], (DEPTH, D_MODEL), jnp.float32),
        'w1_gate': nrm(ks[5], (DEPTH, D_MODEL, D_FF), jnp.float32) * d_s,
        'w1_up': nrm(ks[6], (DEPTH, D_MODEL, D_FF), jnp.float32) * d_s,
        'w1_down': nrm(ks[7], (DEPTH, D_FF, D_MODEL), jnp.float32) * D_FF ** -0.5,
        'g_mix': 1.0 + 0.02 * nrm(ks[8], (DEPTH, D_MODEL), jnp.float32),
        'w_in': nrm(ks[9], (DEPTH, D_MODEL, IN_WIDTH), jnp.float32) * d_s,
        'b_f': jax.random.uniform(ks[10], (DEPTH, N_FOX_HEADS), jnp.float32, 1.0, 4.0),
        'g_q': 1.0 + 0.02 * nrm(ks[11], (DEPTH, N_FOX_HEADS, HEAD_DIM), jnp.float32),
        'g_k': 1.0 + 0.02 * nrm(ks[12], (DEPTH, N_FOX_HEADS, HEAD_DIM), jnp.float32),
        'w_o': nrm(ks[13], (DEPTH, MIX_WIDTH, D_MODEL), jnp.float32) * MIX_WIDTH ** -0.5,
        'g_ffn2': 1.0 + 0.02 * nrm(ks[14], (DEPTH, D_MODEL), jnp.float32),
        'w2_gate': nrm(ks[15], (DEPTH, D_MODEL, D_FF), jnp.float32) * d_s,
        'w2_up': nrm(ks[16], (DEPTH, D_MODEL, D_FF), jnp.float32) * d_s,
        'w2_down': nrm(ks[17], (DEPTH, D_FF, D_MODEL), jnp.float32) * D_FF ** -0.5,
    }


def reference(x, c, w_mod, b_mod, g_ffn1, w1_gate, w1_up, w1_down, g_mix, w_in, b_f, g_q, g_k,
              w_o, g_ffn2, w2_gate, w2_up, w2_down):
    c_act = jax.nn.silu(c)
    for l in range(DEPTH):
        mod = c_act @ w_mod[l] + b_mod[l]
        sh1, sc1, ga1, sh2, sc2, ga2, sh3, sc3, ga3 = jnp.split(mod, N_MOD, axis=-1)
        h = modulate(rms_norm(x, g_ffn1[l]), sh1, sc1)
        x = x + 0.5 * (1 + ga1[:, None, :]) * swiglu(h, w1_gate[l], w1_up[l], w1_down[l])
        h = modulate(rms_norm(x, g_mix[l]), sh2, sc2)
        x = x + (1 + ga2[:, None, :]) * hybrid_mixer(h, w_in[l], b_f[l], g_q[l], g_k[l], w_o[l])
        h = modulate(rms_norm(x, g_ffn2[l]), sh3, sc3)
        x = x + 0.5 * (1 + ga3[:, None, :]) * swiglu(h, w2_gate[l], w2_up[l], w2_down[l])
    return x
```

```cpp
#include <hip/hip_runtime.h>
#include <hip/hip_cooperative_groups.h>
#include <hip/hip_bf16.h>
#include <cstdio>
#include <cstdint>
#include <cmath>
namespace cg = cooperative_groups;
namespace pg8 {
#define PG8_LAS __attribute__((address_space(3)))
typedef unsigned short bf16_t;
typedef short bf16x8 __attribute__((ext_vector_type(8)));
typedef float f32x4 __attribute__((ext_vector_type(4)));
typedef unsigned u32x4 __attribute__((ext_vector_type(4)));
constexpr int BM = 256, BK = 64, HALF = 128, HTB = HALF * BK * 2  , STAGE_BYTES = 8 * HTB, NXCD = 8, WGM = 8;

__host__ __device__ __forceinline__ int lds_byte(int r, int c) { const int st = (r >> 4) * 2 + (c >> 5), rr = r & 15, cc = c & 31, ob = rr * 64 + cc * 2; return st * 1024 + (ob ^ (((ob >> 9) & 1) << 5)); }
__host__ __device__ __forceinline__ void stage_rc(int b, int& R, int& C) { const int st = b / 1024, sb = b % 1024, swz = sb ^ (((sb >> 9) & 1) << 5); R = (st >> 1) * 16 + swz / 64; C = (st & 1) * 32 + (swz % 64) / 2; }
__host__ __device__ __forceinline__ int perm32(int rho) { const int n = rho >> 4, i = rho & 15; return 8 * (i >> 2) + 4 * n + (i & 3); }

struct Unit { int pm, pn; };
struct Gemm { const bf16_t* A; const bf16_t* Bt; int M, N, K; };

struct StaticOrder {
    int nM, nN, nwg, G, c;
    __host__ __device__ void init(int M, int N, int G_, int c_) { nM = M / BM; nN = N / BM; nwg = nM * nN; G = G_; c = c_; }
    __host__ __device__ bool next(int i, Unit& u) const {
        const long L = (long)i * G + c; if (L >= nwg) return false;
        int wgid = (int)L; { const int q = nwg / NXCD, r = nwg % NXCD, xcd = wgid % NXCD, off = wgid / NXCD; wgid = (xcd < r ? xcd * (q + 1) : r * (q + 1) + (xcd - r) * q) + off; }
        const int nig = WGM * nN, gid = wgid / nig, fm = gid * WGM, gsz = (nM - fm) < WGM ? (nM - fm) : WGM;
        u.pm = fm + ((wgid % nig) % gsz); u.pn = (wgid % nig) / gsz; return true;
    }
    __device__ __forceinline__ void a_ready(const Unit&) const {}
    __device__ __forceinline__ void done(const Unit&) const {}
};

__device__ __forceinline__ unsigned cvt_pk_bf16(float lo, float hi) { unsigned r; asm volatile("v_cvt_pk_bf16_f32 %0, %1, %2" : "=v"(r) : "v"(lo), "v"(hi)); return r; }
typedef float f32x2 __attribute__((ext_vector_type(2)));
typedef unsigned u32x2 __attribute__((ext_vector_type(2)));
__device__ __forceinline__ float fast_rcp(float x) { return __builtin_amdgcn_rcpf(x); }
__device__ __forceinline__ float fast_exp2(float x) { return __builtin_amdgcn_exp2f(x); }
struct EpiSwiGLU {
    static constexpr bool PERM = true, AFTER_DRAIN = false;
    bf16_t* O; int ldc;
    __device__ __forceinline__ void operator()(const f32x4 (&acc)[2][2][4][2], const Unit& u, int wr, int wc, int fr, int fq) const {
        const int row0 = u.pm * BM + wr * 64 + fr; const int col0 = u.pn * HALF + wc * 32 + 8 * fq;
#pragma unroll
        for (int ai = 0; ai < 2; ++ai)
#pragma unroll
            for (int m = 0; m < 4; ++m) {
                bf16_t* rowp = O + (size_t)(row0 + ai * HALF + m * 16) * ldc + col0;
                float r[8];
#pragma unroll
                for (int n = 0; n < 2; ++n)
#pragma unroll
                    for (int e = 0; e < 4; ++e) { const float g = acc[ai][0][m][n][e], up = acc[ai][1][m][n][e];
                        const float s = g * fast_rcp(1.0f + fast_exp2(g * -1.4426950408889634f)); r[n * 4 + e] = s * up; }
                u32x4 w; w.x = cvt_pk_bf16(r[0], r[1]); w.y = cvt_pk_bf16(r[2], r[3]); w.z = cvt_pk_bf16(r[4], r[5]); w.w = cvt_pk_bf16(r[6], r[7]);
                *(u32x4*)rowp = w;
            }
    }
};
__device__ __forceinline__ f32x4 bf2f_lo(u32x2 w) { return (f32x4){__uint_as_float(w.x << 16), __uint_as_float(w.x & 0xffff0000u), __uint_as_float(w.y << 16), __uint_as_float(w.y & 0xffff0000u)}; }
template <bool BIN, bool BOUT> struct EpiResid {
    static constexpr bool PERM = true, AFTER_DRAIN = false;
    const void* base; void* out; const float* gate; float mul;
    __device__ __forceinline__ void operator()(const f32x4 (&acc)[2][2][4][2], const Unit& u, int wr, int wc, int fr, int fq) const {
        const int row0 = u.pm * BM + wr * 64 + fr; const int col0 = u.pn * BM + wc * 32 + 8 * fq;
        const float* grow = gate + (size_t)(u.pm >> 4) * 9216 + col0;
        f32x4 gv[2][2];
#pragma unroll
        for (int bj = 0; bj < 2; ++bj)
#pragma unroll
            for (int n = 0; n < 2; ++n) { const f32x4 g = *(const f32x4*)(grow + bj * HALF + 4 * n); gv[bj][n] = (g + 1.0f) * mul; }
        f32x4 (&ac)[2][2][4][2] = const_cast<f32x4 (&)[2][2][4][2]>(acc);
#pragma unroll
        for (int ai = 0; ai < 2; ++ai)
#pragma unroll
            for (int bj = 0; bj < 2; ++bj)
#pragma unroll
                for (int m = 0; m < 4; ++m)
#pragma unroll
                    for (int n = 0; n < 2; ++n) ac[ai][bj][m][n] = ac[ai][bj][m][n] * gv[bj][n];
        asm volatile("" ::: "memory");
        const unsigned lane_el = (unsigned)((wr * 64 + fr) * 1024 + wc * 32 + 8 * fq);
        const size_t tile_el = (size_t)u.pm * BM * 1024 + (size_t)u.pn * BM;
        const char* bb = (const char*)base + tile_el * (BIN ? 2 : 4); char* ob = (char*)out + tile_el * (BOUT ? 2 : 4);
        const unsigned lb = lane_el * (BIN ? 2u : 4u), lo_ = lane_el * (BOUT ? 2u : 4u);
#define RG_EL(ai, m, bj) ((size_t)(((ai) * HALF + (m) * 16) * 1024 + (bj) * HALF))
        if (BIN) {
            u32x4 bw[2][4][2];
#pragma unroll
            for (int ai = 0; ai < 2; ++ai)
#pragma unroll
                for (int m = 0; m < 4; ++m)
#pragma unroll
                    for (int bj = 0; bj < 2; ++bj) bw[ai][m][bj] = *(const u32x4*)(bb + RG_EL(ai, m, bj) * 2 + lb);
            asm volatile("" ::: "memory");
#pragma unroll
            for (int ai = 0; ai < 2; ++ai)
#pragma unroll
                for (int m = 0; m < 4; ++m)
#pragma unroll
                    for (int bj = 0; bj < 2; ++bj) { const u32x4 w_ = bw[ai][m][bj]; const f32x4 b0 = bf2f_lo((u32x2){w_.x, w_.y}), b1 = bf2f_lo((u32x2){w_.z, w_.w});
                        const f32x4 o0 = b0 + ac[ai][bj][m][0], o1 = b1 + ac[ai][bj][m][1];
                        if (BOUT) { u32x4 w; w.x = cvt_pk_bf16(o0[0], o0[1]); w.y = cvt_pk_bf16(o0[2], o0[3]); w.z = cvt_pk_bf16(o1[0], o1[1]); w.w = cvt_pk_bf16(o1[2], o1[3]); *(u32x4*)(ob + RG_EL(ai, m, bj) * 2 + lo_) = w; }
                        else { *(f32x4*)(ob + RG_EL(ai, m, bj) * 4 + lo_) = o0; *(f32x4*)(ob + RG_EL(ai, m, bj) * 4 + lo_ + 16) = o1; } }
        } else {
#pragma unroll
            for (int ai = 0; ai < 2; ++ai) {
                f32x4 bf_[4][2][2];
#pragma unroll
                for (int m = 0; m < 4; ++m)
#pragma unroll
                    for (int bj = 0; bj < 2; ++bj) { const char* bp = bb + RG_EL(ai, m, bj) * 4 + lb; bf_[m][bj][0] = *(const f32x4*)bp; bf_[m][bj][1] = *(const f32x4*)(bp + 16); }
                asm volatile("" ::: "memory");
#pragma unroll
                for (int m = 0; m < 4; ++m)
#pragma unroll
                    for (int bj = 0; bj < 2; ++bj) { const f32x4 o0 = bf_[m][bj][0] + ac[ai][bj][m][0], o1 = bf_[m][bj][1] + ac[ai][bj][m][1];
                        if (BOUT) { u32x4 w; w.x = cvt_pk_bf16(o0[0], o0[1]); w.y = cvt_pk_bf16(o0[2], o0[3]); w.z = cvt_pk_bf16(o1[0], o1[1]); w.w = cvt_pk_bf16(o1[2], o1[3]); *(u32x4*)(ob + RG_EL(ai, m, bj) * 2 + lo_) = w; }
                        else { *(f32x4*)(ob + RG_EL(ai, m, bj) * 4 + lo_) = o0; *(f32x4*)(ob + RG_EL(ai, m, bj) * 4 + lo_ + 16) = o1; } }
                asm volatile("" ::: "memory");
            }
        }
#undef RG_EL
    }
};
struct EpiQKV {
    static constexpr bool PERM = true, AFTER_DRAIN = false;
    bf16_t* O; const float* gq; const float* gk; float qscale;
    __device__ __forceinline__ void operator()(const f32x4 (&acc)[2][2][4][2], const Unit& u, int wr, int wc, int fr, int fq) const {
        const int seg = u.pn >> 1, head = (u.pn & 1) * 4 + wc;
        const int row0 = u.pm * BM + wr * 64 + fr; const int col0 = u.pn * BM + wc * 64 + 8 * fq;
        const bool nrm = (seg == 3) || (seg == 4);
        const float sc = (seg == 0 || seg == 3) ? qscale : 1.0f;
        f32x4 gv[2][2];
#pragma unroll
        for (int bj = 0; bj < 2; ++bj)
#pragma unroll
            for (int n = 0; n < 2; ++n) { f32x4 g = (f32x4){1.f, 1.f, 1.f, 1.f};
                if (nrm) g = *(const f32x4*)((seg == 3 ? gq : gk) + head * 64 + bj * 32 + 8 * fq + 4 * n);
                gv[bj][n] = g * sc; }
#pragma unroll
        for (int ai = 0; ai < 2; ++ai)
#pragma unroll
            for (int m = 0; m < 4; ++m) {
                float rs = 1.0f;
                if (nrm) { float ss = 0.f;
#pragma unroll
                    for (int bj = 0; bj < 2; ++bj)
#pragma unroll
                        for (int n = 0; n < 2; ++n) { const f32x4 x = acc[ai][bj][m][n]; ss += (x[0] * x[0] + x[1] * x[1]) + (x[2] * x[2] + x[3] * x[3]); }
                    ss += __shfl_xor(ss, 16); ss += __shfl_xor(ss, 32);
                    rs = __builtin_amdgcn_rsqf(ss * (1.0f / 64.0f) + 1e-6f); }
                bf16_t* rowp = O + (size_t)(row0 + ai * HALF + m * 16) * 3072 + col0;
#pragma unroll
                for (int bj = 0; bj < 2; ++bj) { const f32x4 v0 = acc[ai][bj][m][0] * rs * gv[bj][0], v1 = acc[ai][bj][m][1] * rs * gv[bj][1];
                    u32x4 w; w.x = cvt_pk_bf16(v0[0], v0[1]); w.y = cvt_pk_bf16(v0[2], v0[3]); w.z = cvt_pk_bf16(v1[0], v1[1]); w.w = cvt_pk_bf16(v1[2], v1[3]);
                    *(u32x4*)(rowp + bj * 32) = w; }
            }
    }
};
template <class Epi, class Sched, bool ALIGN_EPI = false, bool SP2 = false>
__device__ __forceinline__ void gemm_phase(PG8_LAS unsigned char* lds, const Gemm g, const Sched& S, const Epi& E) {
    int tid_ = threadIdx.x; asm volatile("" : "+v"(tid_)); const int tid = tid_, wid = __builtin_amdgcn_readfirstlane(tid >> 6), lane = tid & 63, wr = wid >> 2, wc = wid & 3, fr = lane & 15, fq = lane >> 4;
    const int K = g.K, nt = K / BK;
    unsigned voffA[2], voffB[2];
#pragma unroll
    for (int i = 0; i < 2; ++i) { int R, C; stage_rc(tid * 16 + i * 8192, R, C); const int Rb = Epi::PERM ? ((R & ~31) + perm32(R & 31)) : R;
        voffA[i] = (unsigned)(R * K + C) * 2u; voffB[i] = (unsigned)(Rb * K + C) * 2u; }
    const size_t kstep = (size_t)(BK * 2);
    const size_t hstep = (size_t)HALF * K * 2;
    const size_t tstep = 2 * hstep;
    const unsigned ldsw = (unsigned)wid * 1024u;
    const int aoff = lds_byte(wr * 64 + fr, fq * 8), boff = lds_byte(wc * 32 + fr, fq * 8);
#define PG8_SA(b, h) (((b) * 2 + (h)) * HTB)
#define PG8_SB(b, h) ((4 + (b) * 2 + (h)) * HTB)
#define PG8_STAGE(bufoff, gbase, voff) do { _Pragma("unroll") for (int _i = 0; _i < 2; ++_i) \
        __builtin_amdgcn_global_load_lds((const unsigned*)((const char*)(gbase) + (voff)[_i]), (PG8_LAS unsigned*)(lds + (bufoff) + ldsw + _i * 8192), 16, 0, 0); } while (0)
#define PG8_LDA(dst, b, h) do { _Pragma("unroll") for (int m = 0; m < 4; ++m) _Pragma("unroll") for (int k = 0; k < 2; ++k) dst[m][k] = *(const PG8_LAS bf16x8*)(lds + PG8_SA(b, h) + aoff + m * 2048 + k * 1024); } while (0)
#define PG8_LDB(dst, b, h) do { _Pragma("unroll") for (int n = 0; n < 2; ++n) _Pragma("unroll") for (int k = 0; k < 2; ++k) dst[n][k] = *(const PG8_LAS bf16x8*)(lds + PG8_SB(b, h) + boff + n * 2048 + k * 1024); } while (0)
#define PG8_MMA(ai, bj, At, Bt) do { __builtin_amdgcn_s_setprio(1); _Pragma("unroll") for (int m = 0; m < 4; ++m) _Pragma("unroll") for (int n = 0; n < 2; ++n) _Pragma("unroll") for (int k = 0; k < 2; ++k) \
        acc[ai][bj][m][n] = __builtin_amdgcn_mfma_f32_16x16x32_bf16(Bt[n][k], At[m][k], acc[ai][bj][m][n], 0, 0, 0); __builtin_amdgcn_s_setprio(0); } while (0)
#define PG8_WAIT_V(n) asm volatile("s_waitcnt vmcnt(" #n ")" ::: "memory")
#define PG8_WAIT_L(n) asm volatile("s_waitcnt lgkmcnt(" #n ")" ::: "memory")
#define PG8_BAR __builtin_amdgcn_s_barrier()
#define PG8_SCHED __builtin_amdgcn_sched_barrier(0)
    Unit cur, nxt; int ui = 0;
    if (!S.next(0, cur)) return;
    f32x4 acc[2][2][4][2];
#pragma unroll
    for (int a = 0; a < 2; ++a)
#pragma unroll
        for (int b = 0; b < 2; ++b)
#pragma unroll
            for (int m = 0; m < 4; ++m)
#pragma unroll
                for (int n = 0; n < 2; ++n) acc[a][b][m][n] = (f32x4){0.f, 0.f, 0.f, 0.f};
    bf16x8 At[4][2], B0[2][2], B1[2][2];
    const char* cA = (const char*)g.A + (size_t)cur.pm * tstep; const char* cB = (const char*)g.Bt + (size_t)cur.pn * tstep;
    S.a_ready(cur);
    if constexpr (SP2) {
        PG8_STAGE(PG8_SB(0, 0), cB, voffB); PG8_STAGE(PG8_SB(0, 1), cB + hstep, voffB); PG8_STAGE(PG8_SA(0, 0), cA, voffA); PG8_STAGE(PG8_SA(0, 1), cA + hstep, voffA);
        if (wr == 1) PG8_BAR;
        PG8_WAIT_V(2); PG8_BAR;
        PG8_STAGE(PG8_SB(1, 0), cB + kstep, voffB); PG8_STAGE(PG8_SA(1, 0), cA + kstep, voffA); PG8_STAGE(PG8_SB(1, 1), cB + hstep + kstep, voffB);
        PG8_WAIT_V(6); PG8_BAR;
    } else {
        PG8_STAGE(PG8_SB(0, 0), cB, voffB); PG8_STAGE(PG8_SA(0, 0), cA, voffA); PG8_STAGE(PG8_SB(0, 1), cB + hstep, voffB); PG8_STAGE(PG8_SA(0, 1), cA + hstep, voffA);
        if (wr == 1) PG8_BAR;
        PG8_WAIT_V(4); PG8_BAR;
        PG8_STAGE(PG8_SB(1, 0), cB + kstep, voffB); PG8_STAGE(PG8_SA(1, 0), cA + kstep, voffA); PG8_STAGE(PG8_SB(1, 1), cB + hstep + kstep, voffB);
        PG8_WAIT_V(6); PG8_BAR;
    }
    for (;;) {
        const bool has_next = S.next(ui + 1, nxt);
        const char* nA = has_next ? (const char*)g.A + (size_t)nxt.pm * tstep : cA; const char* nB = has_next ? (const char*)g.Bt + (size_t)nxt.pn * tstep : cB;
        for (int t = 0; t < nt; t += 2) {
            const bool last = (t == nt - 2);
            const char* a1 = cA + (size_t)(t + 1) * kstep;
            const char* a2 = last ? nA : cA + (size_t)(t + 2) * kstep; const char* b2 = last ? nB : cB + (size_t)(t + 2) * kstep;
            const char* a3 = a2 + kstep; const char* b3 = b2 + kstep;
            if (last && has_next) S.a_ready(nxt);
            if constexpr (SP2) {
            PG8_LDB(B0, 0, 0); PG8_LDB(B1, 0, 1); PG8_SCHED; PG8_LDA(At, 0, 0); PG8_STAGE(PG8_SA(1, 1), a1 + hstep, voffA);
            PG8_WAIT_V(8); PG8_WAIT_L(0); PG8_BAR; PG8_MMA(0, 0, At, B0); PG8_MMA(0, 1, At, B1); PG8_BAR; PG8_SCHED;
            PG8_LDA(At, 0, 1); PG8_STAGE(PG8_SB(0, 0), b2, voffB); PG8_STAGE(PG8_SB(0, 1), b2 + hstep, voffB); PG8_STAGE(PG8_SA(0, 0), a2, voffA);
            PG8_WAIT_V(8); PG8_WAIT_L(0); PG8_BAR; PG8_MMA(1, 0, At, B0); PG8_MMA(1, 1, At, B1); PG8_BAR; PG8_SCHED;
            PG8_LDB(B0, 1, 0); PG8_LDB(B1, 1, 1); PG8_SCHED; PG8_LDA(At, 1, 0); PG8_STAGE(PG8_SA(0, 1), a2 + hstep, voffA);
            PG8_WAIT_V(8); PG8_WAIT_L(0); PG8_BAR; PG8_MMA(0, 0, At, B0); PG8_MMA(0, 1, At, B1); PG8_BAR; PG8_SCHED;
            PG8_LDA(At, 1, 1); PG8_STAGE(PG8_SB(1, 0), b3, voffB); PG8_STAGE(PG8_SB(1, 1), b3 + hstep, voffB); PG8_STAGE(PG8_SA(1, 0), a3, voffA);
            PG8_WAIT_V(8); PG8_WAIT_L(0); PG8_BAR; PG8_MMA(1, 0, At, B0); PG8_MMA(1, 1, At, B1); PG8_BAR; PG8_SCHED;
            } else {
            PG8_LDB(B0, 0, 0); PG8_SCHED; PG8_LDA(At, 0, 0); PG8_STAGE(PG8_SA(1, 1), a1 + hstep, voffA);
            PG8_WAIT_L(8); PG8_BAR; PG8_WAIT_L(0); PG8_MMA(0, 0, At, B0); PG8_BAR; PG8_SCHED;
            PG8_LDB(B1, 0, 1); PG8_STAGE(PG8_SB(0, 0), b2, voffB);
            PG8_BAR; PG8_WAIT_L(0); PG8_MMA(0, 1, At, B1); PG8_BAR;
            PG8_LDA(At, 0, 1); PG8_STAGE(PG8_SA(0, 0), a2, voffA);
            PG8_BAR; PG8_WAIT_L(0); PG8_MMA(1, 0, At, B0); PG8_BAR; PG8_SCHED;
            PG8_STAGE(PG8_SB(0, 1), b2 + hstep, voffB);
            PG8_WAIT_V(6); PG8_BAR; PG8_MMA(1, 1, At, B1); PG8_BAR;
            PG8_LDB(B0, 1, 0); PG8_SCHED; PG8_LDA(At, 1, 0); PG8_STAGE(PG8_SA(0, 1), a2 + hstep, voffA);
            PG8_WAIT_L(8); PG8_BAR; PG8_WAIT_L(0); PG8_MMA(0, 0, At, B0); PG8_BAR; PG8_SCHED;
            PG8_LDB(B1, 1, 1); PG8_STAGE(PG8_SB(1, 0), b3, voffB);
            PG8_BAR; PG8_WAIT_L(0); PG8_MMA(0, 1, At, B1); PG8_BAR;
            PG8_LDA(At, 1, 1); PG8_STAGE(PG8_SA(1, 0), a3, voffA);
            PG8_BAR; PG8_WAIT_L(0); PG8_MMA(1, 0, At, B0); PG8_BAR; PG8_SCHED;
            PG8_STAGE(PG8_SB(1, 1), b3 + hstep, voffB);
            PG8_WAIT_V(6); PG8_BAR; PG8_MMA(1, 1, At, B1); PG8_BAR;
            }
        }
        if constexpr (ALIGN_EPI) { if (wr == 0) PG8_BAR; }
        if constexpr (!Epi::AFTER_DRAIN) { E(acc, cur, wr, wc, fr, fq); S.done(cur); }
        if (!has_next) break;
#pragma unroll
        for (int a = 0; a < 2; ++a)
#pragma unroll
            for (int b = 0; b < 2; ++b)
#pragma unroll
                for (int m = 0; m < 4; ++m)
#pragma unroll
                    for (int n = 0; n < 2; ++n) acc[a][b][m][n] = (f32x4){0.f, 0.f, 0.f, 0.f};
        cur = nxt; cA = nA; cB = nB; ++ui;
        if constexpr (ALIGN_EPI) { if (wr == 1) PG8_BAR; }
    }
    PG8_WAIT_V(0);
    if constexpr (!ALIGN_EPI) { if (wr == 0) PG8_BAR; }
    PG8_BAR;
    if constexpr (Epi::AFTER_DRAIN) { E.fused(acc, cur, wr, wc, fr, fq, lds, wid, lane); S.done(cur); }
#undef PG8_SA
#undef PG8_SB
#undef PG8_STAGE
#undef PG8_LDA
#undef PG8_LDB
#undef PG8_MMA
#undef PG8_WAIT_V
#undef PG8_WAIT_L
#undef PG8_BAR
#undef PG8_SCHED
}
}
namespace att {
#define ALAS __attribute__((address_space(3)))
using bf16 = unsigned short;
using bf16x8 = __attribute__((ext_vector_type(8))) short;
using s16x4 = __attribute__((ext_vector_type(4))) short;
using f32x16 = __attribute__((ext_vector_type(16))) float;
using f32x4 = __attribute__((ext_vector_type(4))) float;
using u32x4 = __attribute__((ext_vector_type(4))) unsigned;
constexpr int SEQ = 4096, PITCH = 3072, OPITCH = 1024, QB = 256, KVBLK = 64;
constexpr int SLOTB = 8192;
constexpr int L_K = 0, L_V = 4 * SLOTB, L_B = 8 * SLOTB, L_WS = L_B + 512, L_FLAG = L_WS + 8 * 256, L_OST = L_FLAG + 64, L_BYTES = L_OST + 8 * 4096;
__device__ __forceinline__ int crow(int r, int hi) { return (r & 3) + 8 * (r >> 2) + 4 * hi; }
__device__ __forceinline__ void glds16(const void* gsrc, unsigned lds_dst) { unsigned keep;
    asm volatile("s_mov_b32 %0, m0\n\ts_mov_b32 m0, %2\n\ts_nop 0\n\tglobal_load_lds_dwordx4 %1, off\n\ts_mov_b32 m0, %0" : "=&s"(keep) : "v"(gsrc), "s"(lds_dst) : "memory"); }
__device__ __forceinline__ void glds4(const void* gsrc, unsigned lds_dst) { unsigned keep;
    asm volatile("s_mov_b32 %0, m0\n\ts_mov_b32 m0, %2\n\ts_nop 0\n\tglobal_load_lds_dword %1, off\n\ts_mov_b32 m0, %0" : "=&s"(keep) : "v"(gsrc), "s"(lds_dst) : "memory"); }
typedef float f32x2_t __attribute__((ext_vector_type(2))); typedef __bf16 bf16x2_t __attribute__((ext_vector_type(2)));
__device__ __forceinline__ unsigned cvtpk_s(float lo, float hi) { f32x2_t v = {lo, hi}; bf16x2_t b = __builtin_convertvector(v, bf16x2_t); return __builtin_bit_cast(unsigned, b); }
#define AWAIT_BAR() asm volatile("s_waitcnt vmcnt(0) lgkmcnt(0)\n\ts_barrier" ::: "memory")
#define ASBAR() __builtin_amdgcn_sched_barrier(0)
struct VFrag { s16x4 lo[8], hi[8]; };
__device__ __forceinline__ void v_issue(VFrag& f, int vb) {
#pragma unroll
    for (int i = 0; i < 8; ++i) {
        asm volatile("ds_read_b64_tr_b16 %0,%1 offset:%c2" : "=&v"(f.lo[i]) : "v"(vb), "i"((i >> 2) * 4096 + (i & 3) * 1024) : "memory");
        asm volatile("ds_read_b64_tr_b16 %0,%1 offset:%c2" : "=&v"(f.hi[i]) : "v"(vb), "i"((i >> 2) * 4096 + (i & 3) * 1024 + 512) : "memory"); }
}
__device__ __forceinline__ void pv_mma(f32x16* o, VFrag& f, bf16x8 pa0, bf16x8 pa1, bf16x8 pa2, bf16x8 pa3) {
    asm volatile("s_waitcnt lgkmcnt(0)" : "+v"(f.lo[0]), "+v"(f.lo[1]), "+v"(f.lo[2]), "+v"(f.lo[3]), "+v"(f.lo[4]), "+v"(f.lo[5]), "+v"(f.lo[6]), "+v"(f.lo[7]),
                                          "+v"(f.hi[0]), "+v"(f.hi[1]), "+v"(f.hi[2]), "+v"(f.hi[3]), "+v"(f.hi[4]), "+v"(f.hi[5]), "+v"(f.hi[6]), "+v"(f.hi[7]) :: "memory");
#define APK2(k) (bf16x8){f.lo[k][0], f.lo[k][1], f.lo[k][2], f.lo[k][3], f.hi[k][0], f.hi[k][1], f.hi[k][2], f.hi[k][3]}
    o[0] = __builtin_amdgcn_mfma_f32_32x32x16_bf16(pa0, APK2(0), o[0], 0, 0, 0); o[1] = __builtin_amdgcn_mfma_f32_32x32x16_bf16(pa0, APK2(4), o[1], 0, 0, 0);
    o[0] = __builtin_amdgcn_mfma_f32_32x32x16_bf16(pa1, APK2(1), o[0], 0, 0, 0); o[1] = __builtin_amdgcn_mfma_f32_32x32x16_bf16(pa1, APK2(5), o[1], 0, 0, 0);
    o[0] = __builtin_amdgcn_mfma_f32_32x32x16_bf16(pa2, APK2(2), o[0], 0, 0, 0); o[1] = __builtin_amdgcn_mfma_f32_32x32x16_bf16(pa2, APK2(6), o[1], 0, 0, 0);
    o[0] = __builtin_amdgcn_mfma_f32_32x32x16_bf16(pa3, APK2(3), o[0], 0, 0, 0); o[1] = __builtin_amdgcn_mfma_f32_32x32x16_bf16(pa3, APK2(7), o[1], 0, 0, 0);
#undef APK2
}
__device__ __forceinline__ void pv(f32x16* o, int vb, bf16x8 pa0, bf16x8 pa1, bf16x8 pa2, bf16x8 pa3) {
#pragma unroll
    for (int d0 = 0; d0 < 2; ++d0) { s16x4 lo[4], hi[4];
#pragma unroll
        for (int ks = 0; ks < 4; ++ks) {
            asm volatile("ds_read_b64_tr_b16 %0,%1 offset:%c2" : "=&v"(lo[ks]) : "v"(vb), "i"(d0 * 4096 + ks * 1024) : "memory");
            asm volatile("ds_read_b64_tr_b16 %0,%1 offset:%c2" : "=&v"(hi[ks]) : "v"(vb), "i"(d0 * 4096 + ks * 1024 + 512) : "memory"); }
        asm volatile("s_waitcnt lgkmcnt(0)" ::: "memory"); ASBAR();
#define APK(k) (bf16x8){lo[k][0], lo[k][1], lo[k][2], lo[k][3], hi[k][0], hi[k][1], hi[k][2], hi[k][3]}
        o[d0] = __builtin_amdgcn_mfma_f32_32x32x16_bf16(pa0, APK(0), o[d0], 0, 0, 0);
        o[d0] = __builtin_amdgcn_mfma_f32_32x32x16_bf16(pa1, APK(1), o[d0], 0, 0, 0);
        o[d0] = __builtin_amdgcn_mfma_f32_32x32x16_bf16(pa2, APK(2), o[d0], 0, 0, 0);
        o[d0] = __builtin_amdgcn_mfma_f32_32x32x16_bf16(pa3, APK(3), o[d0], 0, 0, 0);
#undef APK
    }
}
#ifndef SB_EARLY_EXIT
#define SB_EARLY_EXIT 1
#endif
#ifndef FOX_SKIP
#define FOX_SKIP 1
#endif
template <bool FOX>
__device__ __forceinline__ void attn_unit(int b, int h, int qb, const bf16* __restrict__ QKV, const float* __restrict__ kbias, const float* __restrict__ gq, const float* __restrict__ gk, bf16* O, ALAS unsigned char* lds, unsigned* qc, volatile ALAS unsigned* qslot) {
    int tid_ = threadIdx.x; asm volatile("" : "+v"(tid_)); const int tid = tid_, lane = tid & 63, r32 = lane & 31, hi = lane >> 5; const int wid = __builtin_amdgcn_readfirstlane(tid >> 6);
    const long rowbase = (long)b * SEQ; const int q0 = qb * QB;
    const int colq = (FOX ? 1536 : 0) + h * 64;
    const bf16* Qw = QKV + (rowbase + q0 + wid * 32) * PITCH + colq;
    const bf16* Kh = QKV + rowbase * PITCH + colq + 512; const bf16* Vh = QKV + rowbase * PITCH + colq + 1024;
    const unsigned lds0 = (unsigned)(uintptr_t)lds;
    ALAS float* wsf = (ALAS float*)(lds + L_WS) + wid * 64;
    ALAS unsigned* flags = (ALAS unsigned*)(lds + L_FLAG);
    const int kpos = lane, khi = (kpos >> 2) & 1, kr = (kpos & 3) + 4 * ((kpos & 31) >> 3), kkey = khi * 32 + (kpos >> 5) * 16 + kr;
    const bf16* ksrc = Kh + (long)kkey * PITCH + wid * 8;
    const int key16 = lane >> 2, vhi = (key16 >> 2) & 1, vj = (key16 & 3) + 4 * (key16 >> 3), vkey = vhi * 32 + (wid & 3) * 8 + vj;
    const bf16* vsrc = Vh + (long)vkey * PITCH + (wid >> 2) * 32 + (lane & 3) * 8;
    const float* bsrc = kbias + ((long)(b * 8 + h)) * SEQ + lane;
    const unsigned kdst = lds0 + L_K + wid * 1024, vdst = lds0 + L_V + wid * 1024, bdst = lds0 + L_B;
#define ADMA(t, slot) do { glds16(ksrc + (long)(t) * KVBLK * PITCH, (unsigned)__builtin_amdgcn_readfirstlane(kdst + (slot) * SLOTB)); \
                           glds16(vsrc + (long)(t) * KVBLK * PITCH, (unsigned)__builtin_amdgcn_readfirstlane(vdst + (slot) * SLOTB)); \
                           if (FOX && wid == 0) glds4(bsrc + (t) * KVBLK, (unsigned)__builtin_amdgcn_readfirstlane(bdst + (slot) * 256)); } while (0)
    const int vb0 = (int)(lds0 + L_V) + ((lane >> 4) & 1) * 32 + (lane & 3) * 8 + (4 * hi + ((lane & 15) >> 2)) * 64;
    const int NT = (q0 + QB) / KVBLK;
    if (lane == 0) flags[wid] = 0u;
    float sbound = 0.f;
    if (FOX && FOX_SKIP) { float a = fabsf(gq[h * 64 + lane]), c = fabsf(gk[h * 64 + lane]);
#pragma unroll
        for (int o_ = 1; o_ < 64; o_ <<= 1) { a = fmaxf(a, __shfl_xor(a, o_)); c = fmaxf(c, __shfl_xor(c, o_)); }
        sbound = 64.0f * 0.125f * 1.4426950408889634f * a * c * 1.02f + 0.5f; }
    if (FOX) { ADMA(NT - 1, 0); } else { ADMA(NT - 1, (NT - 1) & 3); ADMA(NT - 2, (NT - 2) & 3); ADMA(NT - 3, (NT - 3) & 3); }
    bf16x8 qr[4];
#pragma unroll
    for (int d0 = 0; d0 < 4; ++d0) qr[d0] = *reinterpret_cast<const bf16x8*>(&Qw[(long)r32 * PITCH + d0 * 16 + hi * 8]);
    f32x16 o[2]; o[0] = f32x16{}; o[1] = f32x16{};
    float m_run = -1e30f, l_run = 0.f, Rp = 1.0f;
    const int qpos = q0 + wid * 32 + r32;
    const int qlast = q0 + wid * 32 + 31;
    for (int it = 0; it < NT; ++it) {
        int t, slot;
        if (FOX) { t = NT - 1 - it; slot = it & 1; } else { t = (wid < 4) ? NT - 3 - it : NT - 1 - it; slot = t & 3; }
        AWAIT_BAR();
        if (FOX ? FOX_SKIP : SB_EARLY_EXIT) {
            const u32x4 f0 = *(ALAS const u32x4*)(flags), f1 = *(ALAS const u32x4*)(flags + 4);
            if ((f0.x & f0.y & f0.z & f0.w & f1.x & f1.y & f1.z & f1.w) != 0u) break;
        }
        if (FOX) { if (it + 1 < NT) ADMA(t - 1, slot ^ 1); }
        else { const int tn = NT - 4 - it; if (tn >= 0) ADMA(tn, tn & 3); if (t < 0) { if (lane == 0) flags[wid] = 1u; continue; } }
        if (KVBLK * t > qlast) continue;
        const bool band = (KVBLK * t + KVBLK - 1 > q0 + wid * 32 - (FOX ? 0 : 1));
        f32x16 p0, p1;
        if (FOX) { const ALAS f32x4* bp = (const ALAS f32x4*)(lds + L_B + slot * 256 + hi * 128);
            const f32x4 c0 = bp[0], c1 = bp[1], c2 = bp[2], c3 = bp[3], c4 = bp[4], c5 = bp[5], c6 = bp[6], c7 = bp[7];
            p0 = (f32x16){c0[0], c0[1], c0[2], c0[3], c1[0], c1[1], c1[2], c1[3], c2[0], c2[1], c2[2], c2[3], c3[0], c3[1], c3[2], c3[3]};
            p1 = (f32x16){c4[0], c4[1], c4[2], c4[3], c5[0], c5[1], c5[2], c5[3], c6[0], c6[1], c6[2], c6[3], c7[0], c7[1], c7[2], c7[3]};
        } else { p0 = f32x16{}; p1 = f32x16{}; }
        VFrag vf; v_issue(vf, vb0 + slot * SLOTB);
        { const ALAS unsigned char* kp = lds + L_K + slot * SLOTB + hi * 1024 + r32 * 16;
#pragma unroll
          for (int d0 = 0; d0 < 4; ++d0) { const bf16x8 b0 = *(const ALAS bf16x8*)(kp + d0 * 2048), b1 = *(const ALAS bf16x8*)(kp + d0 * 2048 + 512);
              p0 = __builtin_amdgcn_mfma_f32_32x32x16_bf16(b0, qr[d0], p0, 0, 0, 0); p1 = __builtin_amdgcn_mfma_f32_32x32x16_bf16(b1, qr[d0], p1, 0, 0, 0); } }
        const int kbase = KVBLK * t + hi * 32;
        if (FOX) {
            if (band) {
#pragma unroll
                for (int r = 0; r < 16; ++r) { if (kbase + r > qpos) p0[r] = -INFINITY; if (kbase + 16 + r > qpos) p1[r] = -INFINITY; } }
            float mx = fmaxf(p0[0], p1[0]);
#pragma unroll
            for (int r = 1; r < 16; ++r) mx = fmaxf(mx, fmaxf(p0[r], p1[r]));
            { auto rr = __builtin_amdgcn_permlane32_swap(__float_as_uint(mx), __float_as_uint(mx), false, false); mx = fmaxf(__uint_as_float(rr[0]), __uint_as_float(rr[1])); }
            const float m_new = fmaxf(m_run, mx);
            if (__any(m_new > m_run)) {
                const float alpha = __builtin_amdgcn_exp2f(m_run - m_new); l_run *= alpha; m_run = m_new;
                if (hi == 0) wsf[r32] = alpha;
                asm volatile("s_waitcnt lgkmcnt(0)" ::: "memory");
#pragma unroll
                for (int g = 0; g < 4; ++g) { const f32x4 a = *(const ALAS f32x4*)(wsf + 8 * g + 4 * hi);
#pragma unroll
                    for (int e = 0; e < 4; ++e) { o[0][4 * g + e] *= a[e]; o[1][4 * g + e] *= a[e]; } }
            }
            float sacc = 0.f;
#pragma unroll
            for (int r = 0; r < 16; ++r) { p0[r] = __builtin_amdgcn_exp2f(p0[r] - m_run); p1[r] = __builtin_amdgcn_exp2f(p1[r] - m_run); sacc += p0[r] + p1[r]; }
            l_run += sacc;
            if (FOX_SKIP) {
                const float b0 = *(const ALAS float*)(lds + L_B + slot * 256);
                const bool dead = __all(sbound + b0 - m_run < -150.0f);
                if (lane == 0) flags[wid] = dead ? 1u : 0u; }
        } else {
            float acc = 1.0f;
#pragma unroll
            for (int e = 31; e >= 0; --e) {
                const float s = fminf(e < 16 ? p0[e] : p1[e - 16], 100.0f);
                const float tt = __builtin_amdgcn_exp2f(s);
                float kp_ = __builtin_amdgcn_rcpf(1.0f + tt); bool dead = false;
                if (band) { dead = (kbase + e >= qpos); kp_ = dead ? 1.0f : kp_; }
                acc *= kp_; const float w = dead ? 0.0f : tt * acc;
                if (e < 16) p0[e] = w; else p1[e - 16] = w;
            }
            auto rr = __builtin_amdgcn_permlane32_swap(__float_as_uint(acc), __float_as_uint(acc), false, false);
            const float t_lo = __uint_as_float(rr[0]), t_hi = __uint_as_float(rr[1]);
            const float off = hi ? Rp : Rp * t_hi;
#pragma unroll
            for (int r = 0; r < 16; ++r) { p0[r] *= off; p1[r] *= off; }
            Rp = Rp * t_lo * t_hi;
            if (SB_EARLY_EXIT) { const bool alldead = __all(Rp == 0.0f); if (lane == 0) flags[wid] = alldead ? 1u : 0u; }
        }
        u32x4 pw0, pw1, pw2, pw3;
        pw0 = (u32x4){cvtpk_s(p0[0], p0[1]), cvtpk_s(p0[2], p0[3]), cvtpk_s(p0[4], p0[5]), cvtpk_s(p0[6], p0[7])};
        pw1 = (u32x4){cvtpk_s(p0[8], p0[9]), cvtpk_s(p0[10], p0[11]), cvtpk_s(p0[12], p0[13]), cvtpk_s(p0[14], p0[15])};
        pw2 = (u32x4){cvtpk_s(p1[0], p1[1]), cvtpk_s(p1[2], p1[3]), cvtpk_s(p1[4], p1[5]), cvtpk_s(p1[6], p1[7])};
        pw3 = (u32x4){cvtpk_s(p1[8], p1[9]), cvtpk_s(p1[10], p1[11]), cvtpk_s(p1[12], p1[13]), cvtpk_s(p1[14], p1[15])};
        pv_mma(o, vf, __builtin_bit_cast(bf16x8, pw0), __builtin_bit_cast(bf16x8, pw1), __builtin_bit_cast(bf16x8, pw2), __builtin_bit_cast(bf16x8, pw3));
    }
    unsigned nxq = 0u; if (tid == 0) nxq = atomicAdd(qc, 1u);
    float rli[16];
    if (FOX) {
        { auto rr = __builtin_amdgcn_permlane32_swap(__float_as_uint(l_run), __float_as_uint(l_run), false, false); l_run = __uint_as_float(rr[0]) + __uint_as_float(rr[1]); }
        if (hi == 0) wsf[32 + r32] = l_run;
        asm volatile("s_waitcnt lgkmcnt(0)" ::: "memory");
#pragma unroll
        for (int r = 0; r < 16; ++r) rli[r] = __builtin_amdgcn_rcpf(wsf[32 + crow(r, hi)]);
    } else {
#pragma unroll
        for (int r = 0; r < 16; ++r) rli[r] = 1.0f;
    }
    bf16* Ow = O + (rowbase + q0 + wid * 32) * OPITCH + ((FOX ? 8 : 0) + h) * 64;
    { ALAS bf16* stg = (ALAS bf16*)(lds + L_OST) + wid * 2048;
#pragma unroll
      for (int r = 0; r < 16; ++r) { const int orow = crow(r, hi);
#pragma unroll
          for (int d0 = 0; d0 < 2; ++d0) stg[orow * 64 + d0 * 32 + r32] = (bf16)(cvtpk_s(o[d0][r] * rli[r], 0.f) & 0xffffu); }
      asm volatile("s_waitcnt lgkmcnt(0)" ::: "memory");
#pragma unroll
      for (int i = 0; i < 4; ++i) { const int row = i * 8 + (lane >> 3), ch = lane & 7; const u32x4 v = *(const ALAS u32x4*)(stg + row * 64 + ch * 8); *(u32x4*)(Ow + (long)row * OPITCH + ch * 8) = v; } }
    if (tid == 0) *qslot = nxq;
    asm volatile("s_waitcnt vmcnt(0) lgkmcnt(0)\n\ts_barrier" ::: "memory");
#undef ADMA
}
#undef AWAIT_BAR
#undef ASBAR
}
namespace fox {
using bf16 = unsigned short;
using bf16x8 = __attribute__((ext_vector_type(8))) short;
using s16x4 = __attribute__((ext_vector_type(4))) short;
using f32x16 = __attribute__((ext_vector_type(16))) float;
using f32x4 = __attribute__((ext_vector_type(4))) float;
using u32x4 = __attribute__((ext_vector_type(4))) unsigned;
constexpr int SEQ = 4096, DM = 3072, OPITCH = 1024, D = 64, NW = 8, QBLK = 32, QB = 256, KVBLK = 64;
__device__ __forceinline__ int crow(int r,int hi){return (r&3)+8*(r>>2)+4*hi;}
#define SBAR() __builtin_amdgcn_sched_barrier(0)
__device__ __forceinline__ void cmask(f32x16&p0,f32x16&p1,int jb,int qrel,int hi){
  const float NEG=-INFINITY; int kb=64*jb+4*hi;
  #pragma unroll
  for(int r=0;r<16;++r){int kv=kb+(r&3)+8*(r>>2); if(kv>qrel)p0[r]=NEG; if(kv+32>qrel)p1[r]=NEG;}
}

__device__ __forceinline__ void glds16(const void*gsrc,unsigned lds_dst){unsigned keep;
  asm volatile("s_mov_b32 %0, m0\n\ts_mov_b32 m0, %2\n\ts_nop 0\n\tglobal_load_lds_dwordx4 %1, off\n\ts_mov_b32 m0, %0":"=&s"(keep):"v"(gsrc),"s"(lds_dst):"memory");}
__device__ __forceinline__ float max3f(float a,float b,float c){float r;asm("v_max3_f32 %0, %1, %2, %3":"=v"(r):"v"(a),"v"(b),"v"(c));return r;}
__device__ __forceinline__ float max2f(float a,float b){float r;asm("v_max_f32_e32 %0, %1, %2":"=v"(r):"v"(a),"v"(b));return r;}
__device__ __forceinline__ float fadd_s(float a,float b){float r;asm("v_add_f32_e32 %0, %1, %2":"=v"(r):"v"(a),"v"(b));return r;}
__device__ __forceinline__ float fsub_s(float a,float b){float r;asm("v_sub_f32_e32 %0, %1, %2":"=v"(r):"v"(a),"v"(b));return r;}
typedef float f32x2_t __attribute__((ext_vector_type(2))); typedef __bf16 bf16x2_t __attribute__((ext_vector_type(2)));
__device__ __forceinline__ unsigned cvtpk_s(float lo,float hi){f32x2_t v={lo,hi};bf16x2_t b=__builtin_convertvector(v,bf16x2_t);return __builtin_bit_cast(unsigned,b);}
#define WAIT_BAR(N) asm volatile("s_waitcnt vmcnt(" #N ") lgkmcnt(0)\n\ts_barrier":::"memory")
typedef __attribute__((address_space(3))) const char* lds_cptr;
typedef short v4i16_t __attribute__((ext_vector_type(4)));
__device__ __forceinline__ void kload8(bf16x8*kf,lds_cptr kp){
  kf[0]=*(const __attribute__((address_space(3))) bf16x8*)(kp);      kf[1]=*(const __attribute__((address_space(3))) bf16x8*)(kp+512);
  kf[2]=*(const __attribute__((address_space(3))) bf16x8*)(kp+2048); kf[3]=*(const __attribute__((address_space(3))) bf16x8*)(kp+2560);
  kf[4]=*(const __attribute__((address_space(3))) bf16x8*)(kp+4096); kf[5]=*(const __attribute__((address_space(3))) bf16x8*)(kp+4608);
  kf[6]=*(const __attribute__((address_space(3))) bf16x8*)(kp+6144); kf[7]=*(const __attribute__((address_space(3))) bf16x8*)(kp+6656);
}
__device__ __forceinline__ void kload2(bf16x8*kf,lds_cptr kp,int j){ kf[2*j]=*(const __attribute__((address_space(3))) bf16x8*)(kp+j*2048); kf[2*j+1]=*(const __attribute__((address_space(3))) bf16x8*)(kp+j*2048+512); }
__device__ __forceinline__ s16x4 vtr(lds_cptr p){ return __builtin_bit_cast(s16x4,__builtin_amdgcn_ds_read_tr16_b64_v4i16((__attribute__((address_space(3))) v4i16_t*)p)); }
__device__ __forceinline__ float rowmax(const f32x16&p0,const f32x16&p1){
  float a=max3f(p0[0],p0[1],p1[0]),b=max3f(p0[2],p0[3],p1[1]);a=max3f(a,p1[2],p1[3]);
  #pragma unroll
  for(int r=4;r<16;r+=4){a=max3f(a,p0[r],p0[r+1]);b=max3f(b,p0[r+2],p0[r+3]);a=max3f(a,p1[r],p1[r+1]);b=max3f(b,p1[r+2],p1[r+3]);}
  const float m=max2f(a,b);
  auto rr=__builtin_amdgcn_permlane32_swap(__float_as_uint(m),__float_as_uint(m),false,false);
  return max2f(__uint_as_float(rr[0]),__uint_as_float(rr[1]));
}

__device__ __forceinline__ void pvd(f32x16* o, int vb, bf16x8 pa0, bf16x8 pa1, bf16x8 pa2, bf16x8 pa3) {
#pragma unroll
  for (int d0 = 0; d0 < 2; ++d0) { s16x4 lo[4], hi[4];
#pragma unroll
    for (int ks = 0; ks < 4; ++ks) {
      asm volatile("ds_read_b64_tr_b16 %0,%1 offset:%c2" : "=&v"(lo[ks]) : "v"(vb), "i"(d0 * 4096 + ks * 1024) : "memory");
      asm volatile("ds_read_b64_tr_b16 %0,%1 offset:%c2" : "=&v"(hi[ks]) : "v"(vb), "i"(d0 * 4096 + ks * 1024 + 512) : "memory"); }
    asm volatile("s_waitcnt lgkmcnt(0)" ::: "memory"); SBAR();
#define PK(k) (bf16x8){lo[k][0], lo[k][1], lo[k][2], lo[k][3], hi[k][0], hi[k][1], hi[k][2], hi[k][3]}
    o[d0] = __builtin_amdgcn_mfma_f32_32x32x16_bf16(pa0, PK(0), o[d0], 0, 0, 0);
    o[d0] = __builtin_amdgcn_mfma_f32_32x32x16_bf16(pa1, PK(1), o[d0], 0, 0, 0);
    o[d0] = __builtin_amdgcn_mfma_f32_32x32x16_bf16(pa2, PK(2), o[d0], 0, 0, 0);
    o[d0] = __builtin_amdgcn_mfma_f32_32x32x16_bf16(pa3, PK(3), o[d0], 0, 0, 0);
#undef PK
  }
}

constexpr int NSLOT = 3, SLOTB = 8192, KSLOTB = 9216;
constexpr int LDS_K = 0, LDS_V = NSLOT * KSLOTB, LDS_WS = LDS_V + NSLOT * SLOTB, LDS_OST = LDS_WS + NW * 64 * 4, LDS_BYTES = LDS_OST + NW * 4096;
#define KOFF(sl) ((sl) + ((sl) >> 3))
#define WB(n0, n1) do { if (wid == 0) { WAIT_BAR(n0); } else { WAIT_BAR(n1); } } while (0)
typedef __attribute__((address_space(3))) unsigned char* lds_ptr;
template <int THRL> __device__ __forceinline__ void fox_unit(int b, int h, int qb, const bf16* __restrict__ QKV, const float* __restrict__ kbias, const u32x4* __restrict__ kb16,
                                                             float sbound, bf16* O, lds_ptr shm, unsigned* qc, volatile __attribute__((address_space(3))) unsigned* qslot) {
  int tid_ = threadIdx.x; asm volatile("" : "+v"(tid_)); const int tid = tid_, lane = tid & 63, r32 = lane & 31, hi = lane >> 5; const int wid = __builtin_amdgcn_readfirstlane(tid >> 6);
  const long rowbase = (long)b * SEQ; const int q0 = qb * QB; const int colq = 1536 + h * D;
  const bf16* Qw = QKV + (rowbase + q0 + wid * QBLK) * DM + colq;
  const bf16* Kh = QKV + rowbase * DM + colq + 512; const bf16* Vh = QKV + rowbase * DM + colq + 1024;
  const float* kbh = kbias + (long)(b * 8 + h) * SEQ; const u32x4* kb16h = kb16 + (long)(b * 8 + h) * SEQ;
  const unsigned lds0 = (unsigned)(uintptr_t)shm;
  __attribute__((address_space(3))) float* wsf = (__attribute__((address_space(3))) float*)(shm + LDS_WS) + wid * 64;
  const int NT = (q0 + QB) / KVBLK;
  int T0 = 0;
  {
    const int tc = 2 * ((lane & 31) + 1);
    const bool valid = (lane < 32) && (tc <= NT - 4);
    const float bk = valid ? kbh[64 * tc - 1] : 0.f, bq = kbh[q0];
    const bool dead = valid && (bk < bq - 150.0f - 2.0f * sbound);
    T0 = 2 * __popcll(__ballot(dead)); }
  T0 = __builtin_amdgcn_readfirstlane(T0);
  const bf16* ksrc = Kh + (long)lane * DM + wid * 8;
  const bf16* vsrc = Vh + (long)(16 * (wid & 3) + (lane >> 2)) * DM + (wid >> 2) * 32 + (lane & 3) * 8;
  const u32x4* asrc = kb16h + lane;
  const unsigned kdst = lds0 + LDS_K + wid * 1024, adst = lds0 + LDS_K + 8192, vdst = lds0 + LDS_V + wid * 1024;
#define DMA_K(t, slot) do { glds16(ksrc + (long)(t) * KVBLK * DM, (unsigned)__builtin_amdgcn_readfirstlane(kdst + KOFF(slot))); \
                            if (wid == 0) glds16(asrc + (long)(t) * KVBLK, (unsigned)__builtin_amdgcn_readfirstlane(adst + KOFF(slot))); } while (0)
#define DMA_V(t, slot) glds16(vsrc + (long)(t) * KVBLK * DM, (unsigned)__builtin_amdgcn_readfirstlane(vdst + (slot)))
  const lds_cptr shm3 = (lds_cptr)shm; const lds_cptr kp0 = shm3 + LDS_K + hi * 1024 + r32 * 16; const lds_cptr ka0 = shm3 + LDS_K + 8192 + r32 * 16;
  const lds_cptr vp0 = shm3 + LDS_V + ((lane >> 4) & 1) * 32 + (lane & 3) * 8 + (4 * hi + ((lane & 15) >> 2)) * 64;
  const int vb0 = (int)(lds0 + LDS_V) + ((lane >> 4) & 1) * 32 + (lane & 3) * 8 + (4 * hi + ((lane & 15) >> 2)) * 64;
  bf16x8 kf[8], ka[2];
#define ALOAD(sl) do { ka[0] = *(const __attribute__((address_space(3))) bf16x8*)(ka0 + KOFF(sl)); ka[1] = *(const __attribute__((address_space(3))) bf16x8*)(ka0 + KOFF(sl) + 512); } while (0)
  DMA_K(T0, 0); DMA_V(T0, 0); DMA_K(T0 + 1, SLOTB);
  bf16x8 qr[4];
#pragma unroll
  for (int d0 = 0; d0 < 4; ++d0) qr[d0] = *reinterpret_cast<const bf16x8*>(&Qw[(long)r32 * DM + d0 * 16 + hi * 8]);
  const short one = hi ? (short)0 : (short)0x3F80;
  bf16x8 qa = (bf16x8){one, one, one, 0, 0, 0, 0, 0}; asm volatile("" : "+v"(qa));
  float l_reg = 0.f; f32x16 o[2]; o[0] = f32x16{}; o[1] = f32x16{};
  const int qrel = wid * QBLK + r32;
  f32x16 negm; { const float nb = -(kbh[q0 + qrel] + fmaxf(sbound - 40.0f, 0.0f));
    _Pragma("unroll") for (int r = 0; r < 16; ++r) negm[r] = nb; } asm volatile("" : "+v"(negm));
#define CMASK(P0, P1, t) do { int jb_ = (t) - (NT - 4); if (jb_ >= 0) cmask(P0, P1, jb_, qrel, hi); } while (0)
#define START(P0, P1) do { _Pragma("unroll") for (int r = 0; r < 16; ++r) P0[r] = __builtin_amdgcn_exp2f(P0[r]); } while (0)
#define RESC() do {} while (0)
  f32x16 pA0, pA1, pB0, pB1;
  int sl_prev = 0, sl_cur = 0, sl_next = SLOTB;
#define ROT() do { sl_prev = sl_cur; sl_cur = sl_next; sl_next = (sl_next == (NSLOT - 1) * SLOTB) ? 0 : sl_next + SLOTB; } while (0)
  DMA_K(T0 + 2, 2 * SLOTB);
  WB(5, 3);
  { kload8(kf, kp0); ALOAD(0);
    pA0 = __builtin_amdgcn_mfma_f32_32x32x16_bf16(kf[0], qr[0], negm, 0, 0, 0); pA1 = __builtin_amdgcn_mfma_f32_32x32x16_bf16(kf[1], qr[0], negm, 0, 0, 0);
    pA0 = __builtin_amdgcn_mfma_f32_32x32x16_bf16(kf[2], qr[1], pA0, 0, 0, 0);  pA1 = __builtin_amdgcn_mfma_f32_32x32x16_bf16(kf[3], qr[1], pA1, 0, 0, 0);
    pA0 = __builtin_amdgcn_mfma_f32_32x32x16_bf16(kf[4], qr[2], pA0, 0, 0, 0);  pA1 = __builtin_amdgcn_mfma_f32_32x32x16_bf16(kf[5], qr[2], pA1, 0, 0, 0);
    pA0 = __builtin_amdgcn_mfma_f32_32x32x16_bf16(kf[6], qr[3], pA0, 0, 0, 0);  pA1 = __builtin_amdgcn_mfma_f32_32x32x16_bf16(kf[7], qr[3], pA1, 0, 0, 0);
    pA0 = __builtin_amdgcn_mfma_f32_32x32x16_bf16(ka[0], qa, pA0, 0, 0, 0);     pA1 = __builtin_amdgcn_mfma_f32_32x32x16_bf16(ka[1], qa, pA1, 0, 0, 0); }
  asm volatile("s_nop 15\n\ts_nop 7" : "+v"(pA0), "+v"(pA1)); CMASK(pA0, pA1, T0);
  START(pA0, pA1);
  _Pragma("unroll") for (int r = 0; r < 16; ++r) pA1[r] = __builtin_amdgcn_exp2f(pA1[r]);
  WAIT_BAR(0);
  DMA_K(T0 + 3, 0); DMA_V(T0 + 1, SLOTB);
  ROT();
  kload8(kf, kp0 + KOFF(sl_cur)); ALOAD(sl_cur);
  WB(3, 2);
  s16x4 vlo[8], vhi[8]; u32x4 pw0, pw1, pw2, pw3;
#define PKW(P, B) cvtpk_s(P[B], P[B + 1])
#define PAF(k) __builtin_bit_cast(bf16x8, pw##k)
#define VFR(i) (bf16x8){vlo[i][0], vlo[i][1], vlo[i][2], vlo[i][3], vhi[i][0], vhi[i][1], vhi[i][2], vhi[i][3]}
#define PIN(x) asm volatile("" : "+v"(x))
#define MX3(a, b, c) __builtin_fmaxf(__builtin_fmaxf((a), (b)), (c))
#define GAPA(MF, A0, A1, A2, A3, W0, W1, PW) do { MF; sacc += A0; sacc += A1; sacc += A2; sacc += A3; PIN(sacc); W0; W1; PIN(PW); SBAR(); } while (0)
#define EX(v) __builtin_amdgcn_exp2f(v)
#define GAPB(MF, X, B) do { MF; X[B] = EX(X[B]); X[B + 1] = EX(X[B + 1]); X[B + 2] = EX(X[B + 2]); X[B + 3] = EX(X[B + 3]); PIN(X); SBAR(); } while (0)
#define VRD(i) do { vlo[i] = vtr(vp_ + (((i) >> 2) * 4096 + ((i) & 3) * 1024)); vhi[i] = vtr(vp_ + (((i) >> 2) * 4096 + ((i) & 3) * 1024 + 512)); } while (0)
#define KRD(G, j) do { if (G) { kload2(kf, kp0 + KOFF(sl_next), j); SBAR(); } } while (0)
#define KRDA(G) do { if (G) { ALOAD(sl_next); SBAR(); } } while (0)
#define STEP(C0, C1, P0, P1, t, GK, GV, GL) do { SBAR(); \
    const lds_cptr vp_ = vp0 + sl_prev; \
    VRD(0); SBAR(); float sacc = (P0[0] + P0[1]); \
    GAPA(C0 = __builtin_amdgcn_mfma_f32_32x32x16_bf16(kf[0], qr[0], negm, 0, 0, 0), P0[2], P0[3], P0[4], P0[5],     pw0[0] = PKW(P0, 0), pw0[1] = PKW(P0, 2), pw0); \
    VRD(4); SBAR(); GAPA(C1 = __builtin_amdgcn_mfma_f32_32x32x16_bf16(kf[1], qr[0], negm, 0, 0, 0), P0[6], P0[7], P0[8], P0[9],     pw0[2] = PKW(P0, 4), pw0[3] = PKW(P0, 6), pw0); \
    VRD(1); SBAR(); GAPA(C0 = __builtin_amdgcn_mfma_f32_32x32x16_bf16(kf[2], qr[1], C0, 0, 0, 0),   P0[10], P0[11], P0[12], P0[13], pw1[0] = PKW(P0, 8), pw1[1] = PKW(P0, 10), pw1); \
    VRD(5); SBAR(); GAPA(C1 = __builtin_amdgcn_mfma_f32_32x32x16_bf16(kf[3], qr[1], C1, 0, 0, 0),   P0[14], P0[15], P1[0], P1[1],   pw1[2] = PKW(P0, 12), pw1[3] = PKW(P0, 14), pw1); \
    VRD(2); SBAR(); GAPA(C0 = __builtin_amdgcn_mfma_f32_32x32x16_bf16(kf[4], qr[2], C0, 0, 0, 0),   P1[2], P1[3], P1[4], P1[5],     pw2[0] = PKW(P1, 0), pw2[1] = PKW(P1, 2), pw2); \
    VRD(6); SBAR(); GAPA(C1 = __builtin_amdgcn_mfma_f32_32x32x16_bf16(kf[5], qr[2], C1, 0, 0, 0),   P1[6], P1[7], P1[8], P1[9],     pw2[2] = PKW(P1, 4), pw2[3] = PKW(P1, 6), pw2); \
    VRD(3); SBAR(); GAPA(C0 = __builtin_amdgcn_mfma_f32_32x32x16_bf16(kf[6], qr[3], C0, 0, 0, 0),   P1[10], P1[11], P1[12], P1[13], pw3[0] = PKW(P1, 8), pw3[1] = PKW(P1, 10), pw3); \
    VRD(7); SBAR(); GAPA(C1 = __builtin_amdgcn_mfma_f32_32x32x16_bf16(kf[7], qr[3], C1, 0, 0, 0),   P1[14], P1[15], 0.f, 0.f,       pw3[2] = PKW(P1, 12), pw3[3] = PKW(P1, 14), pw3); \
    C0 = __builtin_amdgcn_mfma_f32_32x32x16_bf16(ka[0], qa, C0, 0, 0, 0); C1 = __builtin_amdgcn_mfma_f32_32x32x16_bf16(ka[1], qa, C1, 0, 0, 0); SBAR(); \
    l_reg += sacc; \
    if (GK) { DMA_K((t) + 3, sl_cur); } if (GV) { DMA_V((t) + 1, sl_next); } \
    CMASK(C0, C1, t); \
    SBAR(); \
    GAPB(o[0] = __builtin_amdgcn_mfma_f32_32x32x16_bf16(PAF(0), VFR(0), o[0], 0, 0, 0), C0, 0); \
    GAPB(o[1] = __builtin_amdgcn_mfma_f32_32x32x16_bf16(PAF(0), VFR(4), o[1], 0, 0, 0), C0, 4); \
    KRD(GL, 0); GAPB(o[0] = __builtin_amdgcn_mfma_f32_32x32x16_bf16(PAF(1), VFR(1), o[0], 0, 0, 0), C0, 8); \
    KRD(GL, 1); GAPB(o[1] = __builtin_amdgcn_mfma_f32_32x32x16_bf16(PAF(1), VFR(5), o[1], 0, 0, 0), C0, 12); \
    KRD(GL, 2); GAPB(o[0] = __builtin_amdgcn_mfma_f32_32x32x16_bf16(PAF(2), VFR(2), o[0], 0, 0, 0), C1, 0); \
    KRD(GL, 3); GAPB(o[1] = __builtin_amdgcn_mfma_f32_32x32x16_bf16(PAF(2), VFR(6), o[1], 0, 0, 0), C1, 4); \
    KRDA(GL); GAPB(o[0] = __builtin_amdgcn_mfma_f32_32x32x16_bf16(PAF(3), VFR(3), o[0], 0, 0, 0), C1, 8); \
    GAPB(o[1] = __builtin_amdgcn_mfma_f32_32x32x16_bf16(PAF(3), VFR(7), o[1], 0, 0, 0), C1, 12); \
    } while (0)
  int t = T0 + 1;
#undef CMASK
#define CMASK(P0, P1, t) do {} while (0)
  for (; t + 5 < NT; t += 2) {
    STEP(pB0, pB1, pA0, pA1, t, true, true, true);     WB(3, 2); RESC(); ROT();
    STEP(pA0, pA1, pB0, pB1, t + 1, true, true, true); WB(3, 2); RESC(); ROT();
  }
#undef CMASK
#define CMASK(P0, P1, t) do { int jb_ = (t) - (NT - 4); if (jb_ >= 0) cmask(P0, P1, jb_, qrel, hi); } while (0)
#define ENDW(tt) do { if ((tt) + 3 < NT) { WB(3, 2); } else if ((tt) + 2 < NT) { WAIT_BAR(1); } else { WAIT_BAR(0); } } while (0)
  for (; t + 1 < NT; t += 2) {
    STEP(pB0, pB1, pA0, pA1, t, (t + 3 < NT), (t + 1 < NT), (t + 1 < NT));         ENDW(t);     RESC(); ROT();
    STEP(pA0, pA1, pB0, pB1, t + 1, (t + 4 < NT), (t + 2 < NT), (t + 2 < NT));     ENDW(t + 1); RESC(); ROT();
  }
  STEP(pB0, pB1, pA0, pA1, NT - 1, false, false, false); RESC();
  { float sacc = pB0[0] + pB0[1]; _Pragma("unroll") for (int r = 2; r < 16; ++r) sacc += pB0[r]; _Pragma("unroll") for (int r = 0; r < 16; ++r) sacc += pB1[r]; l_reg += sacc;
    pw0 = (u32x4){PKW(pB0, 0), PKW(pB0, 2), PKW(pB0, 4), PKW(pB0, 6)}; pw1 = (u32x4){PKW(pB0, 8), PKW(pB0, 10), PKW(pB0, 12), PKW(pB0, 14)};
    pw2 = (u32x4){PKW(pB1, 0), PKW(pB1, 2), PKW(pB1, 4), PKW(pB1, 6)}; pw3 = (u32x4){PKW(pB1, 8), PKW(pB1, 10), PKW(pB1, 12), PKW(pB1, 14)};
    SBAR(); pvd(o, vb0 + sl_cur, PAF(0), PAF(1), PAF(2), PAF(3)); }
  unsigned nxq = 0u; if (tid == 0) nxq = atomicAdd(qc, 1u);
  { auto rr = __builtin_amdgcn_permlane32_swap(__float_as_uint(l_reg), __float_as_uint(l_reg), false, false); l_reg = __uint_as_float(rr[0]) + __uint_as_float(rr[1]); }
  if (hi == 0) wsf[32 + r32] = l_reg; asm volatile("s_waitcnt lgkmcnt(0)" ::: "memory");
  float rli[16];
#pragma unroll
  for (int r = 0; r < 16; ++r) rli[r] = __builtin_amdgcn_rcpf(wsf[32 + crow(r, hi)]);
  bf16* Ow = O + (rowbase + q0 + wid * QBLK) * OPITCH + (8 + h) * D;
  { __attribute__((address_space(3))) bf16* stg = (__attribute__((address_space(3))) bf16*)(shm + LDS_OST) + wid * 2048;
#pragma unroll
    for (int r = 0; r < 16; ++r) { const int orow = crow(r, hi);
#pragma unroll
      for (int d0 = 0; d0 < 2; ++d0) stg[orow * 64 + d0 * 32 + r32] = (bf16)(cvtpk_s(o[d0][r] * rli[r], 0.f) & 0xffffu); }
    asm volatile("s_waitcnt lgkmcnt(0)" ::: "memory");
#pragma unroll
    for (int i = 0; i < 4; ++i) { const int row = i * 8 + (lane >> 3), ch = lane & 7; const u32x4 v = *(const __attribute__((address_space(3))) u32x4*)(stg + row * 64 + ch * 8); *(u32x4*)(Ow + (long)row * OPITCH + ch * 8) = v; } }
  if (tid == 0) *qslot = nxq;
  asm volatile("s_waitcnt vmcnt(0) lgkmcnt(0)\n\ts_barrier" ::: "memory");
#undef DMA_K
#undef DMA_V
#undef ALOAD
#undef CMASK
#undef START
#undef RESC
#undef ROT
#undef PKW
#undef PAF
#undef VFR
#undef PIN
#undef MX3
#undef GAPA
#undef GAPB
#undef EX
#undef VRD
#undef KRD
#undef KRDA
#undef STEP
#undef ENDW
}
#undef KOFF
#undef SBAR
#undef WAIT_BAR
}
constexpr int NWAVES = 8;
constexpr int BATCH = 8, SEQ = 4096, D = 1024, FF = 2816, M = BATCH * SEQ, NMOD = 9 * D, INW = 3080, NQKV = 3072;
constexpr float EPS = 1e-6f, LOG2E = 1.4426950408889634f;
constexpr size_t MiB = 1u << 20;
constexpr size_t WS_MOD = 0, WS_LF = 1 * MiB, WS_KB = 2 * MiB, WS_CTL = 3 * MiB, WS_W1GU = 4 * MiB, WS_W1D = 16 * MiB, WS_W2GU = 22 * MiB, WS_W2D = 34 * MiB, WS_WIN = 40 * MiB, WS_WO = 46 * MiB, WS_KB16 = 48 * MiB,
                 WS_H = 64 * MiB, WS_ACT = 128 * MiB, WS_X1 = 320 * MiB, WS_END = 384 * MiB;
constexpr int RING_BYTES = 131072, MISC_OFF = RING_BYTES + 320, LDS_BYTES = 147456;
static_assert(att::L_BYTES <= RING_BYTES && fox::LDS_BYTES <= RING_BYTES, "attention LDS");
#define LAS __attribute__((address_space(3)))
typedef unsigned short bf16;
typedef unsigned v4u __attribute__((ext_vector_type(4)));
typedef unsigned v2u __attribute__((ext_vector_type(2)));
typedef float f32x4 __attribute__((ext_vector_type(4)));
__device__ __forceinline__ unsigned f2bf(float f) { unsigned u = __builtin_bit_cast(unsigned, f); return (u + 0x7fffu + ((u >> 16) & 1u)) >> 16; }
__device__ __forceinline__ unsigned pk2(float lo, float hi) { return f2bf(lo) | (f2bf(hi) << 16); }
__device__ __forceinline__ float wave_sum(float v) {
#pragma unroll
    for (int o = 1; o < 64; o <<= 1) v += __shfl_xor(v, o);
    return v;
}
struct Params {
    const float *x, *c, *w_mod, *b_mod, *g_ffn1, *w1_gate, *w1_up, *w1_down, *g_mix, *w_in, *b_f, *g_q, *g_k, *w_o, *g_ffn2, *w2_gate, *w2_up, *w2_down;
    float* out; unsigned char* ws;
};
__device__ __forceinline__ void transpose_item(const float* W, int K, int ldw, bf16* WT, int k0, int n0, int dst_n0, LAS float* scr, int lane) {
#pragma unroll
    for (int i = 0; i < 32; ++i) { const int kk = 2 * i + (lane >> 5); scr[kk * 33 + (lane & 31)] = W[(size_t)(k0 + kk) * ldw + n0 + (lane & 31)]; }
    asm volatile("s_waitcnt lgkmcnt(0)" ::: "memory");
    const int c = lane & 7;
#pragma unroll
    for (int j = 0; j < 4; ++j) { const int n = (lane >> 3) + 8 * j; const LAS float* s = scr + (8 * c) * 33 + n;
        v4u o; o.x = pk2(s[0 * 33], s[1 * 33]); o.y = pk2(s[2 * 33], s[3 * 33]); o.z = pk2(s[4 * 33], s[5 * 33]); o.w = pk2(s[6 * 33], s[7 * 33]);
        *(v4u*)(WT + (size_t)(dst_n0 + n) * K + k0 + 8 * c) = o; }
    asm volatile("s_waitcnt lgkmcnt(0)" ::: "memory");
}
__device__ __forceinline__ int dst_row_block(int mode, int n0) {
    if (mode == 1) return 256 * (n0 >> 7) + (n0 & 127);
    if (mode == 2) return 256 * (n0 >> 7) + 128 + (n0 & 127);
    if (mode == 3) { const int pn = n0 >> 8, wc = (n0 >> 6) & 3, bj = (n0 >> 5) & 1; return 256 * pn + 128 * bj + 32 * wc; }
    return n0;
}
__device__ __forceinline__ void convert_matrix(const float* W, int K, int ldw, int N, bf16* WT, int mode, int& base, int gw, int NGW, LAS float* scr, int lane) {
    const int nblk = N / 32, items = (K / 64) * nblk;
    int first = (gw - base % NGW + NGW) % NGW;
    for (int it = first; it < items; it += NGW) { const int kb = it / nblk, nb = it % nblk; transpose_item(W, K, ldw, WT, 64 * kb, 32 * nb, dst_row_block(mode, 32 * nb), scr, lane); }
    base += items;
}
__device__ __forceinline__ void mod_item(const Params& p, int nb, LAS unsigned char* lds, int tid) {
    LAS float* sc = (LAS float*)lds;
    LAS float* red = (LAS float*)(lds + 32768);
    for (int i = tid; i < 8192; i += 512) { const int k = i >> 3, b = i & 7; const float v = p.c[b * D + k]; sc[i] = v / (1.0f + __expf(-v)); }
    __syncthreads();
    const int kg = tid >> 3, cgp = tid & 7; const int col = nb * 32 + 4 * cgp;
    f32x4 acc[8];
#pragma unroll
    for (int b = 0; b < 8; ++b) acc[b] = (f32x4){0.f, 0.f, 0.f, 0.f};
#pragma unroll
    for (int kk = 0; kk < 16; ++kk) { const int k = kg * 16 + kk; const f32x4 w = *(const f32x4*)(p.w_mod + (size_t)k * NMOD + col);
        const f32x4 s0 = *(const LAS f32x4*)(sc + k * 8), s1 = *(const LAS f32x4*)(sc + k * 8 + 4);
        acc[0] += w * s0[0]; acc[1] += w * s0[1]; acc[2] += w * s0[2]; acc[3] += w * s0[3]; acc[4] += w * s1[0]; acc[5] += w * s1[1]; acc[6] += w * s1[2]; acc[7] += w * s1[3]; }
#pragma unroll
    for (int b = 0; b < 8; ++b) *(LAS f32x4*)(red + (kg * 8 + b) * 32 + 4 * cgp) = acc[b];
    __syncthreads();
    if (tid < 256) { const int b = tid >> 5, cc = tid & 31; float s = p.b_mod[nb * 32 + cc];
#pragma unroll 16
        for (int g = 0; g < 64; ++g) s += red[(g * 8 + b) * 32 + cc];
        ((float*)(p.ws + WS_MOD))[b * NMOD + nb * 32 + cc] = s; }
    __syncthreads();
}
template <bool FOXF, bool XB16>
__device__ __forceinline__ void norm_phase(const Params& p, const void* X, const float* g, int sh_off, int sc_off, bf16* H, LAS unsigned char* lds, int gw, int NGW, int lane, int tid) {
    LAS float* wf = (LAS float*)lds;
    if (FOXF) { for (int i = tid; i < 8192; i += 512) wf[i] = p.w_in[(size_t)(i >> 3) * INW + NQKV + (i & 7)]; __syncthreads(); }
    const float* mod = (const float*)(p.ws + WS_MOD);
    for (int m0 = gw * 16; m0 < M; m0 += NGW * 16) {
    const int b = m0 / SEQ;
    f32x4 a[4], sh[4];
#pragma unroll
    for (int j = 0; j < 4; ++j) { const int col = 4 * lane + 256 * j; const f32x4 gv = *(const f32x4*)(g + col), sv = *(const f32x4*)(mod + (size_t)b * NMOD + sc_off + col);
        a[j] = gv * (sv + 1.0f); sh[j] = *(const f32x4*)(mod + (size_t)b * NMOD + sh_off + col); }
    for (int r4 = 0; r4 < 16; r4 += 4) {
        v2u rb[4][4]; f32x4 rf[4][4];
#pragma unroll
        for (int q = 0; q < 4; ++q)
#pragma unroll
            for (int j = 0; j < 4; ++j) {
                if (XB16) rb[q][j] = *(const v2u*)((const bf16*)X + (size_t)(m0 + r4 + q) * D + 4 * lane + 256 * j);
                else rf[q][j] = *(const f32x4*)((const float*)X + (size_t)(m0 + r4 + q) * D + 4 * lane + 256 * j); }
#pragma unroll
        for (int q = 0; q < 4; ++q) { const int m = m0 + r4 + q;
        f32x4 v[4]; float ss = 0.f;
#pragma unroll
        for (int j = 0; j < 4; ++j) {
            if (XB16) { const v2u w = rb[q][j]; v[j] = (f32x4){__uint_as_float(w.x << 16), __uint_as_float(w.x & 0xffff0000u), __uint_as_float(w.y << 16), __uint_as_float(w.y & 0xffff0000u)}; }
            else v[j] = rf[q][j];
            ss += (v[j].x * v[j].x + v[j].y * v[j].y) + (v[j].z * v[j].z + v[j].w * v[j].w); }
        const float rstd = __builtin_amdgcn_rsqf(wave_sum(ss) * (1.0f / D) + EPS);
#pragma unroll
        for (int j = 0; j < 4; ++j) { v[j] = v[j] * rstd * a[j] + sh[j];
            v2u o; o.x = pk2(v[j].x, v[j].y); o.y = pk2(v[j].z, v[j].w); *(v2u*)(H + (size_t)m * D + 4 * lane + 256 * j) = o; }
        if (FOXF) { float f[8];
#pragma unroll
            for (int qq = 0; qq < 8; ++qq) f[qq] = 0.f;
#pragma unroll
            for (int j = 0; j < 4; ++j)
#pragma unroll
                for (int e_ = 0; e_ < 4; ++e_) { const LAS float* wr = wf + (4 * lane + 256 * j + e_) * 8; const f32x4 w0 = *(const LAS f32x4*)wr, w1 = *(const LAS f32x4*)(wr + 4); const float hv = v[j][e_];
                    f[0] += hv * w0[0]; f[1] += hv * w0[1]; f[2] += hv * w0[2]; f[3] += hv * w0[3]; f[4] += hv * w1[0]; f[5] += hv * w1[1]; f[6] += hv * w1[2]; f[7] += hv * w1[3]; }
#pragma unroll
            for (int i = 0; i < 4; ++i) { const float snd = (lane & 1) ? f[i] : f[i + 4], kp = (lane & 1) ? f[i + 4] : f[i]; f[i] = kp + __shfl_xor(snd, 1); }
#pragma unroll
            for (int i = 0; i < 2; ++i) { const float snd = (lane & 2) ? f[i] : f[i + 2], kp = (lane & 2) ? f[i + 2] : f[i]; f[i] = kp + __shfl_xor(snd, 2); }
            { const float snd = (lane & 4) ? f[0] : f[1], kp = (lane & 4) ? f[1] : f[0]; f[0] = kp + __shfl_xor(snd, 4); }
            f[0] += __shfl_xor(f[0], 8); f[0] += __shfl_xor(f[0], 16); f[0] += __shfl_xor(f[0], 32);
            const int jidx = ((lane >> 2) & 1) + 2 * ((lane >> 1) & 1) + 4 * (lane & 1);
            if (lane < 8) { const float z = f[0] + p.b_f[jidx]; const float ls = fminf(z, 0.f) - log1pf(__expf(-fabsf(z))); ((float*)(p.ws + WS_LF))[(size_t)m * 8 + jidx] = ls; } }
        }
    }
    }
}
__device__ __forceinline__ void cumsum_item(const Params& p, int bh, LAS unsigned char* lds, int tid, int lane, int wave) {
    const float* LF = (const float*)(p.ws + WS_LF); float* KB = (float*)(p.ws + WS_KB);
    LAS float* wt = (LAS float*)lds;
    const int b = bh >> 3, h = bh & 7, s0 = tid * 8;
    float v[8]; float run = 0.f;
#pragma unroll
    for (int i = 0; i < 8; ++i) { run += LF[((size_t)b * SEQ + s0 + i) * 8 + h]; v[i] = run; }
    float inc = run;
    for (int o = 1; o < 64; o <<= 1) { const float t = __shfl_up(inc, o); if (lane >= o) inc += t; }
    if (lane == 63) wt[wave] = inc;
    __syncthreads();
    float pre = inc - run;
    for (int w = 0; w < wave; ++w) pre += wt[w];
    v4u* KB16 = (v4u*)(p.ws + WS_KB16);
#pragma unroll
    for (int i = 0; i < 8; ++i) { const float bv = -(pre + v[i]) * LOG2E; KB[(size_t)bh * SEQ + s0 + i] = bv;
        const unsigned h_ = f2bf(bv); const float r1 = bv - __uint_as_float(h_ << 16); const unsigned m_ = f2bf(r1); const float r2 = r1 - __uint_as_float(m_ << 16); const unsigned l_ = f2bf(r2);
        KB16[(size_t)bh * SEQ + s0 + i] = (v4u){h_ | (m_ << 16), l_, 0u, 0u}; }
    __syncthreads();
}

typedef __attribute__((address_space(1))) unsigned gu32;
#define XB_TMO      128
#define XB_XCNT(j)  (256  + 64 * (j))
#define XB_XSUB(j)  (1280 + 64 * (j))
#define XB_XGEN(j)  (2304 + 64 * (j))
#define XB_TOP      3328
#define XB_TOPGEN   3392
#define XCD_BAR_WORDS 3456
#define XB_SPIN_CAP (1u << 18)

__device__ __forceinline__ unsigned xb_ld(unsigned* p)              { return __hip_atomic_load(p, __ATOMIC_RELAXED, __HIP_MEMORY_SCOPE_AGENT); }
__device__ __forceinline__ unsigned xb_add(unsigned* p, unsigned v) { return __hip_atomic_fetch_add(p, v, __ATOMIC_RELAXED, __HIP_MEMORY_SCOPE_AGENT); }
__device__ __forceinline__ unsigned xb_xcc_id() { return (unsigned)__builtin_amdgcn_s_getreg((3 << 11) | 20) & 0xFu; }
#define XB_SPIN(cond, bar) do { unsigned _sp = 0; while (cond) { __builtin_amdgcn_s_sleep(1); \
    if ((++_sp & 255u) == 0u) { if (xb_ld(&(bar)[XB_TMO])) break; if (_sp > XB_SPIN_CAP) { atomicAdd(&(bar)[XB_TMO], 1u); break; } } } } while (0)

struct XcdBarrier {
    unsigned* bar; unsigned x;
    volatile LAS unsigned* st;
};

__device__ __forceinline__ XcdBarrier xcd_barrier_post(unsigned* bar, volatile LAS unsigned* st) {
    XcdBarrier b; b.bar = bar; b.x = xb_xcc_id(); b.st = st;
    if (threadIdx.x == 0) (void)xb_add(&bar[XB_XCNT(b.x)], 1u);
    return b;
}
__device__ __forceinline__ void xcd_barrier_complete(unsigned* bar, unsigned x, unsigned& nloc, unsigned& nx) {
    const unsigned G = gridDim.x * gridDim.y * gridDim.z;
    unsigned sum, cnt, mine, sp = 0u;
    for (;;) {
        sum = 0u; cnt = 0u; mine = 0u;
#pragma unroll
        for (unsigned j = 0; j < 16; ++j) { const unsigned c = xb_ld(&bar[XB_XCNT(j)]); sum += c; cnt += (c > 0u) ? 1u : 0u; mine = (j == x) ? c : mine; }
        if (sum == G) break;
        __builtin_amdgcn_s_sleep(1);
        if ((++sp & 255u) == 0u) { if (xb_ld(&bar[XB_TMO])) break; if (sp > XB_SPIN_CAP) { atomicAdd(&bar[XB_TMO], 1u); break; } }
    }
    nloc = mine > 0u ? mine : 1u; nx = cnt > 0u ? cnt : 1u;
}

__device__ __forceinline__ void xcd_barrier(const XcdBarrier& b) {
    asm volatile("s_waitcnt vmcnt(0)" ::: "memory");
    __syncthreads();
    if (threadIdx.x == 0) {
        unsigned* bar = b.bar;
        __builtin_amdgcn_s_waitcnt(0);
        unsigned nloc = b.st[0], nx = b.st[1];
        if (nloc == 0u) { xcd_barrier_complete(bar, b.x, nloc, nx); b.st[0] = nloc; b.st[1] = nx; }
        const unsigned old = xb_add(&bar[XB_XSUB(b.x)], 1u);
        const unsigned gen = old / nloc;
        if (old + 1u == (gen + 1u) * nloc) {
            __builtin_amdgcn_fence(__ATOMIC_RELEASE, "agent");
            asm volatile("s_waitcnt vmcnt(0)" ::: "memory");
            const unsigned og = xb_add(&bar[XB_TOP], 1u);
            const unsigned tg = og / nx;
            if (og + 1u == (tg + 1u) * nx) xb_add(&bar[XB_TOPGEN], 1u);
            else XB_SPIN(xb_ld(&bar[XB_TOPGEN]) == tg, bar);
            __builtin_amdgcn_fence(__ATOMIC_ACQUIRE, "agent");
            xb_add(&bar[XB_XGEN(b.x)], 1u);
            asm volatile("s_waitcnt vmcnt(0)" ::: "memory");
        } else {
            XB_SPIN(xb_ld(&bar[XB_XGEN(b.x)]) == gen, bar);
            __builtin_amdgcn_fence(__ATOMIC_ACQUIRE, "agent");
            asm volatile("s_waitcnt vmcnt(0)" ::: "memory");
        }
    }
    __syncthreads();
}

#ifndef RESID_ALIGN
#define RESID_ALIGN true
#endif
#ifndef FOX_PIPE
#define FOX_PIPE 1
#endif
#ifndef DUP_MISC
#define DUP_MISC 0
#endif
#ifndef DUP_ATT_FOX
#define DUP_ATT_FOX 0
#endif
#ifndef DUP_ATT_SB
#define DUP_ATT_SB 1
#endif
#ifndef DUP_GU
#define DUP_GU 0
#endif
#ifndef DUP_D1
#define DUP_D1 0
#endif
#ifndef DUP_SYNC
#define DUP_SYNC 0
#endif
__global__ void __launch_bounds__(NWAVES * 64, 2) hymba_fwd(Params p) {
    extern __shared__ __attribute__((aligned(16))) unsigned char lds_raw[];
    LAS unsigned char* lds = (LAS unsigned char*)lds_raw;
    cg::grid_group grid = cg::this_grid();
    const int wave = __builtin_amdgcn_readfirstlane((int)threadIdx.x >> 6);
    const int G = gridDim.x, bx = blockIdx.x;
#define FRESH_TID() int tid = threadIdx.x; asm volatile("" : "+v"(tid)); const int lane = tid & 63
    const int vcu = (G % 8 == 0) ? (bx % 8) * (G / 8) + bx / 8 : bx;
    const int gw = vcu * NWAVES + wave, NGW = G * NWAVES;
    unsigned char* ws = p.ws;
    volatile LAS unsigned* MISC = (volatile LAS unsigned*)(lds + MISC_OFF);
    if (threadIdx.x < 32) MISC[threadIdx.x] = 0u;
    unsigned* barw = (unsigned*)(ws + WS_CTL);
    __syncthreads();
    XcdBarrier xbar = xcd_barrier_post(barw, MISC + 8);
    if (ws == nullptr) grid.sync();
    float* mod = (float*)(ws + WS_MOD);
    bf16 *W1GU = (bf16*)(ws + WS_W1GU), *W1D = (bf16*)(ws + WS_W1D), *W2GU = (bf16*)(ws + WS_W2GU), *W2D = (bf16*)(ws + WS_W2D), *WIN = (bf16*)(ws + WS_WIN), *WO = (bf16*)(ws + WS_WO);
    bf16 *H = (bf16*)(ws + WS_H), *ACT = (bf16*)(ws + WS_ACT), *X1 = (bf16*)(ws + WS_X1);

    for (int rep_ = 0; rep_ < 1 + DUP_MISC; ++rep_)
    { FRESH_TID(); for (int nb = bx; nb < NMOD / 32; nb += G) mod_item(p, nb, lds, tid);
      LAS float* scr = (LAS float*)(lds + wave * 16384); int base = 0;
      convert_matrix(p.w1_gate, D, FF, FF, W1GU, 1, base, gw, NGW, scr, lane);
      convert_matrix(p.w1_up, D, FF, FF, W1GU, 2, base, gw, NGW, scr, lane);
      convert_matrix(p.w1_down, FF, D, D, W1D, 0, base, gw, NGW, scr, lane);
      convert_matrix(p.w_in, D, INW, NQKV, WIN, 3, base, gw, NGW, scr, lane);
      convert_matrix(p.w_o, D, D, D, WO, 0, base, gw, NGW, scr, lane);
      convert_matrix(p.w2_gate, D, FF, FF, W2GU, 1, base, gw, NGW, scr, lane);
      convert_matrix(p.w2_up, D, FF, FF, W2GU, 2, base, gw, NGW, scr, lane);
      convert_matrix(p.w2_down, FF, D, D, W2D, 0, base, gw, NGW, scr, lane); }
    xcd_barrier(xbar);
    for (int rep_ = 0; rep_ < 10 * DUP_SYNC; ++rep_) xcd_barrier(xbar);
    for (int rep_ = 0; rep_ < 1 + DUP_MISC; ++rep_)
    { FRESH_TID(); norm_phase<false, false>(p, p.x, p.g_ffn1, 0 * D, 1 * D, H, lds, gw, NGW, lane, tid); }
    xcd_barrier(xbar);
    for (int rep_ = 0; rep_ < 1 + DUP_GU; ++rep_)
    { pg8::Gemm g{H, W1GU, M, 2 * FF, D}; pg8::StaticOrder S; S.init(M, 2 * FF, G, bx); pg8::EpiSwiGLU E{ACT, FF};
      pg8::gemm_phase<pg8::EpiSwiGLU, pg8::StaticOrder, true, true>(lds, g, S, E); }
    xcd_barrier(xbar);
    for (int rep_ = 0; rep_ < 1 + DUP_D1; ++rep_)
    { pg8::Gemm g{ACT, W1D, M, D, FF}; pg8::StaticOrder S; S.init(M, D, G, bx); pg8::EpiResid<false, true> E{p.x, X1, mod + 2 * D, 0.5f};
      pg8::gemm_phase<pg8::EpiResid<false, true>, pg8::StaticOrder, RESID_ALIGN, true>(lds, g, S, E); }
    xcd_barrier(xbar);
    for (int rep_ = 0; rep_ < 1 + DUP_MISC; ++rep_)
    { FRESH_TID(); norm_phase<true, true>(p, X1, p.g_mix, 3 * D, 4 * D, H, lds, gw, NGW, lane, tid); }
    xcd_barrier(xbar);
    if (bx < 64) { FRESH_TID(); cumsum_item(p, bx, lds, tid, lane, wave); }
    { pg8::Gemm g{H, WIN, M, NQKV, D}; pg8::StaticOrder S; S.init(M, NQKV, G, bx); pg8::EpiQKV E{ACT, p.g_q, p.g_k, 0.125f * LOG2E};
      pg8::gemm_phase<pg8::EpiQKV, pg8::StaticOrder, true, true>(lds, g, S, E); }
    xcd_barrier(xbar);
    { const float* KB = (const float*)(ws + WS_KB); unsigned* qctr = (unsigned*)(ws + WS_CTL + 65536);
      { FRESH_TID(); float a = fabsf(p.g_q[wave * 64 + lane]), c = fabsf(p.g_k[wave * 64 + lane]);
#pragma unroll
        for (int o_ = 1; o_ < 64; o_ <<= 1) { a = fmaxf(a, __shfl_xor(a, o_)); c = fmaxf(c, __shfl_xor(c, o_)); }
        if (lane == 0) MISC[24 + wave] = __float_as_uint(64.0f * 0.125f * LOG2E * a * c * 1.02f + 0.5f); }
      const unsigned home = xbar.x & 7u;
      for (unsigned kq = 0; kq < 8u; ++kq) {
          const unsigned qi = (home + kq) & 7u; unsigned* qc = qctr + 64 * qi;
          if (threadIdx.x == 0) MISC[16] = atomicAdd(qc, 1u);
          __syncthreads();
          for (;;) {
              const unsigned u = MISC[16];
              if (u >= 256u) break;
              const int kind = (u < 128u) ? 1 : 0, v = u & 127, qb = 15 - (v >> 3), b = (int)qi, h = v & 7;
              const float sbound = __uint_as_float(MISC[24 + h]);
              if (kind) fox::fox_unit<8>(b, h, qb, ACT, KB, (const fox::u32x4*)(ws + WS_KB16), sbound, H, lds, qc, MISC + 16);
              else att::attn_unit<false>(b, h, qb, ACT, KB, p.g_q, p.g_k, H, lds, qc, MISC + 16);
          }
          __syncthreads();
      } }
    xcd_barrier(xbar);
    { pg8::Gemm g{H, WO, M, D, D}; pg8::StaticOrder S; S.init(M, D, G, bx); pg8::EpiResid<true, true> E{X1, X1, mod + 5 * D, 1.0f};
      pg8::gemm_phase<pg8::EpiResid<true, true>, pg8::StaticOrder, RESID_ALIGN, true>(lds, g, S, E); }
    xcd_barrier(xbar);
    for (int rep_ = 0; rep_ < 1 + DUP_MISC; ++rep_)
    { FRESH_TID(); norm_phase<false, true>(p, X1, p.g_ffn2, 6 * D, 7 * D, H, lds, gw, NGW, lane, tid); }
    xcd_barrier(xbar);
    { pg8::Gemm g{H, W2GU, M, 2 * FF, D}; pg8::StaticOrder S; S.init(M, 2 * FF, G, bx); pg8::EpiSwiGLU E{ACT, FF};
      pg8::gemm_phase<pg8::EpiSwiGLU, pg8::StaticOrder, true, true>(lds, g, S, E); }
    xcd_barrier(xbar);
    { pg8::Gemm g{ACT, W2D, M, D, FF}; pg8::StaticOrder S; S.init(M, D, G, bx); pg8::EpiResid<true, false> E{X1, p.out, mod + 8 * D, 0.5f};
      pg8::gemm_phase<pg8::EpiResid<true, false>, pg8::StaticOrder, RESID_ALIGN, true>(lds, g, S, E); }
}

extern "C" void kernel_launch(void* const* d_in, const int* in_sizes, int n_in, void* d_out, int out_size, void* d_ws, size_t ws_size, hipStream_t stream) {
    static int grid = 0;
    if (grid == 0) {
        if (n_in != 18 || in_sizes[0] != M * D || out_size != M * D || ws_size < WS_END) { fprintf(stderr, "kernel_launch: unexpected shapes (n_in %d, in0 %d, out %d, ws %zu)\n", n_in, n_in > 0 ? in_sizes[0] : -1, out_size, ws_size); grid = -1; return; }
        int dev = 0, cus = 0, per_cu = 0;
        (void)hipGetDevice(&dev); (void)hipDeviceGetAttribute(&cus, hipDeviceAttributeMultiprocessorCount, dev);
        if (hipFuncSetAttribute((const void*)hymba_fwd, hipFuncAttributeMaxDynamicSharedMemorySize, LDS_BYTES) != hipSuccess) { fprintf(stderr, "kernel_launch: hipFuncSetAttribute failed\n"); grid = -1; return; }
        if (hipOccupancyMaxActiveBlocksPerMultiprocessor(&per_cu, (const void*)hymba_fwd, NWAVES * 64, LDS_BYTES) != hipSuccess || per_cu < 1) { fprintf(stderr, "kernel_launch: occupancy query says %d\n", per_cu); per_cu = 1; }
        (void)hipGetLastError();
        grid = cus * per_cu;
    }
    if (grid < 0) return;
    if (hipMemsetAsync((char*)d_ws + WS_CTL, 0, 131072, stream) != hipSuccess) { fprintf(stderr, "kernel_launch: memset of control words failed\n"); return; }
    Params p{};
    const float** pp = (const float**)&p;
    for (int i = 0; i < 18; ++i) pp[i] = (const float*)d_in[i];
    p.out = (float*)d_out; p.ws = (unsigned char*)d_ws;
    void* args[] = {&p};
    hipError_t e = hipLaunchCooperativeKernel((const void*)hymba_fwd, dim3(grid), dim3(NWAVES * 64), args, LDS_BYTES, stream);
    if (e != hipSuccess) fprintf(stderr, "cooperative launch failed: %s (grid %d)\n", hipGetErrorString(e), grid);
}
```

```cpp
#include <hip/hip_runtime.h>
#include <hip/hip_cooperative_groups.h>
#include <hip/hip_bf16.h>
#include <cstdio>
#include <cstdint>
#include <cmath>
namespace cg = cooperative_groups;
namespace pg8 {
#define PG8_LAS __attribute__((address_space(3)))
typedef unsigned short bf16_t;
typedef short bf16x8 __attribute__((ext_vector_type(8)));
typedef float f32x4 __attribute__((ext_vector_type(4)));
typedef unsigned u32x4 __attribute__((ext_vector_type(4)));
constexpr int BM = 256, BK = 64, HALF = 128, HTB = HALF * BK * 2  , STAGE_BYTES = 8 * HTB, NXCD = 8, WGM = 8;

__host__ __device__ __forceinline__ int lds_byte(int r, int c) { const int st = (r >> 4) * 2 + (c >> 5), rr = r & 15, cc = c & 31, ob = rr * 64 + cc * 2; return st * 1024 + (ob ^ (((ob >> 9) & 1) << 5)); }
__host__ __device__ __forceinline__ void stage_rc(int b, int& R, int& C) { const int st = b / 1024, sb = b % 1024, swz = sb ^ (((sb >> 9) & 1) << 5); R = (st >> 1) * 16 + swz / 64; C = (st & 1) * 32 + (swz % 64) / 2; }
__host__ __device__ __forceinline__ int perm32(int rho) { const int n = rho >> 4, i = rho & 15; return 8 * (i >> 2) + 4 * n + (i & 3); }

struct Unit { int pm, pn; };
struct Gemm { const bf16_t* A; const bf16_t* Bt; int M, N, K; };

struct StaticOrder {
    int nM, nN, nwg, G, c;
    __host__ __device__ void init(int M, int N, int G_, int c_) { nM = M / BM; nN = N / BM; nwg = nM * nN; G = G_; c = c_; }
    __host__ __device__ bool next(int i, Unit& u) const {
        const long L = (long)i * G + c; if (L >= nwg) return false;
        int wgid = (int)L; { const int q = nwg / NXCD, r = nwg % NXCD, xcd = wgid % NXCD, off = wgid / NXCD; wgid = (xcd < r ? xcd * (q + 1) : r * (q + 1) + (xcd - r) * q) + off; }
        const int nig = WGM * nN, gid = wgid / nig, fm = gid * WGM, gsz = (nM - fm) < WGM ? (nM - fm) : WGM;
        u.pm = fm + ((wgid % nig) % gsz); u.pn = (wgid % nig) / gsz; return true;
    }
    __device__ __forceinline__ void a_ready(const Unit&) const {}
    __device__ __forceinline__ void done(const Unit&) const {}
};

__device__ __forceinline__ unsigned cvt_pk_bf16(float lo, float hi) { unsigned r; asm volatile("v_cvt_pk_bf16_f32 %0, %1, %2" : "=v"(r) : "v"(lo), "v"(hi)); return r; }
typedef float f32x2 __attribute__((ext_vector_type(2)));
typedef unsigned u32x2 __attribute__((ext_vector_type(2)));
__device__ __forceinline__ float fast_rcp(float x) { return __builtin_amdgcn_rcpf(x); }
__device__ __forceinline__ float fast_exp2(float x) { return __builtin_amdgcn_exp2f(x); }
struct EpiSwiGLU {
    static constexpr bool PERM = true, AFTER_DRAIN = false;
    bf16_t* O; int ldc;
    __device__ __forceinline__ void operator()(const f32x4 (&acc)[2][2][4][2], const Unit& u, int wr, int wc, int fr, int fq) const {
        const int row0 = u.pm * BM + wr * 64 + fr; const int col0 = u.pn * HALF + wc * 32 + 8 * fq;
#pragma unroll
        for (int ai = 0; ai < 2; ++ai)
#pragma unroll
            for (int m = 0; m < 4; ++m) {
                bf16_t* rowp = O + (size_t)(row0 + ai * HALF + m * 16) * ldc + col0;
                float r[8];
#pragma unroll
                for (int n = 0; n < 2; ++n)
#pragma unroll
                    for (int e = 0; e < 4; ++e) { const float g = acc[ai][0][m][n][e], up = acc[ai][1][m][n][e];
                        const float s = g * fast_rcp(1.0f + fast_exp2(g * -1.4426950408889634f)); r[n * 4 + e] = s * up; }
                u32x4 w; w.x = cvt_pk_bf16(r[0], r[1]); w.y = cvt_pk_bf16(r[2], r[3]); w.z = cvt_pk_bf16(r[4], r[5]); w.w = cvt_pk_bf16(r[6], r[7]);
                *(u32x4*)rowp = w;
            }
    }
};
__device__ __forceinline__ f32x4 bf2f_lo(u32x2 w) { return (f32x4){__uint_as_float(w.x << 16), __uint_as_float(w.x & 0xffff0000u), __uint_as_float(w.y << 16), __uint_as_float(w.y & 0xffff0000u)}; }
template <bool BIN, bool BOUT> struct EpiResid {
    static constexpr bool PERM = true, AFTER_DRAIN = false;
    const void* base; void* out; const float* gate; float mul;
    __device__ __forceinline__ void operator()(const f32x4 (&acc)[2][2][4][2], const Unit& u, int wr, int wc, int fr, int fq) const {
        const int row0 = u.pm * BM + wr * 64 + fr; const int col0 = u.pn * BM + wc * 32 + 8 * fq;
        const float* grow = gate + (size_t)(u.pm >> 4) * 9216 + col0;
        f32x4 gv[2][2];
#pragma unroll
        for (int bj = 0; bj < 2; ++bj)
#pragma unroll
            for (int n = 0; n < 2; ++n) { const f32x4 g = *(const f32x4*)(grow + bj * HALF + 4 * n); gv[bj][n] = (g + 1.0f) * mul; }
        f32x4 (&ac)[2][2][4][2] = const_cast<f32x4 (&)[2][2][4][2]>(acc);
#pragma unroll
        for (int ai = 0; ai < 2; ++ai)
#pragma unroll
            for (int bj = 0; bj < 2; ++bj)
#pragma unroll
                for (int m = 0; m < 4; ++m)
#pragma unroll
                    for (int n = 0; n < 2; ++n) ac[ai][bj][m][n] = ac[ai][bj][m][n] * gv[bj][n];
        asm volatile("" ::: "memory");
        const unsigned lane_el = (unsigned)((wr * 64 + fr) * 1024 + wc * 32 + 8 * fq);
        const size_t tile_el = (size_t)u.pm * BM * 1024 + (size_t)u.pn * BM;
        const char* bb = (const char*)base + tile_el * (BIN ? 2 : 4); char* ob = (char*)out + tile_el * (BOUT ? 2 : 4);
        const unsigned lb = lane_el * (BIN ? 2u : 4u), lo_ = lane_el * (BOUT ? 2u : 4u);
#define RG_EL(ai, m, bj) ((size_t)(((ai) * HALF + (m) * 16) * 1024 + (bj) * HALF))
        if (BIN) {
            u32x4 bw[2][4][2];
#pragma unroll
            for (int ai = 0; ai < 2; ++ai)
#pragma unroll
                for (int m = 0; m < 4; ++m)
#pragma unroll
                    for (int bj = 0; bj < 2; ++bj) bw[ai][m][bj] = *(const u32x4*)(bb + RG_EL(ai, m, bj) * 2 + lb);
            asm volatile("" ::: "memory");
#pragma unroll
            for (int ai = 0; ai < 2; ++ai)
#pragma unroll
                for (int m = 0; m < 4; ++m)
#pragma unroll
                    for (int bj = 0; bj < 2; ++bj) { const u32x4 w_ = bw[ai][m][bj]; const f32x4 b0 = bf2f_lo((u32x2){w_.x, w_.y}), b1 = bf2f_lo((u32x2){w_.z, w_.w});
                        const f32x4 o0 = b0 + ac[ai][bj][m][0], o1 = b1 + ac[ai][bj][m][1];
                        if (BOUT) { u32x4 w; w.x = cvt_pk_bf16(o0[0], o0[1]); w.y = cvt_pk_bf16(o0[2], o0[3]); w.z = cvt_pk_bf16(o1[0], o1[1]); w.w = cvt_pk_bf16(o1[2], o1[3]); *(u32x4*)(ob + RG_EL(ai, m, bj) * 2 + lo_) = w; }
                        else { *(f32x4*)(ob + RG_EL(ai, m, bj) * 4 + lo_) = o0; *(f32x4*)(ob + RG_EL(ai, m, bj) * 4 + lo_ + 16) = o1; } }
        } else {
#pragma unroll
            for (int ai = 0; ai < 2; ++ai) {
                f32x4 bf_[4][2][2];
#pragma unroll
                for (int m = 0; m < 4; ++m)
#pragma unroll
                    for (int bj = 0; bj < 2; ++bj) { const char* bp = bb + RG_EL(ai, m, bj) * 4 + lb; bf_[m][bj][0] = *(const f32x4*)bp; bf_[m][bj][1] = *(const f32x4*)(bp + 16); }
                asm volatile("" ::: "memory");
#pragma unroll
                for (int m = 0; m < 4; ++m)
#pragma unroll
                    for (int bj = 0; bj < 2; ++bj) { const f32x4 o0 = bf_[m][bj][0] + ac[ai][bj][m][0], o1 = bf_[m][bj][1] + ac[ai][bj][m][1];
                        if (BOUT) { u32x4 w; w.x = cvt_pk_bf16(o0[0], o0[1]); w.y = cvt_pk_bf16(o0[2], o0[3]); w.z = cvt_pk_bf16(o1[0], o1[1]); w.w = cvt_pk_bf16(o1[2], o1[3]); *(u32x4*)(ob + RG_EL(ai, m, bj) * 2 + lo_) = w; }
                        else { *(f32x4*)(ob + RG_EL(ai, m, bj) * 4 + lo_) = o0; *(f32x4*)(ob + RG_EL(ai, m, bj) * 4 + lo_ + 16) = o1; } }
                asm volatile("" ::: "memory");
            }
        }
#undef RG_EL
    }
};
struct EpiQKV {
    static constexpr bool PERM = true, AFTER_DRAIN = false;
    bf16_t* O; const float* gq; const float* gk; float qscale;
    __device__ __forceinline__ void operator()(const f32x4 (&acc)[2][2][4][2], const Unit& u, int wr, int wc, int fr, int fq) const {
        const int seg = u.pn >> 1, head = (u.pn & 1) * 4 + wc;
        const int row0 = u.pm * BM + wr * 64 + fr; const int col0 = u.pn * BM + wc * 64 + 8 * fq;
        const bool nrm = (seg == 3) || (seg == 4);
        const float sc = (seg == 0 || seg == 3) ? qscale : 1.0f;
        f32x4 gv[2][2];
#pragma unroll
        for (int bj = 0; bj < 2; ++bj)
#pragma unroll
            for (int n = 0; n < 2; ++n) { f32x4 g = (f32x4){1.f, 1.f, 1.f, 1.f};
                if (nrm) g = *(const f32x4*)((seg == 3 ? gq : gk) + head * 64 + bj * 32 + 8 * fq + 4 * n);
                gv[bj][n] = g * sc; }
#pragma unroll
        for (int ai = 0; ai < 2; ++ai)
#pragma unroll
            for (int m = 0; m < 4; ++m) {
                float rs = 1.0f;
                if (nrm) { float ss = 0.f;
#pragma unroll
                    for (int bj = 0; bj < 2; ++bj)
#pragma unroll
                        for (int n = 0; n < 2; ++n) { const f32x4 x = acc[ai][bj][m][n]; ss += (x[0] * x[0] + x[1] * x[1]) + (x[2] * x[2] + x[3] * x[3]); }
                    ss += __shfl_xor(ss, 16); ss += __shfl_xor(ss, 32);
                    rs = __builtin_amdgcn_rsqf(ss * (1.0f / 64.0f) + 1e-6f); }
                bf16_t* rowp = O + (size_t)(row0 + ai * HALF + m * 16) * 3072 + col0;
#pragma unroll
                for (int bj = 0; bj < 2; ++bj) { const f32x4 v0 = acc[ai][bj][m][0] * rs * gv[bj][0], v1 = acc[ai][bj][m][1] * rs * gv[bj][1];
                    u32x4 w; w.x = cvt_pk_bf16(v0[0], v0[1]); w.y = cvt_pk_bf16(v0[2], v0[3]); w.z = cvt_pk_bf16(v1[0], v1[1]); w.w = cvt_pk_bf16(v1[2], v1[3]);
                    *(u32x4*)(rowp + bj * 32) = w; }
            }
    }
};
template <class Epi, class Sched, bool ALIGN_EPI = false, bool SP2 = false>
__device__ __forceinline__ void gemm_phase(PG8_LAS unsigned char* lds, const Gemm g, const Sched& S, const Epi& E) {
    int tid_ = threadIdx.x; asm volatile("" : "+v"(tid_)); const int tid = tid_, wid = __builtin_amdgcn_readfirstlane(tid >> 6), lane = tid & 63, wr = wid >> 2, wc = wid & 3, fr = lane & 15, fq = lane >> 4;
    const int K = g.K, nt = K / BK;
    unsigned voffA[2], voffB[2];
#pragma unroll
    for (int i = 0; i < 2; ++i) { int R, C; stage_rc(tid * 16 + i * 8192, R, C); const int Rb = Epi::PERM ? ((R & ~31) + perm32(R & 31)) : R;
        voffA[i] = (unsigned)(R * K + C) * 2u; voffB[i] = (unsigned)(Rb * K + C) * 2u; }
    const size_t kstep = (size_t)(BK * 2);
    const size_t hstep = (size_t)HALF * K * 2;
    const size_t tstep = 2 * hstep;
    const unsigned ldsw = (unsigned)wid * 1024u;
    const int aoff = lds_byte(wr * 64 + fr, fq * 8), boff = lds_byte(wc * 32 + fr, fq * 8);
#define PG8_SA(b, h) (((b) * 2 + (h)) * HTB)
#define PG8_SB(b, h) ((4 + (b) * 2 + (h)) * HTB)
#define PG8_STAGE(bufoff, gbase, voff) do { _Pragma("unroll") for (int _i = 0; _i < 2; ++_i) \
        __builtin_amdgcn_global_load_lds((const unsigned*)((const char*)(gbase) + (voff)[_i]), (PG8_LAS unsigned*)(lds + (bufoff) + ldsw + _i * 8192), 16, 0, 0); } while (0)
#define PG8_LDA(dst, b, h) do { _Pragma("unroll") for (int m = 0; m < 4; ++m) _Pragma("unroll") for (int k = 0; k < 2; ++k) dst[m][k] = *(const PG8_LAS bf16x8*)(lds + PG8_SA(b, h) + aoff + m * 2048 + k * 1024); } while (0)
#define PG8_LDB(dst, b, h) do { _Pragma("unroll") for (int n = 0; n < 2; ++n) _Pragma("unroll") for (int k = 0; k < 2; ++k) dst[n][k] = *(const PG8_LAS bf16x8*)(lds + PG8_SB(b, h) + boff + n * 2048 + k * 1024); } while (0)
#define PG8_MMA(ai, bj, At, Bt) do { __builtin_amdgcn_s_setprio(1); _Pragma("unroll") for (int m = 0; m < 4; ++m) _Pragma("unroll") for (int n = 0; n < 2; ++n) _Pragma("unroll") for (int k = 0; k < 2; ++k) \
        acc[ai][bj][m][n] = __builtin_amdgcn_mfma_f32_16x16x32_bf16(Bt[n][k], At[m][k], acc[ai][bj][m][n], 0, 0, 0); __builtin_amdgcn_s_setprio(0); } while (0)
#define PG8_WAIT_V(n) asm volatile("s_waitcnt vmcnt(" #n ")" ::: "memory")
#define PG8_WAIT_L(n) asm volatile("s_waitcnt lgkmcnt(" #n ")" ::: "memory")
#define PG8_BAR __builtin_amdgcn_s_barrier()
#define PG8_SCHED __builtin_amdgcn_sched_barrier(0)
    Unit cur, nxt; int ui = 0;
    if (!S.next(0, cur)) return;
    f32x4 acc[2][2][4][2];
#pragma unroll
    for (int a = 0; a < 2; ++a)
#pragma unroll
        for (int b = 0; b < 2; ++b)
#pragma unroll
            for (int m = 0; m < 4; ++m)
#pragma unroll
                for (int n = 0; n < 2; ++n) acc[a][b][m][n] = (f32x4){0.f, 0.f, 0.f, 0.f};
    bf16x8 At[4][2], B0[2][2], B1[2][2];
    const char* cA = (const char*)g.A + (size_t)cur.pm * tstep; const char* cB = (const char*)g.Bt + (size_t)cur.pn * tstep;
    S.a_ready(cur);
    if constexpr (SP2) {
        PG8_STAGE(PG8_SB(0, 0), cB, voffB); PG8_STAGE(PG8_SB(0, 1), cB + hstep, voffB); PG8_STAGE(PG8_SA(0, 0), cA, voffA); PG8_STAGE(PG8_SA(0, 1), cA + hstep, voffA);
        if (wr == 1) PG8_BAR;
        PG8_WAIT_V(2); PG8_BAR;
        PG8_STAGE(PG8_SB(1, 0), cB + kstep, voffB); PG8_STAGE(PG8_SA(1, 0), cA + kstep, voffA); PG8_STAGE(PG8_SB(1, 1), cB + hstep + kstep, voffB);
        PG8_WAIT_V(6); PG8_BAR;
    } else {
        PG8_STAGE(PG8_SB(0, 0), cB, voffB); PG8_STAGE(PG8_SA(0, 0), cA, voffA); PG8_STAGE(PG8_SB(0, 1), cB + hstep, voffB); PG8_STAGE(PG8_SA(0, 1), cA + hstep, voffA);
        if (wr == 1) PG8_BAR;
        PG8_WAIT_V(4); PG8_BAR;
        PG8_STAGE(PG8_SB(1, 0), cB + kstep, voffB); PG8_STAGE(PG8_SA(1, 0), cA + kstep, voffA); PG8_STAGE(PG8_SB(1, 1), cB + hstep + kstep, voffB);
        PG8_WAIT_V(6); PG8_BAR;
    }
    for (;;) {
        const bool has_next = S.next(ui + 1, nxt);
        const char* nA = has_next ? (const char*)g.A + (size_t)nxt.pm * tstep : cA; const char* nB = has_next ? (const char*)g.Bt + (size_t)nxt.pn * tstep : cB;
        for (int t = 0; t < nt; t += 2) {
            const bool last = (t == nt - 2);
            const char* a1 = cA + (size_t)(t + 1) * kstep;
            const char* a2 = last ? nA : cA + (size_t)(t + 2) * kstep; const char* b2 = last ? nB : cB + (size_t)(t + 2) * kstep;
            const char* a3 = a2 + kstep; const char* b3 = b2 + kstep;
            if (last && has_next) S.a_ready(nxt);
            if constexpr (SP2) {
            PG8_LDB(B0, 0, 0); PG8_LDB(B1, 0, 1); PG8_SCHED; PG8_LDA(At, 0, 0); PG8_STAGE(PG8_SA(1, 1), a1 + hstep, voffA);
            PG8_WAIT_V(8); PG8_WAIT_L(0); PG8_BAR; PG8_MMA(0, 0, At, B0); PG8_MMA(0, 1, At, B1); PG8_BAR; PG8_SCHED;
            PG8_LDA(At, 0, 1); PG8_STAGE(PG8_SB(0, 0), b2, voffB); PG8_STAGE(PG8_SB(0, 1), b2 + hstep, voffB); PG8_STAGE(PG8_SA(0, 0), a2, voffA);
            PG8_WAIT_V(8); PG8_WAIT_L(0); PG8_BAR; PG8_MMA(1, 0, At, B0); PG8_MMA(1, 1, At, B1); PG8_BAR; PG8_SCHED;
            PG8_LDB(B0, 1, 0); PG8_LDB(B1, 1, 1); PG8_SCHED; PG8_LDA(At, 1, 0); PG8_STAGE(PG8_SA(0, 1), a2 + hstep, voffA);
            PG8_WAIT_V(8); PG8_WAIT_L(0); PG8_BAR; PG8_MMA(0, 0, At, B0); PG8_MMA(0, 1, At, B1); PG8_BAR; PG8_SCHED;
            PG8_LDA(At, 1, 1); PG8_STAGE(PG8_SB(1, 0), b3, voffB); PG8_STAGE(PG8_SB(1, 1), b3 + hstep, voffB); PG8_STAGE(PG8_SA(1, 0), a3, voffA);
            PG8_WAIT_V(8); PG8_WAIT_L(0); PG8_BAR; PG8_MMA(1, 0, At, B0); PG8_MMA(1, 1, At, B1); PG8_BAR; PG8_SCHED;
            } else {
            PG8_LDB(B0, 0, 0); PG8_SCHED; PG8_LDA(At, 0, 0); PG8_STAGE(PG8_SA(1, 1), a1 + hstep, voffA);
            PG8_WAIT_L(8); PG8_BAR; PG8_WAIT_L(0); PG8_MMA(0, 0, At, B0); PG8_BAR; PG8_SCHED;
            PG8_LDB(B1, 0, 1); PG8_STAGE(PG8_SB(0, 0), b2, voffB);
            PG8_BAR; PG8_WAIT_L(0); PG8_MMA(0, 1, At, B1); PG8_BAR;
            PG8_LDA(At, 0, 1); PG8_STAGE(PG8_SA(0, 0), a2, voffA);
            PG8_BAR; PG8_WAIT_L(0); PG8_MMA(1, 0, At, B0); PG8_BAR; PG8_SCHED;
            PG8_STAGE(PG8_SB(0, 1), b2 + hstep, voffB);
            PG8_WAIT_V(6); PG8_BAR; PG8_MMA(1, 1, At, B1); PG8_BAR;
            PG8_LDB(B0, 1, 0); PG8_SCHED; PG8_LDA(At, 1, 0); PG8_STAGE(PG8_SA(0, 1), a2 + hstep, voffA);
            PG8_WAIT_L(8); PG8_BAR; PG8_WAIT_L(0); PG8_MMA(0, 0, At, B0); PG8_BAR; PG8_SCHED;
            PG8_LDB(B1, 1, 1); PG8_STAGE(PG8_SB(1, 0), b3, voffB);
            PG8_BAR; PG8_WAIT_L(0); PG8_MMA(0, 1, At, B1); PG8_BAR;
            PG8_LDA(At, 1, 1); PG8_STAGE(PG8_SA(1, 0), a3, voffA);
            PG8_BAR; PG8_WAIT_L(0); PG8_MMA(1, 0, At, B0); PG8_BAR; PG8_SCHED;
            PG8_STAGE(PG8_SB(1, 1), b3 + hstep, voffB);
            PG8_WAIT_V(6); PG8_BAR; PG8_MMA(1, 1, At, B1); PG8_BAR;
            }
        }
        if constexpr (ALIGN_EPI) { if (wr == 0) PG8_BAR; }
        if constexpr (!Epi::AFTER_DRAIN) { E(acc, cur, wr, wc, fr, fq); S.done(cur); }
        if (!has_next) break;
#pragma unroll
        for (int a = 0; a < 2; ++a)
#pragma unroll
            for (int b = 0; b < 2; ++b)
#pragma unroll
                for (int m = 0; m < 4; ++m)
#pragma unroll
                    for (int n = 0; n < 2; ++n) acc[a][b][m][n] = (f32x4){0.f, 0.f, 0.f, 0.f};
        cur = nxt; cA = nA; cB = nB; ++ui;
        if constexpr (ALIGN_EPI) { if (wr == 1) PG8_BAR; }
    }
    PG8_WAIT_V(0);
    if constexpr (!ALIGN_EPI) { if (wr == 0) PG8_BAR; }
    PG8_BAR;
    if constexpr (Epi::AFTER_DRAIN) { E.fused(acc, cur, wr, wc, fr, fq, lds, wid, lane); S.done(cur); }
#undef PG8_SA
#undef PG8_SB
#undef PG8_STAGE
#undef PG8_LDA
#undef PG8_LDB
#undef PG8_MMA
#undef PG8_WAIT_V
#undef PG8_WAIT_L
#undef PG8_BAR
#undef PG8_SCHED
}
}
namespace att {
#define ALAS __attribute__((address_space(3)))
using bf16 = unsigned short;
using bf16x8 = __attribute__((ext_vector_type(8))) short;
using s16x4 = __attribute__((ext_vector_type(4))) short;
using f32x16 = __attribute__((ext_vector_type(16))) float;
using f32x4 = __attribute__((ext_vector_type(4))) float;
using u32x4 = __attribute__((ext_vector_type(4))) unsigned;
constexpr int SEQ = 4096, PITCH = 3072, OPITCH = 1024, QB = 256, KVBLK = 64;
constexpr int SLOTB = 8192;
constexpr int L_K = 0, L_V = 4 * SLOTB, L_B = 8 * SLOTB, L_WS = L_B + 512, L_FLAG = L_WS + 8 * 256, L_OST = L_FLAG + 64, L_BYTES = L_OST + 8 * 4096;
__device__ __forceinline__ int crow(int r, int hi) { return (r & 3) + 8 * (r >> 2) + 4 * hi; }
__device__ __forceinline__ void glds16(const void* gsrc, unsigned lds_dst) { unsigned keep;
    asm volatile("s_mov_b32 %0, m0\n\ts_mov_b32 m0, %2\n\ts_nop 0\n\tglobal_load_lds_dwordx4 %1, off\n\ts_mov_b32 m0, %0" : "=&s"(keep) : "v"(gsrc), "s"(lds_dst) : "memory"); }
__device__ __forceinline__ void glds4(const void* gsrc, unsigned lds_dst) { unsigned keep;
    asm volatile("s_mov_b32 %0, m0\n\ts_mov_b32 m0, %2\n\ts_nop 0\n\tglobal_load_lds_dword %1, off\n\ts_mov_b32 m0, %0" : "=&s"(keep) : "v"(gsrc), "s"(lds_dst) : "memory"); }
typedef float f32x2_t __attribute__((ext_vector_type(2))); typedef __bf16 bf16x2_t __attribute__((ext_vector_type(2)));
__device__ __forceinline__ unsigned cvtpk_s(float lo, float hi) { f32x2_t v = {lo, hi}; bf16x2_t b = __builtin_convertvector(v, bf16x2_t); return __builtin_bit_cast(unsigned, b); }
#define AWAIT_BAR() asm volatile("s_waitcnt vmcnt(0) lgkmcnt(0)\n\ts_barrier" ::: "memory")
#define ASBAR() __builtin_amdgcn_sched_barrier(0)
struct VFrag { s16x4 lo[8], hi[8]; };
__device__ __forceinline__ void v_issue(VFrag& f, int vb) {
#pragma unroll
    for (int i = 0; i < 8; ++i) {
        asm volatile("ds_read_b64_tr_b16 %0,%1 offset:%c2" : "=&v"(f.lo[i]) : "v"(vb), "i"((i >> 2) * 4096 + (i & 3) * 1024) : "memory");
        asm volatile("ds_read_b64_tr_b16 %0,%1 offset:%c2" : "=&v"(f.hi[i]) : "v"(vb), "i"((i >> 2) * 4096 + (i & 3) * 1024 + 512) : "memory"); }
}
__device__ __forceinline__ void pv_mma(f32x16* o, VFrag& f, bf16x8 pa0, bf16x8 pa1, bf16x8 pa2, bf16x8 pa3) {
    asm volatile("s_waitcnt lgkmcnt(0)" : "+v"(f.lo[0]), "+v"(f.lo[1]), "+v"(f.lo[2]), "+v"(f.lo[3]), "+v"(f.lo[4]), "+v"(f.lo[5]), "+v"(f.lo[6]), "+v"(f.lo[7]),
                                          "+v"(f.hi[0]), "+v"(f.hi[1]), "+v"(f.hi[2]), "+v"(f.hi[3]), "+v"(f.hi[4]), "+v"(f.hi[5]), "+v"(f.hi[6]), "+v"(f.hi[7]) :: "memory");
#define APK2(k) (bf16x8){f.lo[k][0], f.lo[k][1], f.lo[k][2], f.lo[k][3], f.hi[k][0], f.hi[k][1], f.hi[k][2], f.hi[k][3]}
    o[0] = __builtin_amdgcn_mfma_f32_32x32x16_bf16(pa0, APK2(0), o[0], 0, 0, 0); o[1] = __builtin_amdgcn_mfma_f32_32x32x16_bf16(pa0, APK2(4), o[1], 0, 0, 0);
    o[0] = __builtin_amdgcn_mfma_f32_32x32x16_bf16(pa1, APK2(1), o[0], 0, 0, 0); o[1] = __builtin_amdgcn_mfma_f32_32x32x16_bf16(pa1, APK2(5), o[1], 0, 0, 0);
    o[0] = __builtin_amdgcn_mfma_f32_32x32x16_bf16(pa2, APK2(2), o[0], 0, 0, 0); o[1] = __builtin_amdgcn_mfma_f32_32x32x16_bf16(pa2, APK2(6), o[1], 0, 0, 0);
    o[0] = __builtin_amdgcn_mfma_f32_32x32x16_bf16(pa3, APK2(3), o[0], 0, 0, 0); o[1] = __builtin_amdgcn_mfma_f32_32x32x16_bf16(pa3, APK2(7), o[1], 0, 0, 0);
#undef APK2
}
__device__ __forceinline__ void pv(f32x16* o, int vb, bf16x8 pa0, bf16x8 pa1, bf16x8 pa2, bf16x8 pa3) {
#pragma unroll
    for (int d0 = 0; d0 < 2; ++d0) { s16x4 lo[4], hi[4];
#pragma unroll
        for (int ks = 0; ks < 4; ++ks) {
            asm volatile("ds_read_b64_tr_b16 %0,%1 offset:%c2" : "=&v"(lo[ks]) : "v"(vb), "i"(d0 * 4096 + ks * 1024) : "memory");
            asm volatile("ds_read_b64_tr_b16 %0,%1 offset:%c2" : "=&v"(hi[ks]) : "v"(vb), "i"(d0 * 4096 + ks * 1024 + 512) : "memory"); }
        asm volatile("s_waitcnt lgkmcnt(0)" ::: "memory"); ASBAR();
#define APK(k) (bf16x8){lo[k][0], lo[k][1], lo[k][2], lo[k][3], hi[k][0], hi[k][1], hi[k][2], hi[k][3]}
        o[d0] = __builtin_amdgcn_mfma_f32_32x32x16_bf16(pa0, APK(0), o[d0], 0, 0, 0);
        o[d0] = __builtin_amdgcn_mfma_f32_32x32x16_bf16(pa1, APK(1), o[d0], 0, 0, 0);
        o[d0] = __builtin_amdgcn_mfma_f32_32x32x16_bf16(pa2, APK(2), o[d0], 0, 0, 0);
        o[d0] = __builtin_amdgcn_mfma_f32_32x32x16_bf16(pa3, APK(3), o[d0], 0, 0, 0);
#undef APK
    }
}
#ifndef SB_EARLY_EXIT
#define SB_EARLY_EXIT 1
#endif
#ifndef FOX_SKIP
#define FOX_SKIP 1
#endif
template <bool FOX>
__device__ __forceinline__ void attn_unit(int b, int h, int qb, const bf16* __restrict__ QKV, const float* __restrict__ kbias, const float* __restrict__ gq, const float* __restrict__ gk, bf16* O, ALAS unsigned char* lds, unsigned* qc, volatile ALAS unsigned* qslot) {
    int tid_ = threadIdx.x; asm volatile("" : "+v"(tid_)); const int tid = tid_, lane = tid & 63, r32 = lane & 31, hi = lane >> 5; const int wid = __builtin_amdgcn_readfirstlane(tid >> 6);
    const long rowbase = (long)b * SEQ; const int q0 = qb * QB;
    const int colq = (FOX ? 1536 : 0) + h * 64;
    const bf16* Qw = QKV + (rowbase + q0 + wid * 32) * PITCH + colq;
    const bf16* Kh = QKV + rowbase * PITCH + colq + 512; const bf16* Vh = QKV + rowbase * PITCH + colq + 1024;
    const unsigned lds0 = (unsigned)(uintptr_t)lds;
    ALAS float* wsf = (ALAS float*)(lds + L_WS) + wid * 64;
    ALAS unsigned* flags = (ALAS unsigned*)(lds + L_FLAG);
    const int kpos = lane, khi = (kpos >> 2) & 1, kr = (kpos & 3) + 4 * ((kpos & 31) >> 3), kkey = khi * 32 + (kpos >> 5) * 16 + kr;
    const bf16* ksrc = Kh + (long)kkey * PITCH + wid * 8;
    const int key16 = lane >> 2, vhi = (key16 >> 2) & 1, vj = (key16 & 3) + 4 * (key16 >> 3), vkey = vhi * 32 + (wid & 3) * 8 + vj;
    const bf16* vsrc = Vh + (long)vkey * PITCH + (wid >> 2) * 32 + (lane & 3) * 8;
    const float* bsrc = kbias + ((long)(b * 8 + h)) * SEQ + lane;
    const unsigned kdst = lds0 + L_K + wid * 1024, vdst = lds0 + L_V + wid * 1024, bdst = lds0 + L_B;
#define ADMA(t, slot) do { glds16(ksrc + (long)(t) * KVBLK * PITCH, (unsigned)__builtin_amdgcn_readfirstlane(kdst + (slot) * SLOTB)); \
                           glds16(vsrc + (long)(t) * KVBLK * PITCH, (unsigned)__builtin_amdgcn_readfirstlane(vdst + (slot) * SLOTB)); \
                           if (FOX && wid == 0) glds4(bsrc + (t) * KVBLK, (unsigned)__builtin_amdgcn_readfirstlane(bdst + (slot) * 256)); } while (0)
    const int vb0 = (int)(lds0 + L_V) + ((lane >> 4) & 1) * 32 + (lane & 3) * 8 + (4 * hi + ((lane & 15) >> 2)) * 64;
    const int NT = (q0 + QB) / KVBLK;
    if (lane == 0) flags[wid] = 0u;
    float sbound = 0.f;
    if (FOX && FOX_SKIP) { float a = fabsf(gq[h * 64 + lane]), c = fabsf(gk[h * 64 + lane]);
#pragma unroll
        for (int o_ = 1; o_ < 64; o_ <<= 1) { a = fmaxf(a, __shfl_xor(a, o_)); c = fmaxf(c, __shfl_xor(c, o_)); }
        sbound = 64.0f * 0.125f * 1.4426950408889634f * a * c * 1.02f + 0.5f; }
    if (FOX) { ADMA(NT - 1, 0); } else { ADMA(NT - 1, (NT - 1) & 3); ADMA(NT - 2, (NT - 2) & 3); ADMA(NT - 3, (NT - 3) & 3); }
    bf16x8 qr[4];
#pragma unroll
    for (int d0 = 0; d0 < 4; ++d0) qr[d0] = *reinterpret_cast<const bf16x8*>(&Qw[(long)r32 * PITCH + d0 * 16 + hi * 8]);
    f32x16 o[2]; o[0] = f32x16{}; o[1] = f32x16{};
    float m_run = -1e30f, l_run = 0.f, Rp = 1.0f;
    const int qpos = q0 + wid * 32 + r32;
    const int qlast = q0 + wid * 32 + 31;
    for (int it = 0; it < NT; ++it) {
        int t, slot;
        if (FOX) { t = NT - 1 - it; slot = it & 1; } else { t = (wid < 4) ? NT - 3 - it : NT - 1 - it; slot = t & 3; }
        AWAIT_BAR();
        if (FOX ? FOX_SKIP : SB_EARLY_EXIT) {
            const u32x4 f0 = *(ALAS const u32x4*)(flags), f1 = *(ALAS const u32x4*)(flags + 4);
            if ((f0.x & f0.y & f0.z & f0.w & f1.x & f1.y & f1.z & f1.w) != 0u) break;
        }
        if (FOX) { if (it + 1 < NT) ADMA(t - 1, slot ^ 1); }
        else { const int tn = NT - 4 - it; if (tn >= 0) ADMA(tn, tn & 3); if (t < 0) { if (lane == 0) flags[wid] = 1u; continue; } }
        if (KVBLK * t > qlast) continue;
        const bool band = (KVBLK * t + KVBLK - 1 > q0 + wid * 32 - (FOX ? 0 : 1));
        f32x16 p0, p1;
        if (FOX) { const ALAS f32x4* bp = (const ALAS f32x4*)(lds + L_B + slot * 256 + hi * 128);
            const f32x4 c0 = bp[0], c1 = bp[1], c2 = bp[2], c3 = bp[3], c4 = bp[4], c5 = bp[5], c6 = bp[6], c7 = bp[7];
            p0 = (f32x16){c0[0], c0[1], c0[2], c0[3], c1[0], c1[1], c1[2], c1[3], c2[0], c2[1], c2[2], c2[3], c3[0], c3[1], c3[2], c3[3]};
            p1 = (f32x16){c4[0], c4[1], c4[2], c4[3], c5[0], c5[1], c5[2], c5[3], c6[0], c6[1], c6[2], c6[3], c7[0], c7[1], c7[2], c7[3]};
        } else { p0 = f32x16{}; p1 = f32x16{}; }
        VFrag vf; v_issue(vf, vb0 + slot * SLOTB);
        { const ALAS unsigned char* kp = lds + L_K + slot * SLOTB + hi * 1024 + r32 * 16;
#pragma unroll
          for (int d0 = 0; d0 < 4; ++d0) { const bf16x8 b0 = *(const ALAS bf16x8*)(kp + d0 * 2048), b1 = *(const ALAS bf16x8*)(kp + d0 * 2048 + 512);
              p0 = __builtin_amdgcn_mfma_f32_32x32x16_bf16(b0, qr[d0], p0, 0, 0, 0); p1 = __builtin_amdgcn_mfma_f32_32x32x16_bf16(b1, qr[d0], p1, 0, 0, 0); } }
        const int kbase = KVBLK * t + hi * 32;
        if (FOX) {
            if (band) {
#pragma unroll
                for (int r = 0; r < 16; ++r) { if (kbase + r > qpos) p0[r] = -INFINITY; if (kbase + 16 + r > qpos) p1[r] = -INFINITY; } }
            float mx = fmaxf(p0[0], p1[0]);
#pragma unroll
            for (int r = 1; r < 16; ++r) mx = fmaxf(mx, fmaxf(p0[r], p1[r]));
            { auto rr = __builtin_amdgcn_permlane32_swap(__float_as_uint(mx), __float_as_uint(mx), false, false); mx = fmaxf(__uint_as_float(rr[0]), __uint_as_float(rr[1])); }
            const float m_new = fmaxf(m_run, mx);
            if (__any(m_new > m_run)) {
                const float alpha = __builtin_amdgcn_exp2f(m_run - m_new); l_run *= alpha; m_run = m_new;
                if (hi == 0) wsf[r32] = alpha;
                asm volatile("s_waitcnt lgkmcnt(0)" ::: "memory");
#pragma unroll
                for (int g = 0; g < 4; ++g) { const f32x4 a = *(const ALAS f32x4*)(wsf + 8 * g + 4 * hi);
#pragma unroll
                    for (int e = 0; e < 4; ++e) { o[0][4 * g + e] *= a[e]; o[1][4 * g + e] *= a[e]; } }
            }
            float sacc = 0.f;
#pragma unroll
            for (int r = 0; r < 16; ++r) { p0[r] = __builtin_amdgcn_exp2f(p0[r] - m_run); p1[r] = __builtin_amdgcn_exp2f(p1[r] - m_run); sacc += p0[r] + p1[r]; }
            l_run += sacc;
            if (FOX_SKIP) {
                const float b0 = *(const ALAS float*)(lds + L_B + slot * 256);
                const bool dead = __all(sbound + b0 - m_run < -150.0f);
                if (lane == 0) flags[wid] = dead ? 1u : 0u; }
        } else {
            float acc = 1.0f;
#pragma unroll
            for (int e = 31; e >= 0; --e) {
                const float s = fminf(e < 16 ? p0[e] : p1[e - 16], 100.0f);
                const float tt = __builtin_amdgcn_exp2f(s);
                float kp_ = __builtin_amdgcn_rcpf(1.0f + tt); bool dead = false;
                if (band) { dead = (kbase + e >= qpos); kp_ = dead ? 1.0f : kp_; }
                acc *= kp_; const float w = dead ? 0.0f : tt * acc;
                if (e < 16) p0[e] = w; else p1[e - 16] = w;
            }
            auto rr = __builtin_amdgcn_permlane32_swap(__float_as_uint(acc), __float_as_uint(acc), false, false);
            const float t_lo = __uint_as_float(rr[0]), t_hi = __uint_as_float(rr[1]);
            const float off = hi ? Rp : Rp * t_hi;
#pragma unroll
            for (int r = 0; r < 16; ++r) { p0[r] *= off; p1[r] *= off; }
            Rp = Rp * t_lo * t_hi;
            if (SB_EARLY_EXIT) { const bool alldead = __all(Rp == 0.0f); if (lane == 0) flags[wid] = alldead ? 1u : 0u; }
        }
        u32x4 pw0, pw1, pw2, pw3;
        pw0 = (u32x4){cvtpk_s(p0[0], p0[1]), cvtpk_s(p0[2], p0[3]), cvtpk_s(p0[4], p0[5]), cvtpk_s(p0[6], p0[7])};
        pw1 = (u32x4){cvtpk_s(p0[8], p0[9]), cvtpk_s(p0[10], p0[11]), cvtpk_s(p0[12], p0[13]), cvtpk_s(p0[14], p0[15])};
        pw2 = (u32x4){cvtpk_s(p1[0], p1[1]), cvtpk_s(p1[2], p1[3]), cvtpk_s(p1[4], p1[5]), cvtpk_s(p1[6], p1[7])};
        pw3 = (u32x4){cvtpk_s(p1[8], p1[9]), cvtpk_s(p1[10], p1[11]), cvtpk_s(p1[12], p1[13]), cvtpk_s(p1[14], p1[15])};
        pv_mma(o, vf, __builtin_bit_cast(bf16x8, pw0), __builtin_bit_cast(bf16x8, pw1), __builtin_bit_cast(bf16x8, pw2), __builtin_bit_cast(bf16x8, pw3));
    }
    unsigned nxq = 0u; if (tid == 0) nxq = atomicAdd(qc, 1u);
    float rli[16];
    if (FOX) {
        { auto rr = __builtin_amdgcn_permlane32_swap(__float_as_uint(l_run), __float_as_uint(l_run), false, false); l_run = __uint_as_float(rr[0]) + __uint_as_float(rr[1]); }
        if (hi == 0) wsf[32 + r32] = l_run;
        asm volatile("s_waitcnt lgkmcnt(0)" ::: "memory");
#pragma unroll
        for (int r = 0; r < 16; ++r) rli[r] = __builtin_amdgcn_rcpf(wsf[32 + crow(r, hi)]);
    } else {
#pragma unroll
        for (int r = 0; r < 16; ++r) rli[r] = 1.0f;
    }
    bf16* Ow = O + (rowbase + q0 + wid * 32) * OPITCH + ((FOX ? 8 : 0) + h) * 64;
    { ALAS bf16* stg = (ALAS bf16*)(lds + L_OST) + wid * 2048;
#pragma unroll
      for (int r = 0; r < 16; ++r) { const int orow = crow(r, hi);
#pragma unroll
          for (int d0 = 0; d0 < 2; ++d0) stg[orow * 64 + d0 * 32 + r32] = (bf16)(cvtpk_s(o[d0][r] * rli[r], 0.f) & 0xffffu); }
      asm volatile("s_waitcnt lgkmcnt(0)" ::: "memory");
#pragma unroll
      for (int i = 0; i < 4; ++i) { const int row = i * 8 + (lane >> 3), ch = lane & 7; const u32x4 v = *(const ALAS u32x4*)(stg + row * 64 + ch * 8); *(u32x4*)(Ow + (long)row * OPITCH + ch * 8) = v; } }
    if (tid == 0) *qslot = nxq;
    asm volatile("s_waitcnt vmcnt(0) lgkmcnt(0)\n\ts_barrier" ::: "memory");
#undef ADMA
}
#undef AWAIT_BAR
#undef ASBAR
}
namespace fox {
using bf16 = unsigned short;
using bf16x8 = __attribute__((ext_vector_type(8))) short;
using s16x4 = __attribute__((ext_vector_type(4))) short;
using f32x16 = __attribute__((ext_vector_type(16))) float;
using f32x4 = __attribute__((ext_vector_type(4))) float;
using u32x4 = __attribute__((ext_vector_type(4))) unsigned;
constexpr int SEQ = 4096, DM = 3072, OPITCH = 1024, D = 64, NW = 8, QBLK = 32, QB = 256, KVBLK = 64;
__device__ __forceinline__ int crow(int r,int hi){return (r&3)+8*(r>>2)+4*hi;}
#define SBAR() __builtin_amdgcn_sched_barrier(0)
__device__ __forceinline__ void cmask(f32x16&p0,f32x16&p1,int jb,int qrel,int hi){
  const float NEG=-INFINITY; int kb=64*jb+4*hi;
  #pragma unroll
  for(int r=0;r<16;++r){int kv=kb+(r&3)+8*(r>>2); if(kv>qrel)p0[r]=NEG; if(kv+32>qrel)p1[r]=NEG;}
}

__device__ __forceinline__ void glds16(const void*gsrc,unsigned lds_dst){unsigned keep;
  asm volatile("s_mov_b32 %0, m0\n\ts_mov_b32 m0, %2\n\ts_nop 0\n\tglobal_load_lds_dwordx4 %1, off\n\ts_mov_b32 m0, %0":"=&s"(keep):"v"(gsrc),"s"(lds_dst):"memory");}
__device__ __forceinline__ float max3f(float a,float b,float c){float r;asm("v_max3_f32 %0, %1, %2, %3":"=v"(r):"v"(a),"v"(b),"v"(c));return r;}
__device__ __forceinline__ float max2f(float a,float b){float r;asm("v_max_f32_e32 %0, %1, %2":"=v"(r):"v"(a),"v"(b));return r;}
__device__ __forceinline__ float fadd_s(float a,float b){float r;asm("v_add_f32_e32 %0, %1, %2":"=v"(r):"v"(a),"v"(b));return r;}
__device__ __forceinline__ float fsub_s(float a,float b){float r;asm("v_sub_f32_e32 %0, %1, %2":"=v"(r):"v"(a),"v"(b));return r;}
typedef float f32x2_t __attribute__((ext_vector_type(2))); typedef __bf16 bf16x2_t __attribute__((ext_vector_type(2)));
__device__ __forceinline__ unsigned cvtpk_s(float lo,float hi){f32x2_t v={lo,hi};bf16x2_t b=__builtin_convertvector(v,bf16x2_t);return __builtin_bit_cast(unsigned,b);}
#define WAIT_BAR(N) asm volatile("s_waitcnt vmcnt(" #N ") lgkmcnt(0)\n\ts_barrier":::"memory")
typedef __attribute__((address_space(3))) const char* lds_cptr;
typedef short v4i16_t __attribute__((ext_vector_type(4)));
__device__ __forceinline__ void kload8(bf16x8*kf,lds_cptr kp){
  kf[0]=*(const __attribute__((address_space(3))) bf16x8*)(kp);      kf[1]=*(const __attribute__((address_space(3))) bf16x8*)(kp+512);
  kf[2]=*(const __attribute__((address_space(3))) bf16x8*)(kp+2048); kf[3]=*(const __attribute__((address_space(3))) bf16x8*)(kp+2560);
  kf[4]=*(const __attribute__((address_space(3))) bf16x8*)(kp+4096); kf[5]=*(const __attribute__((address_space(3))) bf16x8*)(kp+4608);
  kf[6]=*(const __attribute__((address_space(3))) bf16x8*)(kp+6144); kf[7]=*(const __attribute__((address_space(3))) bf16x8*)(kp+6656);
}
__device__ __forceinline__ void kload2(bf16x8*kf,lds_cptr kp,int j){ kf[2*j]=*(const __attribute__((address_space(3))) bf16x8*)(kp+j*2048); kf[2*j+1]=*(const __attribute__((address_space(3))) bf16x8*)(kp+j*2048+512); }
__device__ __forceinline__ s16x4 vtr(lds_cptr p){ return __builtin_bit_cast(s16x4,__builtin_amdgcn_ds_read_tr16_b64_v4i16((__attribute__((address_space(3))) v4i16_t*)p)); }
__device__ __forceinline__ float rowmax(const f32x16&p0,const f32x16&p1){
  float a=max3f(p0[0],p0[1],p1[0]),b=max3f(p0[2],p0[3],p1[1]);a=max3f(a,p1[2],p1[3]);
  #pragma unroll
  for(int r=4;r<16;r+=4){a=max3f(a,p0[r],p0[r+1]);b=max3f(b,p0[r+2],p0[r+3]);a=max3f(a,p1[r],p1[r+1]);b=max3f(b,p1[r+2],p1[r+3]);}
  const float m=max2f(a,b);
  auto rr=__builtin_amdgcn_permlane32_swap(__float_as_uint(m),__float_as_uint(m),false,false);
  return max2f(__uint_as_float(rr[0]),__uint_as_float(rr[1]));
}

__device__ __forceinline__ void pvd(f32x16* o, int vb, bf16x8 pa0, bf16x8 pa1, bf16x8 pa2, bf16x8 pa3) {
#pragma unroll
  for (int d0 = 0; d0 < 2; ++d0) { s16x4 lo[4], hi[4];
#pragma unroll
    for (int ks = 0; ks < 4; ++ks) {
      asm volatile("ds_read_b64_tr_b16 %0,%1 offset:%c2" : "=&v"(lo[ks]) : "v"(vb), "i"(d0 * 4096 + ks * 1024) : "memory");
      asm volatile("ds_read_b64_tr_b16 %0,%1 offset:%c2" : "=&v"(hi[ks]) : "v"(vb), "i"(d0 * 4096 + ks * 1024 + 512) : "memory"); }
    asm volatile("s_waitcnt lgkmcnt(0)" ::: "memory"); SBAR();
#define PK(k) (bf16x8){lo[k][0], lo[k][1], lo[k][2], lo[k][3], hi[k][0], hi[k][1], hi[k][2], hi[k][3]}
    o[d0] = __builtin_amdgcn_mfma_f32_32x32x16_bf16(pa0, PK(0), o[d0], 0, 0, 0);
    o[d0] = __builtin_amdgcn_mfma_f32_32x32x16_bf16(pa1, PK(1), o[d0], 0, 0, 0);
    o[d0] = __builtin_amdgcn_mfma_f32_32x32x16_bf16(pa2, PK(2), o[d0], 0, 0, 0);
    o[d0] = __builtin_amdgcn_mfma_f32_32x32x16_bf16(pa3, PK(3), o[d0], 0, 0, 0);
#undef PK
  }
}

constexpr int NSLOT = 3, SLOTB = 8192, KSLOTB = 9216;
constexpr int LDS_K = 0, LDS_V = NSLOT * KSLOTB, LDS_WS = LDS_V + NSLOT * SLOTB, LDS_OST = LDS_WS + NW * 64 * 4, LDS_BYTES = LDS_OST + NW * 4096;
#define KOFF(sl) ((sl) + ((sl) >> 3))
#define WB(n0, n1) do { if (wid == 0) { WAIT_BAR(n0); } else { WAIT_BAR(n1); } } while (0)
typedef __attribute__((address_space(3))) unsigned char* lds_ptr;
template <int THRL> __device__ __forceinline__ void fox_unit(int b, int h, int qb, const bf16* __restrict__ QKV, const float* __restrict__ kbias, const u32x4* __restrict__ kb16,
                                                             float sbound, bf16* O, lds_ptr shm, unsigned* qc, volatile __attribute__((address_space(3))) unsigned* qslot) {
  int tid_ = threadIdx.x; asm volatile("" : "+v"(tid_)); const int tid = tid_, lane = tid & 63, r32 = lane & 31, hi = lane >> 5; const int wid = __builtin_amdgcn_readfirstlane(tid >> 6);
  const long rowbase = (long)b * SEQ; const int q0 = qb * QB; const int colq = 1536 + h * D;
  const bf16* Qw = QKV + (rowbase + q0 + wid * QBLK) * DM + colq;
  const bf16* Kh = QKV + rowbase * DM + colq + 512; const bf16* Vh = QKV + rowbase * DM + colq + 1024;
  const float* kbh = kbias + (long)(b * 8 + h) * SEQ; const u32x4* kb16h = kb16 + (long)(b * 8 + h) * SEQ;
  const unsigned lds0 = (unsigned)(uintptr_t)shm;
  __attribute__((address_space(3))) float* wsf = (__attribute__((address_space(3))) float*)(shm + LDS_WS) + wid * 64;
  const int NT = (q0 + QB) / KVBLK;
  int T0 = 0;
  {
    const int tc = 2 * ((lane & 31) + 1);
    const bool valid = (lane < 32) && (tc <= NT - 4);
    const float bk = valid ? kbh[64 * tc - 1] : 0.f, bq = kbh[q0];
    const bool dead = valid && (bk < bq - 150.0f - 2.0f * sbound);
    T0 = 2 * __popcll(__ballot(dead)); }
  T0 = __builtin_amdgcn_readfirstlane(T0);
  const bf16* ksrc = Kh + (long)lane * DM + wid * 8;
  const bf16* vsrc = Vh + (long)(16 * (wid & 3) + (lane >> 2)) * DM + (wid >> 2) * 32 + (lane & 3) * 8;
  const u32x4* asrc = kb16h + lane;
  const unsigned kdst = lds0 + LDS_K + wid * 1024, adst = lds0 + LDS_K + 8192, vdst = lds0 + LDS_V + wid * 1024;
#define DMA_K(t, slot) do { glds16(ksrc + (long)(t) * KVBLK * DM, (unsigned)__builtin_amdgcn_readfirstlane(kdst + KOFF(slot))); \
                            if (wid == 0) glds16(asrc + (long)(t) * KVBLK, (unsigned)__builtin_amdgcn_readfirstlane(adst + KOFF(slot))); } while (0)
#define DMA_V(t, slot) glds16(vsrc + (long)(t) * KVBLK * DM, (unsigned)__builtin_amdgcn_readfirstlane(vdst + (slot)))
  const lds_cptr shm3 = (lds_cptr)shm; const lds_cptr kp0 = shm3 + LDS_K + hi * 1024 + r32 * 16; const lds_cptr ka0 = shm3 + LDS_K + 8192 + r32 * 16;
  const lds_cptr vp0 = shm3 + LDS_V + ((lane >> 4) & 1) * 32 + (lane & 3) * 8 + (4 * hi + ((lane & 15) >> 2)) * 64;
  const int vb0 = (int)(lds0 + LDS_V) + ((lane >> 4) & 1) * 32 + (lane & 3) * 8 + (4 * hi + ((lane & 15) >> 2)) * 64;
  bf16x8 kf[8], ka[2];
#define ALOAD(sl) do { ka[0] = *(const __attribute__((address_space(3))) bf16x8*)(ka0 + KOFF(sl)); ka[1] = *(const __attribute__((address_space(3))) bf16x8*)(ka0 + KOFF(sl) + 512); } while (0)
  DMA_K(T0, 0); DMA_V(T0, 0); DMA_K(T0 + 1, SLOTB);
  bf16x8 qr[4];
#pragma unroll
  for (int d0 = 0; d0 < 4; ++d0) qr[d0] = *reinterpret_cast<const bf16x8*>(&Qw[(long)r32 * DM + d0 * 16 + hi * 8]);
  const short one = hi ? (short)0 : (short)0x3F80;
  bf16x8 qa = (bf16x8){one, one, one, 0, 0, 0, 0, 0}; asm volatile("" : "+v"(qa));
  float l_reg = 0.f; f32x16 o[2]; o[0] = f32x16{}; o[1] = f32x16{};
  const int qrel = wid * QBLK + r32;
  f32x16 negm; { const float nb = -(kbh[q0 + qrel] + fmaxf(sbound - 40.0f, 0.0f));
    _Pragma("unroll") for (int r = 0; r < 16; ++r) negm[r] = nb; } asm volatile("" : "+v"(negm));
#define CMASK(P0, P1, t) do { int jb_ = (t) - (NT - 4); if (jb_ >= 0) cmask(P0, P1, jb_, qrel, hi); } while (0)
#define START(P0, P1) do { _Pragma("unroll") for (int r = 0; r < 16; ++r) P0[r] = __builtin_amdgcn_exp2f(P0[r]); } while (0)
#define RESC() do {} while (0)
  f32x16 pA0, pA1, pB0, pB1;
  int sl_prev = 0, sl_cur = 0, sl_next = SLOTB;
#define ROT() do { sl_prev = sl_cur; sl_cur = sl_next; sl_next = (sl_next == (NSLOT - 1) * SLOTB) ? 0 : sl_next + SLOTB; } while (0)
  DMA_K(T0 + 2, 2 * SLOTB);
  WB(5, 3);
  { kload8(kf, kp0); ALOAD(0);
    pA0 = __builtin_amdgcn_mfma_f32_32x32x16_bf16(kf[0], qr[0], negm, 0, 0, 0); pA1 = __builtin_amdgcn_mfma_f32_32x32x16_bf16(kf[1], qr[0], negm, 0, 0, 0);
    pA0 = __builtin_amdgcn_mfma_f32_32x32x16_bf16(kf[2], qr[1], pA0, 0, 0, 0);  pA1 = __builtin_amdgcn_mfma_f32_32x32x16_bf16(kf[3], qr[1], pA1, 0, 0, 0);
    pA0 = __builtin_amdgcn_mfma_f32_32x32x16_bf16(kf[4], qr[2], pA0, 0, 0, 0);  pA1 = __builtin_amdgcn_mfma_f32_32x32x16_bf16(kf[5], qr[2], pA1, 0, 0, 0);
    pA0 = __builtin_amdgcn_mfma_f32_32x32x16_bf16(kf[6], qr[3], pA0, 0, 0, 0);  pA1 = __builtin_amdgcn_mfma_f32_32x32x16_bf16(kf[7], qr[3], pA1, 0, 0, 0);
    pA0 = __builtin_amdgcn_mfma_f32_32x32x16_bf16(ka[0], qa, pA0, 0, 0, 0);     pA1 = __builtin_amdgcn_mfma_f32_32x32x16_bf16(ka[1], qa, pA1, 0, 0, 0); }
  asm volatile("s_nop 15\n\ts_nop 7" : "+v"(pA0), "+v"(pA1)); CMASK(pA0, pA1, T0);
  START(pA0, pA1);
  _Pragma("unroll") for (int r = 0; r < 16; ++r) pA1[r] = __builtin_amdgcn_exp2f(pA1[r]);
  WAIT_BAR(0);
  DMA_K(T0 + 3, 0); DMA_V(T0 + 1, SLOTB);
  ROT();
  kload8(kf, kp0 + KOFF(sl_cur)); ALOAD(sl_cur);
  WB(3, 2);
  s16x4 vlo[8], vhi[8]; u32x4 pw0, pw1, pw2, pw3;
#define PKW(P, B) cvtpk_s(P[B], P[B + 1])
#define PAF(k) __builtin_bit_cast(bf16x8, pw##k)
#define VFR(i) (bf16x8){vlo[i][0], vlo[i][1], vlo[i][2], vlo[i][3], vhi[i][0], vhi[i][1], vhi[i][2], vhi[i][3]}
#define PIN(x) asm volatile("" : "+v"(x))
#define MX3(a, b, c) __builtin_fmaxf(__builtin_fmaxf((a), (b)), (c))
#define GAPA(MF, A0, A1, A2, A3, W0, W1, PW) do { MF; sacc += A0; sacc += A1; sacc += A2; sacc += A3; PIN(sacc); W0; W1; PIN(PW); SBAR(); } while (0)
#define EX(v) __builtin_amdgcn_exp2f(v)
#define GAPB(MF, X, B) do { MF; X[B] = EX(X[B]); X[B + 1] = EX(X[B + 1]); X[B + 2] = EX(X[B + 2]); X[B + 3] = EX(X[B + 3]); PIN(X); SBAR(); } while (0)
#define VRD(i) do { vlo[i] = vtr(vp_ + (((i) >> 2) * 4096 + ((i) & 3) * 1024)); vhi[i] = vtr(vp_ + (((i) >> 2) * 4096 + ((i) & 3) * 1024 + 512)); } while (0)
#define KRD(G, j) do { if (G) { kload2(kf, kp0 + KOFF(sl_next), j); SBAR(); } } while (0)
#define KRDA(G) do { if (G) { ALOAD(sl_next); SBAR(); } } while (0)
#define STEP(C0, C1, P0, P1, t, GK, GV, GL) do { SBAR(); \
    const lds_cptr vp_ = vp0 + sl_prev; \
    VRD(0); SBAR(); float sacc = (P0[0] + P0[1]); \
    GAPA(C0 = __builtin_amdgcn_mfma_f32_32x32x16_bf16(kf[0], qr[0], negm, 0, 0, 0), P0[2], P0[3], P0[4], P0[5],     pw0[0] = PKW(P0, 0), pw0[1] = PKW(P0, 2), pw0); \
    VRD(4); SBAR(); GAPA(C1 = __builtin_amdgcn_mfma_f32_32x32x16_bf16(kf[1], qr[0], negm, 0, 0, 0), P0[6], P0[7], P0[8], P0[9],     pw0[2] = PKW(P0, 4), pw0[3] = PKW(P0, 6), pw0); \
    VRD(1); SBAR(); GAPA(C0 = __builtin_amdgcn_mfma_f32_32x32x16_bf16(kf[2], qr[1], C0, 0, 0, 0),   P0[10], P0[11], P0[12], P0[13], pw1[0] = PKW(P0, 8), pw1[1] = PKW(P0, 10), pw1); \
    VRD(5); SBAR(); GAPA(C1 = __builtin_amdgcn_mfma_f32_32x32x16_bf16(kf[3], qr[1], C1, 0, 0, 0),   P0[14], P0[15], P1[0], P1[1],   pw1[2] = PKW(P0, 12), pw1[3] = PKW(P0, 14), pw1); \
    VRD(2); SBAR(); GAPA(C0 = __builtin_amdgcn_mfma_f32_32x32x16_bf16(kf[4], qr[2], C0, 0, 0, 0),   P1[2], P1[3], P1[4], P1[5],     pw2[0] = PKW(P1, 0), pw2[1] = PKW(P1, 2), pw2); \
    VRD(6); SBAR(); GAPA(C1 = __builtin_amdgcn_mfma_f32_32x32x16_bf16(kf[5], qr[2], C1, 0, 0, 0),   P1[6], P1[7], P1[8], P1[9],     pw2[2] = PKW(P1, 4), pw2[3] = PKW(P1, 6), pw2); \
    VRD(3); SBAR(); GAPA(C0 = __builtin_amdgcn_mfma_f32_32x32x16_bf16(kf[6], qr[3], C0, 0, 0, 0),   P1[10], P1[11], P1[12], P1[13], pw3[0] = PKW(P1, 8), pw3[1] = PKW(P1, 10), pw3); \
    VRD(7); SBAR(); GAPA(C1 = __builtin_amdgcn_mfma_f32_32x32x16_bf16(kf[7], qr[3], C1, 0, 0, 0),   P1[14], P1[15], 0.f, 0.f,       pw3[2] = PKW(P1, 12), pw3[3] = PKW(P1, 14), pw3); \
    C0 = __builtin_amdgcn_mfma_f32_32x32x16_bf16(ka[0], qa, C0, 0, 0, 0); C1 = __builtin_amdgcn_mfma_f32_32x32x16_bf16(ka[1], qa, C1, 0, 0, 0); SBAR(); \
    l_reg += sacc; \
    if (GK) { DMA_K((t) + 3, sl_cur); } if (GV) { DMA_V((t) + 1, sl_next); } \
    CMASK(C0, C1, t); \
    SBAR(); \
    GAPB(o[0] = __builtin_amdgcn_mfma_f32_32x32x16_bf16(PAF(0), VFR(0), o[0], 0, 0, 0), C0, 0); \
    GAPB(o[1] = __builtin_amdgcn_mfma_f32_32x32x16_bf16(PAF(0), VFR(4), o[1], 0, 0, 0), C0, 4); \
    KRD(GL, 0); GAPB(o[0] = __builtin_amdgcn_mfma_f32_32x32x16_bf16(PAF(1), VFR(1), o[0], 0, 0, 0), C0, 8); \
    KRD(GL, 1); GAPB(o[1] = __builtin_amdgcn_mfma_f32_32x32x16_bf16(PAF(1), VFR(5), o[1], 0, 0, 0), C0, 12); \
    KRD(GL, 2); GAPB(o[0] = __builtin_amdgcn_mfma_f32_32x32x16_bf16(PAF(2), VFR(2), o[0], 0, 0, 0), C1, 0); \
    KRD(GL, 3); GAPB(o[1] = __builtin_amdgcn_mfma_f32_32x32x16_bf16(PAF(2), VFR(6), o[1], 0, 0, 0), C1, 4); \
    KRDA(GL); GAPB(o[0] = __builtin_amdgcn_mfma_f32_32x32x16_bf16(PAF(3), VFR(3), o[0], 0, 0, 0), C1, 8); \
    GAPB(o[1] = __builtin_amdgcn_mfma_f32_32x32x16_bf16(PAF(3), VFR(7), o[1], 0, 0, 0), C1, 12); \
    } while (0)
  int t = T0 + 1;
#undef CMASK
#define CMASK(P0, P1, t) do {} while (0)
  for (; t + 5 < NT; t += 2) {
    STEP(pB0, pB1, pA0, pA1, t, true, true, true);     WB(3, 2); RESC(); ROT();
    STEP(pA0, pA1, pB0, pB1, t + 1, true, true, true); WB(3, 2); RESC(); ROT();
  }
#undef CMASK
#define CMASK(P0, P1, t) do { int jb_ = (t) - (NT - 4); if (jb_ >= 0) cmask(P0, P1, jb_, qrel, hi); } while (0)
#define ENDW(tt) do { if ((tt) + 3 < NT) { WB(3, 2); } else if ((tt) + 2 < NT) { WAIT_BAR(1); } else { WAIT_BAR(0); } } while (0)
  for (; t + 1 < NT; t += 2) {
    STEP(pB0, pB1, pA0, pA1, t, (t + 3 < NT), (t + 1 < NT), (t + 1 < NT));         ENDW(t);     RESC(); ROT();
    STEP(pA0, pA1, pB0, pB1, t + 1, (t + 4 < NT), (t + 2 < NT), (t + 2 < NT));     ENDW(t + 1); RESC(); ROT();
  }
  STEP(pB0, pB1, pA0, pA1, NT - 1, false, false, false); RESC();
  { float sacc = pB0[0] + pB0[1]; _Pragma("unroll") for (int r = 2; r < 16; ++r) sacc += pB0[r]; _Pragma("unroll") for (int r = 0; r < 16; ++r) sacc += pB1[r]; l_reg += sacc;
    pw0 = (u32x4){PKW(pB0, 0), PKW(pB0, 2), PKW(pB0, 4), PKW(pB0, 6)}; pw1 = (u32x4){PKW(pB0, 8), PKW(pB0, 10), PKW(pB0, 12), PKW(pB0, 14)};
    pw2 = (u32x4){PKW(pB1, 0), PKW(pB1, 2), PKW(pB1, 4), PKW(pB1, 6)}; pw3 = (u32x4){PKW(pB1, 8), PKW(pB1, 10), PKW(pB1, 12), PKW(pB1, 14)};
    SBAR(); pvd(o, vb0 + sl_cur, PAF(0), PAF(1), PAF(2), PAF(3)); }
  unsigned nxq = 0u; if (tid == 0) nxq = atomicAdd(qc, 1u);
  { auto rr = __builtin_amdgcn_permlane32_swap(__float_as_uint(l_reg), __float_as_uint(l_reg), false, false); l_reg = __uint_as_float(rr[0]) + __uint_as_float(rr[1]); }
  if (hi == 0) wsf[32 + r32] = l_reg; asm volatile("s_waitcnt lgkmcnt(0)" ::: "memory");
  float rli[16];
#pragma unroll
  for (int r = 0; r < 16; ++r) rli[r] = __builtin_amdgcn_rcpf(wsf[32 + crow(r, hi)]);
  bf16* Ow = O + (rowbase + q0 + wid * QBLK) * OPITCH + (8 + h) * D;
  { __attribute__((address_space(3))) bf16* stg = (__attribute__((address_space(3))) bf16*)(shm + LDS_OST) + wid * 2048;
#pragma unroll
    for (int r = 0; r < 16; ++r) { const int orow = crow(r, hi);
#pragma unroll
      for (int d0 = 0; d0 < 2; ++d0) stg[orow * 64 + d0 * 32 + r32] = (bf16)(cvtpk_s(o[d0][r] * rli[r], 0.f) & 0xffffu); }
    asm volatile("s_waitcnt lgkmcnt(0)" ::: "memory");
#pragma unroll
    for (int i = 0; i < 4; ++i) { const int row = i * 8 + (lane >> 3), ch = lane & 7; const u32x4 v = *(const __attribute__((address_space(3))) u32x4*)(stg + row * 64 + ch * 8); *(u32x4*)(Ow + (long)row * OPITCH + ch * 8) = v; } }
  if (tid == 0) *qslot = nxq;
  asm volatile("s_waitcnt vmcnt(0) lgkmcnt(0)\n\ts_barrier" ::: "memory");
#undef DMA_K
#undef DMA_V
#undef ALOAD
#undef CMASK
#undef START
#undef RESC
#undef ROT
#undef PKW
#undef PAF
#undef VFR
#undef PIN
#undef MX3
#undef GAPA
#undef GAPB
#undef EX
#undef VRD
#undef KRD
#undef KRDA
#undef STEP
#undef ENDW
}
#undef KOFF
#undef SBAR
#undef WAIT_BAR
}
constexpr int NWAVES = 8;
constexpr int BATCH = 8, SEQ = 4096, D = 1024, FF = 2816, M = BATCH * SEQ, NMOD = 9 * D, INW = 3080, NQKV = 3072;
constexpr float EPS = 1e-6f, LOG2E = 1.4426950408889634f;
constexpr size_t MiB = 1u << 20;
constexpr size_t WS_MOD = 0, WS_LF = 1 * MiB, WS_KB = 2 * MiB, WS_CTL = 3 * MiB, WS_W1GU = 4 * MiB, WS_W1D = 16 * MiB, WS_W2GU = 22 * MiB, WS_W2D = 34 * MiB, WS_WIN = 40 * MiB, WS_WO = 46 * MiB, WS_KB16 = 48 * MiB,
                 WS_H = 64 * MiB, WS_ACT = 128 * MiB, WS_X1 = 320 * MiB, WS_END = 384 * MiB;
constexpr int RING_BYTES = 131072, MISC_OFF = RING_BYTES + 320, LDS_BYTES = 147456;
static_assert(att::L_BYTES <= RING_BYTES && fox::LDS_BYTES <= RING_BYTES, "attention LDS");
#define LAS __attribute__((address_space(3)))
typedef unsigned short bf16;
typedef unsigned v4u __attribute__((ext_vector_type(4)));
typedef unsigned v2u __attribute__((ext_vector_type(2)));
typedef float f32x4 __attribute__((ext_vector_type(4)));
__device__ __forceinline__ unsigned f2bf(float f) { unsigned u = __builtin_bit_cast(unsigned, f); return (u + 0x7fffu + ((u >> 16) & 1u)) >> 16; }
__device__ __forceinline__ unsigned pk2(float lo, float hi) { return f2bf(lo) | (f2bf(hi) << 16); }
__device__ __forceinline__ float wave_sum(float v) {
#pragma unroll
    for (int o = 1; o < 64; o <<= 1) v += __shfl_xor(v, o);
    return v;
}
struct Params {
    const float *x, *c, *w_mod, *b_mod, *g_ffn1, *w1_gate, *w1_up, *w1_down, *g_mix, *w_in, *b_f, *g_q, *g_k, *w_o, *g_ffn2, *w2_gate, *w2_up, *w2_down;
    float* out; unsigned char* ws;
};
__device__ __forceinline__ void transpose_item(const float* W, int K, int ldw, bf16* WT, int k0, int n0, int dst_n0, LAS float* scr, int lane) {
#pragma unroll
    for (int i = 0; i < 32; ++i) { const int kk = 2 * i + (lane >> 5); scr[kk * 33 + (lane & 31)] = W[(size_t)(k0 + kk) * ldw + n0 + (lane & 31)]; }
    asm volatile("s_waitcnt lgkmcnt(0)" ::: "memory");
    const int c = lane & 7;
#pragma unroll
    for (int j = 0; j < 4; ++j) { const int n = (lane >> 3) + 8 * j; const LAS float* s = scr + (8 * c) * 33 + n;
        v4u o; o.x = pk2(s[0 * 33], s[1 * 33]); o.y = pk2(s[2 * 33], s[3 * 33]); o.z = pk2(s[4 * 33], s[5 * 33]); o.w = pk2(s[6 * 33], s[7 * 33]);
        *(v4u*)(WT + (size_t)(dst_n0 + n) * K + k0 + 8 * c) = o; }
    asm volatile("s_waitcnt lgkmcnt(0)" ::: "memory");
}
__device__ __forceinline__ int dst_row_block(int mode, int n0) {
    if (mode == 1) return 256 * (n0 >> 7) + (n0 & 127);
    if (mode == 2) return 256 * (n0 >> 7) + 128 + (n0 & 127);
    if (mode == 3) { const int pn = n0 >> 8, wc = (n0 >> 6) & 3, bj = (n0 >> 5) & 1; return 256 * pn + 128 * bj + 32 * wc; }
    return n0;
}
__device__ __forceinline__ void convert_matrix(const float* W, int K, int ldw, int N, bf16* WT, int mode, int& base, int gw, int NGW, LAS float* scr, int lane) {
    const int nblk = N / 32, items = (K / 64) * nblk;
    int first = (gw - base % NGW + NGW) % NGW;
    for (int it = first; it < items; it += NGW) { const int kb = it / nblk, nb = it % nblk; transpose_item(W, K, ldw, WT, 64 * kb, 32 * nb, dst_row_block(mode, 32 * nb), scr, lane); }
    base += items;
}
__device__ __forceinline__ void mod_item(const Params& p, int nb, LAS unsigned char* lds, int tid) {
    LAS float* sc = (LAS float*)lds;
    LAS float* red = (LAS float*)(lds + 32768);
    for (int i = tid; i < 8192; i += 512) { const int k = i >> 3, b = i & 7; const float v = p.c[b * D + k]; sc[i] = v / (1.0f + __expf(-v)); }
    __syncthreads();
    const int kg = tid >> 5, cgp = tid & 31; const int col = nb * 128 + 4 * cgp;
    f32x4 acc[8];
#pragma unroll
    for (int b = 0; b < 8; ++b) acc[b] = (f32x4){0.f, 0.f, 0.f, 0.f};
#pragma unroll 8
    for (int kk = 0; kk < 64; ++kk) { const int k = kg * 64 + kk; const f32x4 w = *(const f32x4*)(p.w_mod + (size_t)k * NMOD + col);
        const f32x4 s0 = *(const LAS f32x4*)(sc + k * 8), s1 = *(const LAS f32x4*)(sc + k * 8 + 4);
        acc[0] += w * s0[0]; acc[1] += w * s0[1]; acc[2] += w * s0[2]; acc[3] += w * s0[3]; acc[4] += w * s1[0]; acc[5] += w * s1[1]; acc[6] += w * s1[2]; acc[7] += w * s1[3]; }
#pragma unroll
    for (int b = 0; b < 8; ++b) *(LAS f32x4*)(red + (kg * 8 + b) * 128 + 4 * cgp) = acc[b];
    __syncthreads();
    for (int o = tid; o < 1024; o += 512) { const int b = o >> 7, cc = o & 127; float s = p.b_mod[nb * 128 + cc];
#pragma unroll
        for (int g = 0; g < 16; ++g) s += red[(g * 8 + b) * 128 + cc];
        ((float*)(p.ws + WS_MOD))[b * NMOD + nb * 128 + cc] = s; }
    __syncthreads();
}
template <bool FOXF, bool XB16>
__device__ __forceinline__ void norm_phase(const Params& p, const void* X, const float* g, int sh_off, int sc_off, bf16* H, LAS unsigned char* lds, int gw, int NGW, int lane, int tid) {
    LAS float* wf = (LAS float*)lds;
    if (FOXF) { for (int i = tid; i < 8192; i += 512) wf[i] = p.w_in[(size_t)(i >> 3) * INW + NQKV + (i & 7)]; __syncthreads(); }
    const float* mod = (const float*)(p.ws + WS_MOD);
    for (int m0 = gw * 16; m0 < M; m0 += NGW * 16) {
    const int b = m0 / SEQ;
    f32x4 a[4], sh[4];
#pragma unroll
    for (int j = 0; j < 4; ++j) { const int col = 4 * lane + 256 * j; const f32x4 gv = *(const f32x4*)(g + col), sv = *(const f32x4*)(mod + (size_t)b * NMOD + sc_off + col);
        a[j] = gv * (sv + 1.0f); sh[j] = *(const f32x4*)(mod + (size_t)b * NMOD + sh_off + col); }
    for (int r4 = 0; r4 < 16; r4 += 4) {
        v2u rb[4][4]; f32x4 rf[4][4];
#pragma unroll
        for (int q = 0; q < 4; ++q)
#pragma unroll
            for (int j = 0; j < 4; ++j) {
                if (XB16) rb[q][j] = *(const v2u*)((const bf16*)X + (size_t)(m0 + r4 + q) * D + 4 * lane + 256 * j);
                else rf[q][j] = *(const f32x4*)((const float*)X + (size_t)(m0 + r4 + q) * D + 4 * lane + 256 * j); }
#pragma unroll
        for (int q = 0; q < 4; ++q) { const int m = m0 + r4 + q;
        f32x4 v[4]; float ss = 0.f;
#pragma unroll
        for (int j = 0; j < 4; ++j) {
            if (XB16) { const v2u w = rb[q][j]; v[j] = (f32x4){__uint_as_float(w.x << 16), __uint_as_float(w.x & 0xffff0000u), __uint_as_float(w.y << 16), __uint_as_float(w.y & 0xffff0000u)}; }
            else v[j] = rf[q][j];
            ss += (v[j].x * v[j].x + v[j].y * v[j].y) + (v[j].z * v[j].z + v[j].w * v[j].w); }
        const float rstd = __builtin_amdgcn_rsqf(wave_sum(ss) * (1.0f / D) + EPS);
#pragma unroll
        for (int j = 0; j < 4; ++j) { v[j] = v[j] * rstd * a[j] + sh[j];
            v2u o; o.x = pk2(v[j].x, v[j].y); o.y = pk2(v[j].z, v[j].w); *(v2u*)(H + (size_t)m * D + 4 * lane + 256 * j) = o; }
        if (FOXF) { float f[8];
#pragma unroll
            for (int qq = 0; qq < 8; ++qq) f[qq] = 0.f;
#pragma unroll
            for (int j = 0; j < 4; ++j)
#pragma unroll
                for (int e_ = 0; e_ < 4; ++e_) { const LAS float* wr = wf + (4 * lane + 256 * j + e_) * 8; const f32x4 w0 = *(const LAS f32x4*)wr, w1 = *(const LAS f32x4*)(wr + 4); const float hv = v[j][e_];
                    f[0] += hv * w0[0]; f[1] += hv * w0[1]; f[2] += hv * w0[2]; f[3] += hv * w0[3]; f[4] += hv * w1[0]; f[5] += hv * w1[1]; f[6] += hv * w1[2]; f[7] += hv * w1[3]; }
#pragma unroll
            for (int i = 0; i < 4; ++i) { const float snd = (lane & 1) ? f[i] : f[i + 4], kp = (lane & 1) ? f[i + 4] : f[i]; f[i] = kp + __shfl_xor(snd, 1); }
#pragma unroll
            for (int i = 0; i < 2; ++i) { const float snd = (lane & 2) ? f[i] : f[i + 2], kp = (lane & 2) ? f[i + 2] : f[i]; f[i] = kp + __shfl_xor(snd, 2); }
            { const float snd = (lane & 4) ? f[0] : f[1], kp = (lane & 4) ? f[1] : f[0]; f[0] = kp + __shfl_xor(snd, 4); }
            f[0] += __shfl_xor(f[0], 8); f[0] += __shfl_xor(f[0], 16); f[0] += __shfl_xor(f[0], 32);
            const int jidx = ((lane >> 2) & 1) + 2 * ((lane >> 1) & 1) + 4 * (lane & 1);
            if (lane < 8) { const float z = f[0] + p.b_f[jidx]; const float ls = fminf(z, 0.f) - log1pf(__expf(-fabsf(z))); ((float*)(p.ws + WS_LF))[(size_t)m * 8 + jidx] = ls; } }
        }
    }
    }
}
__device__ __forceinline__ void cumsum_item(const Params& p, int bh, LAS unsigned char* lds, int tid, int lane, int wave) {
    const float* LF = (const float*)(p.ws + WS_LF); float* KB = (float*)(p.ws + WS_KB);
    LAS float* wt = (LAS float*)lds;
    const int b = bh >> 3, h = bh & 7, s0 = tid * 8;
    float v[8]; float run = 0.f;
#pragma unroll
    for (int i = 0; i < 8; ++i) { run += LF[((size_t)b * SEQ + s0 + i) * 8 + h]; v[i] = run; }
    float inc = run;
    for (int o = 1; o < 64; o <<= 1) { const float t = __shfl_up(inc, o); if (lane >= o) inc += t; }
    if (lane == 63) wt[wave] = inc;
    __syncthreads();
    float pre = inc - run;
    for (int w = 0; w < wave; ++w) pre += wt[w];
    v4u* KB16 = (v4u*)(p.ws + WS_KB16);
#pragma unroll
    for (int i = 0; i < 8; ++i) { const float bv = -(pre + v[i]) * LOG2E; KB[(size_t)bh * SEQ + s0 + i] = bv;
        const unsigned h_ = f2bf(bv); const float r1 = bv - __uint_as_float(h_ << 16); const unsigned m_ = f2bf(r1); const float r2 = r1 - __uint_as_float(m_ << 16); const unsigned l_ = f2bf(r2);
        KB16[(size_t)bh * SEQ + s0 + i] = (v4u){h_ | (m_ << 16), l_, 0u, 0u}; }
    __syncthreads();
}

typedef __attribute__((address_space(1))) unsigned gu32;
#define XB_TMO      128
#define XB_XCNT(j)  (256  + 64 * (j))
#define XB_XSUB(j)  (1280 + 64 * (j))
#define XB_XGEN(j)  (2304 + 64 * (j))
#define XB_TOP      3328
#define XB_TOPGEN   3392
#define XCD_BAR_WORDS 3456
#define XB_SPIN_CAP (1u << 18)

__device__ __forceinline__ unsigned xb_ld(unsigned* p)              { return __hip_atomic_load(p, __ATOMIC_RELAXED, __HIP_MEMORY_SCOPE_AGENT); }
__device__ __forceinline__ unsigned xb_add(unsigned* p, unsigned v) { return __hip_atomic_fetch_add(p, v, __ATOMIC_RELAXED, __HIP_MEMORY_SCOPE_AGENT); }
__device__ __forceinline__ unsigned xb_xcc_id() { return (unsigned)__builtin_amdgcn_s_getreg((3 << 11) | 20) & 0xFu; }
#define XB_SPIN(cond, bar) do { unsigned _sp = 0; while (cond) { __builtin_amdgcn_s_sleep(1); \
    if ((++_sp & 255u) == 0u) { if (xb_ld(&(bar)[XB_TMO])) break; if (_sp > XB_SPIN_CAP) { atomicAdd(&(bar)[XB_TMO], 1u); break; } } } } while (0)

struct XcdBarrier {
    unsigned* bar; unsigned x;
    volatile LAS unsigned* st;
};

__device__ __forceinline__ XcdBarrier xcd_barrier_post(unsigned* bar, volatile LAS unsigned* st) {
    XcdBarrier b; b.bar = bar; b.x = xb_xcc_id(); b.st = st;
    if (threadIdx.x == 0) (void)xb_add(&bar[XB_XCNT(b.x)], 1u);
    return b;
}
__device__ __forceinline__ void xcd_barrier_complete(unsigned* bar, unsigned x, unsigned& nloc, unsigned& nx) {
    const unsigned G = gridDim.x * gridDim.y * gridDim.z;
    unsigned sum, cnt, mine, sp = 0u;
    for (;;) {
        sum = 0u; cnt = 0u; mine = 0u;
#pragma unroll
        for (unsigned j = 0; j < 16; ++j) { const unsigned c = xb_ld(&bar[XB_XCNT(j)]); sum += c; cnt += (c > 0u) ? 1u : 0u; mine = (j == x) ? c : mine; }
        if (sum == G) break;
        __builtin_amdgcn_s_sleep(1);
        if ((++sp & 255u) == 0u) { if (xb_ld(&bar[XB_TMO])) break; if (sp > XB_SPIN_CAP) { atomicAdd(&bar[XB_TMO], 1u); break; } }
    }
    nloc = mine > 0u ? mine : 1u; nx = cnt > 0u ? cnt : 1u;
}

__device__ __forceinline__ void xcd_barrier(const XcdBarrier& b) {
    asm volatile("s_waitcnt vmcnt(0)" ::: "memory");
    __syncthreads();
    if (threadIdx.x == 0) {
        unsigned* bar = b.bar;
        __builtin_amdgcn_s_waitcnt(0);
        unsigned nloc = b.st[0], nx = b.st[1];
        if (nloc == 0u) { xcd_barrier_complete(bar, b.x, nloc, nx); b.st[0] = nloc; b.st[1] = nx; }
        const unsigned old = xb_add(&bar[XB_XSUB(b.x)], 1u);
        const unsigned gen = old / nloc;
        if (old + 1u == (gen + 1u) * nloc) {
            __builtin_amdgcn_fence(__ATOMIC_RELEASE, "agent");
            asm volatile("s_waitcnt vmcnt(0)" ::: "memory");
            const unsigned og = xb_add(&bar[XB_TOP], 1u);
            const unsigned tg = og / nx;
            if (og + 1u == (tg + 1u) * nx) xb_add(&bar[XB_TOPGEN], 1u);
            else XB_SPIN(xb_ld(&bar[XB_TOPGEN]) == tg, bar);
            __builtin_amdgcn_fence(__ATOMIC_ACQUIRE, "agent");
            xb_add(&bar[XB_XGEN(b.x)], 1u);
            asm volatile("s_waitcnt vmcnt(0)" ::: "memory");
        } else {
            XB_SPIN(xb_ld(&bar[XB_XGEN(b.x)]) == gen, bar);
            __builtin_amdgcn_fence(__ATOMIC_ACQUIRE, "agent");
            asm volatile("s_waitcnt vmcnt(0)" ::: "memory");
        }
    }
    __syncthreads();
}

#ifndef RESID_ALIGN
#define RESID_ALIGN true
#endif
#ifndef FOX_PIPE
#define FOX_PIPE 1
#endif
#ifndef DUP_MISC
#define DUP_MISC 0
#endif
#ifndef DUP_ATT_FOX
#define DUP_ATT_FOX 0
#endif
#ifndef DUP_ATT_SB
#define DUP_ATT_SB 1
#endif
#ifndef DUP_GU
#define DUP_GU 0
#endif
#ifndef DUP_D1
#define DUP_D1 0
#endif
#ifndef DUP_SYNC
#define DUP_SYNC 0
#endif
__global__ void __launch_bounds__(NWAVES * 64, 2) hymba_fwd(Params p) {
    extern __shared__ __attribute__((aligned(16))) unsigned char lds_raw[];
    LAS unsigned char* lds = (LAS unsigned char*)lds_raw;
    cg::grid_group grid = cg::this_grid();
    const int wave = __builtin_amdgcn_readfirstlane((int)threadIdx.x >> 6);
    const int G = gridDim.x, bx = blockIdx.x;
#define FRESH_TID() int tid = threadIdx.x; asm volatile("" : "+v"(tid)); const int lane = tid & 63
    const int vcu = (G % 8 == 0) ? (bx % 8) * (G / 8) + bx / 8 : bx;
    const int gw = vcu * NWAVES + wave, NGW = G * NWAVES;
    unsigned char* ws = p.ws;
    volatile LAS unsigned* MISC = (volatile LAS unsigned*)(lds + MISC_OFF);
    if (threadIdx.x < 32) MISC[threadIdx.x] = 0u;
    unsigned* barw = (unsigned*)(ws + WS_CTL);
    __syncthreads();
    XcdBarrier xbar = xcd_barrier_post(barw, MISC + 8);
    if (ws == nullptr) grid.sync();
    float* mod = (float*)(ws + WS_MOD);
    bf16 *W1GU = (bf16*)(ws + WS_W1GU), *W1D = (bf16*)(ws + WS_W1D), *W2GU = (bf16*)(ws + WS_W2GU), *W2D = (bf16*)(ws + WS_W2D), *WIN = (bf16*)(ws + WS_WIN), *WO = (bf16*)(ws + WS_WO);
    bf16 *H = (bf16*)(ws + WS_H), *ACT = (bf16*)(ws + WS_ACT), *X1 = (bf16*)(ws + WS_X1);

    for (int rep_ = 0; rep_ < 1 + DUP_MISC; ++rep_)
    { FRESH_TID(); for (int nb = bx; nb < NMOD / 128; nb += G) mod_item(p, nb, lds, tid);
      LAS float* scr = (LAS float*)(lds + wave * 16384); int base = 0;
      convert_matrix(p.w1_gate, D, FF, FF, W1GU, 1, base, gw, NGW, scr, lane);
      convert_matrix(p.w1_up, D, FF, FF, W1GU, 2, base, gw, NGW, scr, lane);
      convert_matrix(p.w1_down, FF, D, D, W1D, 0, base, gw, NGW, scr, lane);
      convert_matrix(p.w_in, D, INW, NQKV, WIN, 3, base, gw, NGW, scr, lane);
      convert_matrix(p.w_o, D, D, D, WO, 0, base, gw, NGW, scr, lane);
      convert_matrix(p.w2_gate, D, FF, FF, W2GU, 1, base, gw, NGW, scr, lane);
      convert_matrix(p.w2_up, D, FF, FF, W2GU, 2, base, gw, NGW, scr, lane);
      convert_matrix(p.w2_down, FF, D, D, W2D, 0, base, gw, NGW, scr, lane); }
    xcd_barrier(xbar);
    for (int rep_ = 0; rep_ < 10 * DUP_SYNC; ++rep_) xcd_barrier(xbar);
    for (int rep_ = 0; rep_ < 1 + DUP_MISC; ++rep_)
    { FRESH_TID(); norm_phase<false, false>(p, p.x, p.g_ffn1, 0 * D, 1 * D, H, lds, gw, NGW, lane, tid); }
    xcd_barrier(xbar);
    for (int rep_ = 0; rep_ < 1 + DUP_GU; ++rep_)
    { pg8::Gemm g{H, W1GU, M, 2 * FF, D}; pg8::StaticOrder S; S.init(M, 2 * FF, G, bx); pg8::EpiSwiGLU E{ACT, FF};
      pg8::gemm_phase<pg8::EpiSwiGLU, pg8::StaticOrder, true, true>(lds, g, S, E); }
    xcd_barrier(xbar);
    for (int rep_ = 0; rep_ < 1 + DUP_D1; ++rep_)
    { pg8::Gemm g{ACT, W1D, M, D, FF}; pg8::StaticOrder S; S.init(M, D, G, bx); pg8::EpiResid<false, true> E{p.x, X1, mod + 2 * D, 0.5f};
      pg8::gemm_phase<pg8::EpiResid<false, true>, pg8::StaticOrder, RESID_ALIGN, true>(lds, g, S, E); }
    xcd_barrier(xbar);
    for (int rep_ = 0; rep_ < 1 + DUP_MISC; ++rep_)
    { FRESH_TID(); norm_phase<true, true>(p, X1, p.g_mix, 3 * D, 4 * D, H, lds, gw, NGW, lane, tid); }
    xcd_barrier(xbar);
    if (bx < 64) { FRESH_TID(); cumsum_item(p, bx, lds, tid, lane, wave); }
    { pg8::Gemm g{H, WIN, M, NQKV, D}; pg8::StaticOrder S; S.init(M, NQKV, G, bx); pg8::EpiQKV E{ACT, p.g_q, p.g_k, 0.125f * LOG2E};
      pg8::gemm_phase<pg8::EpiQKV, pg8::StaticOrder, true, true>(lds, g, S, E); }
    xcd_barrier(xbar);
    { const float* KB = (const float*)(ws + WS_KB); unsigned* qctr = (unsigned*)(ws + WS_CTL + 65536);
      { FRESH_TID(); float a = fabsf(p.g_q[wave * 64 + lane]), c = fabsf(p.g_k[wave * 64 + lane]);
#pragma unroll
        for (int o_ = 1; o_ < 64; o_ <<= 1) { a = fmaxf(a, __shfl_xor(a, o_)); c = fmaxf(c, __shfl_xor(c, o_)); }
        if (lane == 0) MISC[24 + wave] = __float_as_uint(64.0f * 0.125f * LOG2E * a * c * 1.02f + 0.5f); }
      const unsigned home = xbar.x & 7u;
      for (unsigned kq = 0; kq < 8u; ++kq) {
          const unsigned qi = (home + kq) & 7u; unsigned* qc = qctr + 64 * qi;
          if (threadIdx.x == 0) MISC[16] = atomicAdd(qc, 1u);
          __syncthreads();
          for (;;) {
              const unsigned u = MISC[16];
              if (u >= 256u) break;
              const int kind = (u < 128u) ? 1 : 0, v = u & 127, qb = 15 - (v >> 3), b = (int)qi, h = v & 7;
              const float sbound = __uint_as_float(MISC[24 + h]);
              if (kind) fox::fox_unit<8>(b, h, qb, ACT, KB, (const fox::u32x4*)(ws + WS_KB16), sbound, H, lds, qc, MISC + 16);
              else att::attn_unit<false>(b, h, qb, ACT, KB, p.g_q, p.g_k, H, lds, qc, MISC + 16);
          }
          __syncthreads();
      } }
    xcd_barrier(xbar);
    { pg8::Gemm g{H, WO, M, D, D}; pg8::StaticOrder S; S.init(M, D, G, bx); pg8::EpiResid<true, true> E{X1, X1, mod + 5 * D, 1.0f};
      pg8::gemm_phase<pg8::EpiResid<true, true>, pg8::StaticOrder, RESID_ALIGN, true>(lds, g, S, E); }
    xcd_barrier(xbar);
    for (int rep_ = 0; rep_ < 1 + DUP_MISC; ++rep_)
    { FRESH_TID(); norm_phase<false, true>(p, X1, p.g_ffn2, 6 * D, 7 * D, H, lds, gw, NGW, lane, tid); }
    xcd_barrier(xbar);
    { pg8::Gemm g{H, W2GU, M, 2 * FF, D}; pg8::StaticOrder S; S.init(M, 2 * FF, G, bx); pg8::EpiSwiGLU E{ACT, FF};
      pg8::gemm_phase<pg8::EpiSwiGLU, pg8::StaticOrder, true, true>(lds, g, S, E); }
    xcd_barrier(xbar);
    { pg8::Gemm g{ACT, W2D, M, D, FF}; pg8::StaticOrder S; S.init(M, D, G, bx); pg8::EpiResid<true, false> E{X1, p.out, mod + 8 * D, 0.5f};
      pg8::gemm_phase<pg8::EpiResid<true, false>, pg8::StaticOrder, RESID_ALIGN, true>(lds, g, S, E); }
}

extern "C" void kernel_launch(void* const* d_in, const int* in_sizes, int n_in, void* d_out, int out_size, void* d_ws, size_t ws_size, hipStream_t stream) {
    static int grid = 0;
    if (grid == 0) {
        if (n_in != 18 || in_sizes[0] != M * D || out_size != M * D || ws_size < WS_END) { fprintf(stderr, "kernel_launch: unexpected shapes (n_in %d, in0 %d, out %d, ws %zu)\n", n_in, n_in > 0 ? in_sizes[0] : -1, out_size, ws_size); grid = -1; return; }
        int dev = 0, cus = 0, per_cu = 0;
        (void)hipGetDevice(&dev); (void)hipDeviceGetAttribute(&cus, hipDeviceAttributeMultiprocessorCount, dev);
        if (hipFuncSetAttribute((const void*)hymba_fwd, hipFuncAttributeMaxDynamicSharedMemorySize, LDS_BYTES) != hipSuccess) { fprintf(stderr, "kernel_launch: hipFuncSetAttribute failed\n"); grid = -1; return; }
        if (hipOccupancyMaxActiveBlocksPerMultiprocessor(&per_cu, (const void*)hymba_fwd, NWAVES * 64, LDS_BYTES) != hipSuccess || per_cu < 1) { fprintf(stderr, "kernel_launch: occupancy query says %d\n", per_cu); per_cu = 1; }
        (void)hipGetLastError();
        grid = cus * per_cu;
    }
    if (grid < 0) return;
    if (hipMemsetAsync((char*)d_ws + WS_CTL, 0, 131072, stream) != hipSuccess) { fprintf(stderr, "kernel_launch: memset of control words failed\n"); return; }
    Params p{};
    const float** pp = (const float**)&p;
    for (int i = 0; i < 18; ++i) pp[i] = (const float*)d_in[i];
    p.out = (float*)d_out; p.ws = (unsigned char*)d_ws;
    void* args[] = {&p};
    hipError_t e = hipLaunchCooperativeKernel((const void*)hymba_fwd, dim3(grid), dim3(NWAVES * 64), args, LDS_BYTES, stream);
    if (e != hipSuccess) fprintf(stderr, "cooperative launch failed: %s (grid %d)\n", hipGetErrorString(e), grid);
}
```

```cpp
#include <hip/hip_runtime.h>
#include <hip/hip_cooperative_groups.h>
#include <hip/hip_bf16.h>
#include <cstdio>
#include <cstdint>
#include <cmath>
namespace cg = cooperative_groups;
namespace pg8 {
#define PG8_LAS __attribute__((address_space(3)))
typedef unsigned short bf16_t;
typedef short bf16x8 __attribute__((ext_vector_type(8)));
typedef float f32x4 __attribute__((ext_vector_type(4)));
typedef unsigned u32x4 __attribute__((ext_vector_type(4)));
constexpr int BM = 256, BK = 64, HALF = 128, HTB = HALF * BK * 2  , STAGE_BYTES = 8 * HTB, NXCD = 8, WGM = 8;

__host__ __device__ __forceinline__ int lds_byte(int r, int c) { const int st = (r >> 4) * 2 + (c >> 5), rr = r & 15, cc = c & 31, ob = rr * 64 + cc * 2; return st * 1024 + (ob ^ (((ob >> 9) & 1) << 5)); }
__host__ __device__ __forceinline__ void stage_rc(int b, int& R, int& C) { const int st = b / 1024, sb = b % 1024, swz = sb ^ (((sb >> 9) & 1) << 5); R = (st >> 1) * 16 + swz / 64; C = (st & 1) * 32 + (swz % 64) / 2; }
__host__ __device__ __forceinline__ int perm32(int rho) { const int n = rho >> 4, i = rho & 15; return 8 * (i >> 2) + 4 * n + (i & 3); }

struct Unit { int pm, pn; };
struct Gemm { const bf16_t* A; const bf16_t* Bt; int M, N, K; };

struct StaticOrder {
    int nM, nN, nwg, G, c;
    __host__ __device__ void init(int M, int N, int G_, int c_) { nM = M / BM; nN = N / BM; nwg = nM * nN; G = G_; c = c_; }
    __host__ __device__ bool next(int i, Unit& u) const {
        const long L = (long)i * G + c; if (L >= nwg) return false;
        int wgid = (int)L; { const int q = nwg / NXCD, r = nwg % NXCD, xcd = wgid % NXCD, off = wgid / NXCD; wgid = (xcd < r ? xcd * (q + 1) : r * (q + 1) + (xcd - r) * q) + off; }
        const int nig = WGM * nN, gid = wgid / nig, fm = gid * WGM, gsz = (nM - fm) < WGM ? (nM - fm) : WGM;
        u.pm = fm + ((wgid % nig) % gsz); u.pn = (wgid % nig) / gsz; return true;
    }
    __device__ __forceinline__ void a_ready(const Unit&) const {}
    __device__ __forceinline__ void done(const Unit&) const {}
};

__device__ __forceinline__ unsigned cvt_pk_bf16(float lo, float hi) { unsigned r; asm volatile("v_cvt_pk_bf16_f32 %0, %1, %2" : "=v"(r) : "v"(lo), "v"(hi)); return r; }
typedef float f32x2 __attribute__((ext_vector_type(2)));
typedef unsigned u32x2 __attribute__((ext_vector_type(2)));
__device__ __forceinline__ float fast_rcp(float x) { return __builtin_amdgcn_rcpf(x); }
__device__ __forceinline__ float fast_exp2(float x) { return __builtin_amdgcn_exp2f(x); }
struct EpiSwiGLU {
    static constexpr bool PERM = true, AFTER_DRAIN = false;
    bf16_t* O; int ldc;
    __device__ __forceinline__ void operator()(const f32x4 (&acc)[2][2][4][2], const Unit& u, int wr, int wc, int fr, int fq) const {
        typedef float f32x2v __attribute__((ext_vector_type(2)));
        const int row0 = u.pm * BM + wr * 64 + fr; const int col0 = u.pn * HALF + wc * 32 + 8 * fq;
#pragma unroll
        for (int ai = 0; ai < 2; ++ai)
#pragma unroll
            for (int m = 0; m < 4; ++m) {
                bf16_t* rowp = O + (size_t)(row0 + ai * HALF + m * 16) * ldc + col0;
                f32x2v r[4];
#pragma unroll
                for (int n = 0; n < 2; ++n)
#pragma unroll
                    for (int e = 0; e < 4; e += 2) { const f32x2v a = (f32x2v){acc[ai][0][m][n][e], acc[ai][0][m][n][e + 1]}, up = (f32x2v){acc[ai][1][m][n][e], acc[ai][1][m][n][e + 1]};
                        f32x2v t; t.x = fast_exp2(a.x); t.y = fast_exp2(a.y);
                        const f32x2v den = t + 1.0f; f32x2v rc; rc.x = fast_rcp(den.x); rc.y = fast_rcp(den.y);
                        r[n * 2 + (e >> 1)] = (a * up) * rc; }
                u32x4 w; w.x = cvt_pk_bf16(r[0].x, r[0].y); w.y = cvt_pk_bf16(r[1].x, r[1].y); w.z = cvt_pk_bf16(r[2].x, r[2].y); w.w = cvt_pk_bf16(r[3].x, r[3].y);
                *(u32x4*)rowp = w;
            }
    }
};
__device__ __forceinline__ f32x4 bf2f_lo(u32x2 w) { return (f32x4){__uint_as_float(w.x << 16), __uint_as_float(w.x & 0xffff0000u), __uint_as_float(w.y << 16), __uint_as_float(w.y & 0xffff0000u)}; }
template <bool BIN, bool BOUT> struct EpiResid {
    static constexpr bool PERM = true, AFTER_DRAIN = false;
    const void* base; void* out; const float* gate; float mul;
    __device__ __forceinline__ void operator()(const f32x4 (&acc)[2][2][4][2], const Unit& u, int wr, int wc, int fr, int fq) const {
        const int row0 = u.pm * BM + wr * 64 + fr; const int col0 = u.pn * BM + wc * 32 + 8 * fq;
        const float* grow = gate + (size_t)(u.pm >> 4) * 9216 + col0;
        f32x4 gv[2][2];
#pragma unroll
        for (int bj = 0; bj < 2; ++bj)
#pragma unroll
            for (int n = 0; n < 2; ++n) { const f32x4 g = *(const f32x4*)(grow + bj * HALF + 4 * n); gv[bj][n] = (g + 1.0f) * mul; }
        if (BIN) {
#pragma unroll
            for (int ai = 0; ai < 2; ++ai) {
                u32x4 bw[4][2];
#pragma unroll
                for (int m = 0; m < 4; ++m)
#pragma unroll
                    for (int bj = 0; bj < 2; ++bj) bw[m][bj] = *(const u32x4*)((const bf16_t*)base + (size_t)(row0 + ai * HALF + m * 16) * 1024 + col0 + bj * HALF);
                asm volatile("" ::: "memory");
#pragma unroll
                for (int m = 0; m < 4; ++m) { const size_t off = (size_t)(row0 + ai * HALF + m * 16) * 1024 + col0;
#pragma unroll
                    for (int bj = 0; bj < 2; ++bj) { const u32x4 w_ = bw[m][bj]; const f32x4 b0 = bf2f_lo((u32x2){w_.x, w_.y}), b1 = bf2f_lo((u32x2){w_.z, w_.w});
                        const f32x4 o0 = b0 + gv[bj][0] * acc[ai][bj][m][0], o1 = b1 + gv[bj][1] * acc[ai][bj][m][1];
                        if (BOUT) { u32x4 w; w.x = cvt_pk_bf16(o0[0], o0[1]); w.y = cvt_pk_bf16(o0[2], o0[3]); w.z = cvt_pk_bf16(o1[0], o1[1]); w.w = cvt_pk_bf16(o1[2], o1[3]); *(u32x4*)((bf16_t*)out + off + bj * HALF) = w; }
                        else { *(f32x4*)((float*)out + off + bj * HALF) = o0; *(f32x4*)((float*)out + off + bj * HALF + 4) = o1; } } }
                asm volatile("" ::: "memory");
            }
        } else {
#pragma unroll
            for (int ai = 0; ai < 2; ++ai)
#pragma unroll
                for (int m = 0; m < 4; ++m) { const size_t off = (size_t)(row0 + ai * HALF + m * 16) * 1024 + col0;
#pragma unroll
                    for (int bj = 0; bj < 2; ++bj) { const f32x4 b0 = *(const f32x4*)((const float*)base + off + bj * HALF), b1 = *(const f32x4*)((const float*)base + off + bj * HALF + 4);
                        const f32x4 o0 = b0 + gv[bj][0] * acc[ai][bj][m][0], o1 = b1 + gv[bj][1] * acc[ai][bj][m][1];
                        if (BOUT) { u32x4 w; w.x = cvt_pk_bf16(o0[0], o0[1]); w.y = cvt_pk_bf16(o0[2], o0[3]); w.z = cvt_pk_bf16(o1[0], o1[1]); w.w = cvt_pk_bf16(o1[2], o1[3]); *(u32x4*)((bf16_t*)out + off + bj * HALF) = w; }
                        else { *(f32x4*)((float*)out + off + bj * HALF) = o0; *(f32x4*)((float*)out + off + bj * HALF + 4) = o1; } }
                    if (m & 1) asm volatile("" ::: "memory"); }
        }
    }
};
struct EpiQKV {
    static constexpr bool PERM = true, AFTER_DRAIN = false;
    bf16_t* O; const float* gq; const float* gk; float qscale;
    __device__ __forceinline__ void operator()(const f32x4 (&acc)[2][2][4][2], const Unit& u, int wr, int wc, int fr, int fq) const {
        const int seg = u.pn >> 1, head = (u.pn & 1) * 4 + wc;
        const int row0 = u.pm * BM + wr * 64 + fr; const int col0 = u.pn * BM + wc * 64 + 8 * fq;
        const bool nrm = (seg == 3) || (seg == 4);
        const float sc = (seg == 0 || seg == 3) ? qscale : 1.0f;
        f32x4 gv[2][2];
#pragma unroll
        for (int bj = 0; bj < 2; ++bj)
#pragma unroll
            for (int n = 0; n < 2; ++n) { f32x4 g = (f32x4){1.f, 1.f, 1.f, 1.f};
                if (nrm) g = *(const f32x4*)((seg == 3 ? gq : gk) + head * 64 + bj * 32 + 8 * fq + 4 * n);
                gv[bj][n] = g * sc; }
#pragma unroll
        for (int ai = 0; ai < 2; ++ai)
#pragma unroll
            for (int m = 0; m < 4; ++m) {
                float rs = 1.0f;
                if (nrm) { float ss = 0.f;
#pragma unroll
                    for (int bj = 0; bj < 2; ++bj)
#pragma unroll
                        for (int n = 0; n < 2; ++n) { const f32x4 x = acc[ai][bj][m][n]; ss += (x[0] * x[0] + x[1] * x[1]) + (x[2] * x[2] + x[3] * x[3]); }
                    ss += __shfl_xor(ss, 16); ss += __shfl_xor(ss, 32);
                    rs = 1.0f / sqrtf(ss * (1.0f / 64.0f) + 1e-6f); }
                bf16_t* rowp = O + (size_t)(row0 + ai * HALF + m * 16) * 3072 + col0;
#pragma unroll
                for (int bj = 0; bj < 2; ++bj) { const f32x4 v0 = acc[ai][bj][m][0] * rs * gv[bj][0], v1 = acc[ai][bj][m][1] * rs * gv[bj][1];
                    u32x4 w; w.x = cvt_pk_bf16(v0[0], v0[1]); w.y = cvt_pk_bf16(v0[2], v0[3]); w.z = cvt_pk_bf16(v1[0], v1[1]); w.w = cvt_pk_bf16(v1[2], v1[3]);
                    *(u32x4*)(rowp + bj * 32) = w; }
            }
    }
};
template <class Epi, class Sched, bool ALIGN_EPI = false, bool SP2 = false>
__device__ __forceinline__ void gemm_phase(PG8_LAS unsigned char* lds, const Gemm g, const Sched& S, const Epi& E) {
    int tid_ = threadIdx.x; asm volatile("" : "+v"(tid_)); const int tid = tid_, wid = __builtin_amdgcn_readfirstlane(tid >> 6), lane = tid & 63, wr = wid >> 2, wc = wid & 3, fr = lane & 15, fq = lane >> 4;
    const int K = g.K, nt = K / BK;
    unsigned voffA[2], voffB[2];
#pragma unroll
    for (int i = 0; i < 2; ++i) { int R, C; stage_rc(tid * 16 + i * 8192, R, C); const int Rb = Epi::PERM ? ((R & ~31) + perm32(R & 31)) : R;
        voffA[i] = (unsigned)(R * K + C) * 2u; voffB[i] = (unsigned)(Rb * K + C) * 2u; }
    const size_t kstep = (size_t)(BK * 2);
    const size_t hstep = (size_t)HALF * K * 2;
    const size_t tstep = 2 * hstep;
    const unsigned ldsw = (unsigned)wid * 1024u;
    const int aoff = lds_byte(wr * 64 + fr, fq * 8), boff = lds_byte(wc * 32 + fr, fq * 8);
#define PG8_SA(b, h) (((b) * 2 + (h)) * HTB)
#define PG8_SB(b, h) ((4 + (b) * 2 + (h)) * HTB)
#define PG8_STAGE(bufoff, gbase, voff) do { _Pragma("unroll") for (int _i = 0; _i < 2; ++_i) \
        __builtin_amdgcn_global_load_lds((const unsigned*)((const char*)(gbase) + (voff)[_i]), (PG8_LAS unsigned*)(lds + (bufoff) + ldsw + _i * 8192), 16, 0, 0); } while (0)
#define PG8_LDA(dst, b, h) do { _Pragma("unroll") for (int m = 0; m < 4; ++m) _Pragma("unroll") for (int k = 0; k < 2; ++k) dst[m][k] = *(const PG8_LAS bf16x8*)(lds + PG8_SA(b, h) + aoff + m * 2048 + k * 1024); } while (0)
#define PG8_LDB(dst, b, h) do { _Pragma("unroll") for (int n = 0; n < 2; ++n) _Pragma("unroll") for (int k = 0; k < 2; ++k) dst[n][k] = *(const PG8_LAS bf16x8*)(lds + PG8_SB(b, h) + boff + n * 2048 + k * 1024); } while (0)
#define PG8_MMA(ai, bj, At, Bt) do { __builtin_amdgcn_s_setprio(1); _Pragma("unroll") for (int m = 0; m < 4; ++m) _Pragma("unroll") for (int n = 0; n < 2; ++n) _Pragma("unroll") for (int k = 0; k < 2; ++k) \
        acc[ai][bj][m][n] = __builtin_amdgcn_mfma_f32_16x16x32_bf16(Bt[n][k], At[m][k], acc[ai][bj][m][n], 0, 0, 0); __builtin_amdgcn_s_setprio(0); } while (0)
#define PG8_WAIT_V(n) asm volatile("s_waitcnt vmcnt(" #n ")" ::: "memory")
#define PG8_WAIT_L(n) asm volatile("s_waitcnt lgkmcnt(" #n ")" ::: "memory")
#define PG8_BAR __builtin_amdgcn_s_barrier()
#define PG8_SCHED __builtin_amdgcn_sched_barrier(0)
    Unit cur, nxt; int ui = 0;
    if (!S.next(0, cur)) return;
    f32x4 acc[2][2][4][2];
#pragma unroll
    for (int a = 0; a < 2; ++a)
#pragma unroll
        for (int b = 0; b < 2; ++b)
#pragma unroll
            for (int m = 0; m < 4; ++m)
#pragma unroll
                for (int n = 0; n < 2; ++n) acc[a][b][m][n] = (f32x4){0.f, 0.f, 0.f, 0.f};
    bf16x8 At[4][2], B0[2][2], B1[2][2];
    const char* cA = (const char*)g.A + (size_t)cur.pm * tstep; const char* cB = (const char*)g.Bt + (size_t)cur.pn * tstep;
    S.a_ready(cur);
    if constexpr (SP2) {
        PG8_STAGE(PG8_SB(0, 0), cB, voffB); PG8_STAGE(PG8_SB(0, 1), cB + hstep, voffB); PG8_STAGE(PG8_SA(0, 0), cA, voffA); PG8_STAGE(PG8_SA(0, 1), cA + hstep, voffA);
        if (wr == 1) PG8_BAR;
        PG8_WAIT_V(2); PG8_BAR;
        PG8_STAGE(PG8_SB(1, 0), cB + kstep, voffB); PG8_STAGE(PG8_SA(1, 0), cA + kstep, voffA); PG8_STAGE(PG8_SB(1, 1), cB + hstep + kstep, voffB);
        PG8_WAIT_V(6); PG8_BAR;
    } else {
        PG8_STAGE(PG8_SB(0, 0), cB, voffB); PG8_STAGE(PG8_SA(0, 0), cA, voffA); PG8_STAGE(PG8_SB(0, 1), cB + hstep, voffB); PG8_STAGE(PG8_SA(0, 1), cA + hstep, voffA);
        if (wr == 1) PG8_BAR;
        PG8_WAIT_V(4); PG8_BAR;
        PG8_STAGE(PG8_SB(1, 0), cB + kstep, voffB); PG8_STAGE(PG8_SA(1, 0), cA + kstep, voffA); PG8_STAGE(PG8_SB(1, 1), cB + hstep + kstep, voffB);
        PG8_WAIT_V(6); PG8_BAR;
    }
    for (;;) {
        const bool has_next = S.next(ui + 1, nxt);
        const char* nA = has_next ? (const char*)g.A + (size_t)nxt.pm * tstep : cA; const char* nB = has_next ? (const char*)g.Bt + (size_t)nxt.pn * tstep : cB;
        for (int t = 0; t < nt; t += 2) {
            const bool last = (t == nt - 2);
            const char* a1 = cA + (size_t)(t + 1) * kstep;
            const char* a2 = last ? nA : cA + (size_t)(t + 2) * kstep; const char* b2 = last ? nB : cB + (size_t)(t + 2) * kstep;
            const char* a3 = a2 + kstep; const char* b3 = b2 + kstep;
            if (last && has_next) S.a_ready(nxt);
            if constexpr (SP2) {
            PG8_LDB(B0, 0, 0); PG8_LDB(B1, 0, 1); PG8_SCHED; PG8_LDA(At, 0, 0); PG8_STAGE(PG8_SA(1, 1), a1 + hstep, voffA);
            PG8_WAIT_V(8); PG8_WAIT_L(0); PG8_BAR; PG8_MMA(0, 0, At, B0); PG8_MMA(0, 1, At, B1); PG8_BAR; PG8_SCHED;
            PG8_LDA(At, 0, 1); PG8_STAGE(PG8_SB(0, 0), b2, voffB); PG8_STAGE(PG8_SB(0, 1), b2 + hstep, voffB); PG8_STAGE(PG8_SA(0, 0), a2, voffA);
            PG8_WAIT_V(8); PG8_WAIT_L(0); PG8_BAR; PG8_MMA(1, 0, At, B0); PG8_MMA(1, 1, At, B1); PG8_BAR; PG8_SCHED;
            PG8_LDB(B0, 1, 0); PG8_LDB(B1, 1, 1); PG8_SCHED; PG8_LDA(At, 1, 0); PG8_STAGE(PG8_SA(0, 1), a2 + hstep, voffA);
            PG8_WAIT_V(8); PG8_WAIT_L(0); PG8_BAR; PG8_MMA(0, 0, At, B0); PG8_MMA(0, 1, At, B1); PG8_BAR; PG8_SCHED;
            PG8_LDA(At, 1, 1); PG8_STAGE(PG8_SB(1, 0), b3, voffB); PG8_STAGE(PG8_SB(1, 1), b3 + hstep, voffB); PG8_STAGE(PG8_SA(1, 0), a3, voffA);
            PG8_WAIT_V(8); PG8_WAIT_L(0); PG8_BAR; PG8_MMA(1, 0, At, B0); PG8_MMA(1, 1, At, B1); PG8_BAR; PG8_SCHED;
            } else {
            PG8_LDB(B0, 0, 0); PG8_SCHED; PG8_LDA(At, 0, 0); PG8_STAGE(PG8_SA(1, 1), a1 + hstep, voffA);
            PG8_WAIT_L(8); PG8_BAR; PG8_WAIT_L(0); PG8_MMA(0, 0, At, B0); PG8_BAR; PG8_SCHED;
            PG8_LDB(B1, 0, 1); PG8_STAGE(PG8_SB(0, 0), b2, voffB);
            PG8_BAR; PG8_WAIT_L(0); PG8_MMA(0, 1, At, B1); PG8_BAR;
            PG8_LDA(At, 0, 1); PG8_STAGE(PG8_SA(0, 0), a2, voffA);
            PG8_BAR; PG8_WAIT_L(0); PG8_MMA(1, 0, At, B0); PG8_BAR; PG8_SCHED;
            PG8_STAGE(PG8_SB(0, 1), b2 + hstep, voffB);
            PG8_WAIT_V(6); PG8_BAR; PG8_MMA(1, 1, At, B1); PG8_BAR;
            PG8_LDB(B0, 1, 0); PG8_SCHED; PG8_LDA(At, 1, 0); PG8_STAGE(PG8_SA(0, 1), a2 + hstep, voffA);
            PG8_WAIT_L(8); PG8_BAR; PG8_WAIT_L(0); PG8_MMA(0, 0, At, B0); PG8_BAR; PG8_SCHED;
            PG8_LDB(B1, 1, 1); PG8_STAGE(PG8_SB(1, 0), b3, voffB);
            PG8_BAR; PG8_WAIT_L(0); PG8_MMA(0, 1, At, B1); PG8_BAR;
            PG8_LDA(At, 1, 1); PG8_STAGE(PG8_SA(1, 0), a3, voffA);
            PG8_BAR; PG8_WAIT_L(0); PG8_MMA(1, 0, At, B0); PG8_BAR; PG8_SCHED;
            PG8_STAGE(PG8_SB(1, 1), b3 + hstep, voffB);
            PG8_WAIT_V(6); PG8_BAR; PG8_MMA(1, 1, At, B1); PG8_BAR;
            }
        }
        if constexpr (ALIGN_EPI) { if (wr == 0) PG8_BAR; }
        if constexpr (!Epi::AFTER_DRAIN) { E(acc, cur, wr, wc, fr, fq); S.done(cur); }
        if (!has_next) break;
#pragma unroll
        for (int a = 0; a < 2; ++a)
#pragma unroll
            for (int b = 0; b < 2; ++b)
#pragma unroll
                for (int m = 0; m < 4; ++m)
#pragma unroll
                    for (int n = 0; n < 2; ++n) acc[a][b][m][n] = (f32x4){0.f, 0.f, 0.f, 0.f};
        cur = nxt; cA = nA; cB = nB; ++ui;
        if constexpr (ALIGN_EPI) { if (wr == 1) PG8_BAR; }
    }
    PG8_WAIT_V(0);
    if constexpr (!ALIGN_EPI) { if (wr == 0) PG8_BAR; }
    PG8_BAR;
    if constexpr (Epi::AFTER_DRAIN) { E.fused(acc, cur, wr, wc, fr, fq, lds, wid, lane); S.done(cur); }
#undef PG8_SA
#undef PG8_SB
#undef PG8_STAGE
#undef PG8_LDA
#undef PG8_LDB
#undef PG8_MMA
#undef PG8_WAIT_V
#undef PG8_WAIT_L
#undef PG8_BAR
#undef PG8_SCHED
}
}
namespace att {
#define ALAS __attribute__((address_space(3)))
using bf16 = unsigned short;
using bf16x8 = __attribute__((ext_vector_type(8))) short;
using s16x4 = __attribute__((ext_vector_type(4))) short;
using f32x16 = __attribute__((ext_vector_type(16))) float;
using f32x4 = __attribute__((ext_vector_type(4))) float;
using u32x4 = __attribute__((ext_vector_type(4))) unsigned;
constexpr int SEQ = 4096, PITCH = 3072, OPITCH = 1024, QB = 256, KVBLK = 64;
constexpr int SLOTB = 8192;
constexpr int L_K = 0, L_V = 4 * SLOTB, L_B = 8 * SLOTB, L_WS = L_B + 512, L_FLAG = L_WS + 8 * 256, L_OST = L_FLAG + 64, L_BYTES = L_OST + 8 * 4096;
__device__ __forceinline__ int crow(int r, int hi) { return (r & 3) + 8 * (r >> 2) + 4 * hi; }
__device__ __forceinline__ void glds16(const void* gsrc, unsigned lds_dst) { unsigned keep;
    asm volatile("s_mov_b32 %0, m0\n\ts_mov_b32 m0, %2\n\ts_nop 0\n\tglobal_load_lds_dwordx4 %1, off\n\ts_mov_b32 m0, %0" : "=&s"(keep) : "v"(gsrc), "s"(lds_dst) : "memory"); }
__device__ __forceinline__ void glds4(const void* gsrc, unsigned lds_dst) { unsigned keep;
    asm volatile("s_mov_b32 %0, m0\n\ts_mov_b32 m0, %2\n\ts_nop 0\n\tglobal_load_lds_dword %1, off\n\ts_mov_b32 m0, %0" : "=&s"(keep) : "v"(gsrc), "s"(lds_dst) : "memory"); }
typedef float f32x2_t __attribute__((ext_vector_type(2))); typedef __bf16 bf16x2_t __attribute__((ext_vector_type(2)));
__device__ __forceinline__ unsigned cvtpk_s(float lo, float hi) { f32x2_t v = {lo, hi}; bf16x2_t b = __builtin_convertvector(v, bf16x2_t); return __builtin_bit_cast(unsigned, b); }
#define AWAIT_BAR() asm volatile("s_waitcnt vmcnt(0) lgkmcnt(0)\n\ts_barrier" ::: "memory")
#define ASBAR() __builtin_amdgcn_sched_barrier(0)
struct VFrag { s16x4 lo[8], hi[8]; };
__device__ __forceinline__ void v_issue(VFrag& f, int vb) {
#pragma unroll
    for (int i = 0; i < 8; ++i) {
        asm volatile("ds_read_b64_tr_b16 %0,%1 offset:%c2" : "=&v"(f.lo[i]) : "v"(vb), "i"((i >> 2) * 4096 + (i & 3) * 1024) : "memory");
        asm volatile("ds_read_b64_tr_b16 %0,%1 offset:%c2" : "=&v"(f.hi[i]) : "v"(vb), "i"((i >> 2) * 4096 + (i & 3) * 1024 + 512) : "memory"); }
}
__device__ __forceinline__ void pv_mma(f32x16* o, VFrag& f, bf16x8 pa0, bf16x8 pa1, bf16x8 pa2, bf16x8 pa3) {
    asm volatile("s_waitcnt lgkmcnt(0)" : "+v"(f.lo[0]), "+v"(f.lo[1]), "+v"(f.lo[2]), "+v"(f.lo[3]), "+v"(f.lo[4]), "+v"(f.lo[5]), "+v"(f.lo[6]), "+v"(f.lo[7]),
                                          "+v"(f.hi[0]), "+v"(f.hi[1]), "+v"(f.hi[2]), "+v"(f.hi[3]), "+v"(f.hi[4]), "+v"(f.hi[5]), "+v"(f.hi[6]), "+v"(f.hi[7]) :: "memory");
#define APK2(k) (bf16x8){f.lo[k][0], f.lo[k][1], f.lo[k][2], f.lo[k][3], f.hi[k][0], f.hi[k][1], f.hi[k][2], f.hi[k][3]}
    o[0] = __builtin_amdgcn_mfma_f32_32x32x16_bf16(pa0, APK2(0), o[0], 0, 0, 0); o[1] = __builtin_amdgcn_mfma_f32_32x32x16_bf16(pa0, APK2(4), o[1], 0, 0, 0);
    o[0] = __builtin_amdgcn_mfma_f32_32x32x16_bf16(pa1, APK2(1), o[0], 0, 0, 0); o[1] = __builtin_amdgcn_mfma_f32_32x32x16_bf16(pa1, APK2(5), o[1], 0, 0, 0);
    o[0] = __builtin_amdgcn_mfma_f32_32x32x16_bf16(pa2, APK2(2), o[0], 0, 0, 0); o[1] = __builtin_amdgcn_mfma_f32_32x32x16_bf16(pa2, APK2(6), o[1], 0, 0, 0);
    o[0] = __builtin_amdgcn_mfma_f32_32x32x16_bf16(pa3, APK2(3), o[0], 0, 0, 0); o[1] = __builtin_amdgcn_mfma_f32_32x32x16_bf16(pa3, APK2(7), o[1], 0, 0, 0);
#undef APK2
}
__device__ __forceinline__ void pv(f32x16* o, int vb, bf16x8 pa0, bf16x8 pa1, bf16x8 pa2, bf16x8 pa3) {
#pragma unroll
    for (int d0 = 0; d0 < 2; ++d0) { s16x4 lo[4], hi[4];
#pragma unroll
        for (int ks = 0; ks < 4; ++ks) {
            asm volatile("ds_read_b64_tr_b16 %0,%1 offset:%c2" : "=&v"(lo[ks]) : "v"(vb), "i"(d0 * 4096 + ks * 1024) : "memory");
            asm volatile("ds_read_b64_tr_b16 %0,%1 offset:%c2" : "=&v"(hi[ks]) : "v"(vb), "i"(d0 * 4096 + ks * 1024 + 512) : "memory"); }
        asm volatile("s_waitcnt lgkmcnt(0)" ::: "memory"); ASBAR();
#define APK(k) (bf16x8){lo[k][0], lo[k][1], lo[k][2], lo[k][3], hi[k][0], hi[k][1], hi[k][2], hi[k][3]}
        o[d0] = __builtin_amdgcn_mfma_f32_32x32x16_bf16(pa0, APK(0), o[d0], 0, 0, 0);
        o[d0] = __builtin_amdgcn_mfma_f32_32x32x16_bf16(pa1, APK(1), o[d0], 0, 0, 0);
        o[d0] = __builtin_amdgcn_mfma_f32_32x32x16_bf16(pa2, APK(2), o[d0], 0, 0, 0);
        o[d0] = __builtin_amdgcn_mfma_f32_32x32x16_bf16(pa3, APK(3), o[d0], 0, 0, 0);
#undef APK
    }
}
#ifndef SB_EARLY_EXIT
#define SB_EARLY_EXIT 1
#endif
#ifndef FOX_SKIP
#define FOX_SKIP 1
#endif
template <bool FOX>
__device__ __forceinline__ void attn_unit(int b, int h, int qb, const bf16* __restrict__ QKV, const float* __restrict__ kbias, const float* __restrict__ gq, const float* __restrict__ gk, bf16* O, ALAS unsigned char* lds, unsigned* qc, volatile ALAS unsigned* qslot) {
    int tid_ = threadIdx.x; asm volatile("" : "+v"(tid_)); const int tid = tid_, lane = tid & 63, r32 = lane & 31, hi = lane >> 5; const int wid = __builtin_amdgcn_readfirstlane(tid >> 6);
    const long rowbase = (long)b * SEQ; const int q0 = qb * QB;
    const int colq = (FOX ? 1536 : 0) + h * 64;
    const bf16* Qw = QKV + (rowbase + q0 + wid * 32) * PITCH + colq;
    const bf16* Kh = QKV + rowbase * PITCH + colq + 512; const bf16* Vh = QKV + rowbase * PITCH + colq + 1024;
    const unsigned lds0 = (unsigned)(uintptr_t)lds;
    ALAS float* wsf = (ALAS float*)(lds + L_WS) + wid * 64;
    ALAS unsigned* flags = (ALAS unsigned*)(lds + L_FLAG);
    const int kpos = lane, khi = (kpos >> 2) & 1, kr = (kpos & 3) + 4 * ((kpos & 31) >> 3), kkey = khi * 32 + (kpos >> 5) * 16 + kr;
    const bf16* ksrc = Kh + (long)kkey * PITCH + wid * 8;
    const int key16 = lane >> 2, vhi = (key16 >> 2) & 1, vj = (key16 & 3) + 4 * (key16 >> 3), vkey = vhi * 32 + (wid & 3) * 8 + vj;
    const bf16* vsrc = Vh + (long)vkey * PITCH + (wid >> 2) * 32 + (lane & 3) * 8;
    const float* bsrc = kbias + ((long)(b * 8 + h)) * SEQ + lane;
    const unsigned kdst = lds0 + L_K + wid * 1024, vdst = lds0 + L_V + wid * 1024, bdst = lds0 + L_B;
#define ADMA(t, slot) do { glds16(ksrc + (long)(t) * KVBLK * PITCH, (unsigned)__builtin_amdgcn_readfirstlane(kdst + (slot) * SLOTB)); \
                           glds16(vsrc + (long)(t) * KVBLK * PITCH, (unsigned)__builtin_amdgcn_readfirstlane(vdst + (slot) * SLOTB)); \
                           if (FOX && wid == 0) glds4(bsrc + (t) * KVBLK, (unsigned)__builtin_amdgcn_readfirstlane(bdst + (slot) * 256)); } while (0)
    const int vb0 = (int)(lds0 + L_V) + ((lane >> 4) & 1) * 32 + (lane & 3) * 8 + (4 * hi + ((lane & 15) >> 2)) * 64;
    const int NT = (q0 + QB) / KVBLK;
    if (lane == 0) flags[wid] = 0u;
    float sbound = 0.f;
    if (FOX && FOX_SKIP) { float a = fabsf(gq[h * 64 + lane]), c = fabsf(gk[h * 64 + lane]);
#pragma unroll
        for (int o_ = 1; o_ < 64; o_ <<= 1) { a = fmaxf(a, __shfl_xor(a, o_)); c = fmaxf(c, __shfl_xor(c, o_)); }
        sbound = 64.0f * 0.125f * 1.4426950408889634f * a * c * 1.02f + 0.5f; }
    if (FOX) { ADMA(NT - 1, 0); } else { ADMA(NT - 1, (NT - 1) & 3); ADMA(NT - 2, (NT - 2) & 3); ADMA(NT - 3, (NT - 3) & 3); }
    bf16x8 qr[4];
#pragma unroll
    for (int d0 = 0; d0 < 4; ++d0) qr[d0] = *reinterpret_cast<const bf16x8*>(&Qw[(long)r32 * PITCH + d0 * 16 + hi * 8]);
    f32x16 o[2]; o[0] = f32x16{}; o[1] = f32x16{};
    float m_run = -1e30f, l_run = 0.f, Rp = 1.0f;
    const int qpos = q0 + wid * 32 + r32;
    const int qlast = q0 + wid * 32 + 31;
    for (int it = 0; it < NT; ++it) {
        int t, slot;
        if (FOX) { t = NT - 1 - it; slot = it & 1; } else { t = (wid < 4) ? NT - 3 - it : NT - 1 - it; slot = t & 3; }
        AWAIT_BAR();
        if (FOX ? FOX_SKIP : SB_EARLY_EXIT) {
            const u32x4 f0 = *(ALAS const u32x4*)(flags), f1 = *(ALAS const u32x4*)(flags + 4);
            if ((f0.x & f0.y & f0.z & f0.w & f1.x & f1.y & f1.z & f1.w) != 0u) break;
        }
        if (FOX) { if (it + 1 < NT) ADMA(t - 1, slot ^ 1); }
        else { const int tn = NT - 4 - it; if (tn >= 0) ADMA(tn, tn & 3); if (t < 0) { if (lane == 0) flags[wid] = 1u; continue; } }
        if (KVBLK * t > qlast) continue;
        const bool band = (KVBLK * t + KVBLK - 1 > q0 + wid * 32 - (FOX ? 0 : 1));
        f32x16 p0, p1;
        if (FOX) { const ALAS f32x4* bp = (const ALAS f32x4*)(lds + L_B + slot * 256 + hi * 128);
            const f32x4 c0 = bp[0], c1 = bp[1], c2 = bp[2], c3 = bp[3], c4 = bp[4], c5 = bp[5], c6 = bp[6], c7 = bp[7];
            p0 = (f32x16){c0[0], c0[1], c0[2], c0[3], c1[0], c1[1], c1[2], c1[3], c2[0], c2[1], c2[2], c2[3], c3[0], c3[1], c3[2], c3[3]};
            p1 = (f32x16){c4[0], c4[1], c4[2], c4[3], c5[0], c5[1], c5[2], c5[3], c6[0], c6[1], c6[2], c6[3], c7[0], c7[1], c7[2], c7[3]};
        } else { p0 = f32x16{}; p1 = f32x16{}; }
        VFrag vf; v_issue(vf, vb0 + slot * SLOTB);
        { const ALAS unsigned char* kp = lds + L_K + slot * SLOTB + hi * 1024 + r32 * 16;
#pragma unroll
          for (int d0 = 0; d0 < 4; ++d0) { const bf16x8 b0 = *(const ALAS bf16x8*)(kp + d0 * 2048), b1 = *(const ALAS bf16x8*)(kp + d0 * 2048 + 512);
              p0 = __builtin_amdgcn_mfma_f32_32x32x16_bf16(b0, qr[d0], p0, 0, 0, 0); p1 = __builtin_amdgcn_mfma_f32_32x32x16_bf16(b1, qr[d0], p1, 0, 0, 0); } }
        const int kbase = KVBLK * t + hi * 32;
        if (FOX) {
            if (band) {
#pragma unroll
                for (int r = 0; r < 16; ++r) { if (kbase + r > qpos) p0[r] = -INFINITY; if (kbase + 16 + r > qpos) p1[r] = -INFINITY; } }
            float mx = fmaxf(p0[0], p1[0]);
#pragma unroll
            for (int r = 1; r < 16; ++r) mx = fmaxf(mx, fmaxf(p0[r], p1[r]));
            { auto rr = __builtin_amdgcn_permlane32_swap(__float_as_uint(mx), __float_as_uint(mx), false, false); mx = fmaxf(__uint_as_float(rr[0]), __uint_as_float(rr[1])); }
            const float m_new = fmaxf(m_run, mx);
            if (__any(m_new > m_run)) {
                const float alpha = __builtin_amdgcn_exp2f(m_run - m_new); l_run *= alpha; m_run = m_new;
                if (hi == 0) wsf[r32] = alpha;
                asm volatile("s_waitcnt lgkmcnt(0)" ::: "memory");
#pragma unroll
                for (int g = 0; g < 4; ++g) { const f32x4 a = *(const ALAS f32x4*)(wsf + 8 * g + 4 * hi);
#pragma unroll
                    for (int e = 0; e < 4; ++e) { o[0][4 * g + e] *= a[e]; o[1][4 * g + e] *= a[e]; } }
            }
            float sacc = 0.f;
#pragma unroll
            for (int r = 0; r < 16; ++r) { p0[r] = __builtin_amdgcn_exp2f(p0[r] - m_run); p1[r] = __builtin_amdgcn_exp2f(p1[r] - m_run); sacc += p0[r] + p1[r]; }
            l_run += sacc;
            if (FOX_SKIP) {
                const float b0 = *(const ALAS float*)(lds + L_B + slot * 256);
                const bool dead = __all(sbound + b0 - m_run < -150.0f);
                if (lane == 0) flags[wid] = dead ? 1u : 0u; }
        } else {
            float acc = 1.0f;
#pragma unroll
            for (int e = 31; e >= 0; --e) {
                const float tt = __builtin_amdgcn_exp2f(e < 16 ? p0[e] : p1[e - 16]);
                float kp_ = __builtin_amdgcn_rcpf(1.0f + tt);
                if (band) { const bool dead = (kbase + e >= qpos); kp_ = dead ? 1.0f : kp_; }
                const float accn = acc * kp_; const float w = acc - accn; acc = accn;
                if (e < 16) p0[e] = w; else p1[e - 16] = w;
            }
            auto rr = __builtin_amdgcn_permlane32_swap(__float_as_uint(acc), __float_as_uint(acc), false, false);
            const float t_lo = __uint_as_float(rr[0]), t_hi = __uint_as_float(rr[1]);
            const float off = hi ? Rp : Rp * t_hi;
#pragma unroll
            for (int r = 0; r < 16; ++r) { p0[r] *= off; p1[r] *= off; }
            Rp = Rp * t_lo * t_hi;
            if (SB_EARLY_EXIT) { const bool alldead = __all(Rp == 0.0f); if (lane == 0) flags[wid] = alldead ? 1u : 0u; }
        }
        u32x4 pw0, pw1, pw2, pw3;
        pw0 = (u32x4){cvtpk_s(p0[0], p0[1]), cvtpk_s(p0[2], p0[3]), cvtpk_s(p0[4], p0[5]), cvtpk_s(p0[6], p0[7])};
        pw1 = (u32x4){cvtpk_s(p0[8], p0[9]), cvtpk_s(p0[10], p0[11]), cvtpk_s(p0[12], p0[13]), cvtpk_s(p0[14], p0[15])};
        pw2 = (u32x4){cvtpk_s(p1[0], p1[1]), cvtpk_s(p1[2], p1[3]), cvtpk_s(p1[4], p1[5]), cvtpk_s(p1[6], p1[7])};
        pw3 = (u32x4){cvtpk_s(p1[8], p1[9]), cvtpk_s(p1[10], p1[11]), cvtpk_s(p1[12], p1[13]), cvtpk_s(p1[14], p1[15])};
        pv_mma(o, vf, __builtin_bit_cast(bf16x8, pw0), __builtin_bit_cast(bf16x8, pw1), __builtin_bit_cast(bf16x8, pw2), __builtin_bit_cast(bf16x8, pw3));
    }
    unsigned nxq = 0u; if (tid == 0) nxq = atomicAdd(qc, 1u);
    float rli[16];
    if (FOX) {
        { auto rr = __builtin_amdgcn_permlane32_swap(__float_as_uint(l_run), __float_as_uint(l_run), false, false); l_run = __uint_as_float(rr[0]) + __uint_as_float(rr[1]); }
        if (hi == 0) wsf[32 + r32] = l_run;
        asm volatile("s_waitcnt lgkmcnt(0)" ::: "memory");
#pragma unroll
        for (int r = 0; r < 16; ++r) rli[r] = __builtin_amdgcn_rcpf(wsf[32 + crow(r, hi)]);
    } else {
#pragma unroll
        for (int r = 0; r < 16; ++r) rli[r] = 1.0f;
    }
    bf16* Ow = O + (rowbase + q0 + wid * 32) * OPITCH + ((FOX ? 8 : 0) + h) * 64;
    { ALAS bf16* stg = (ALAS bf16*)(lds + L_OST) + wid * 2048;
#pragma unroll
      for (int r = 0; r < 16; ++r) { const int orow = crow(r, hi);
#pragma unroll
          for (int d0 = 0; d0 < 2; ++d0) stg[orow * 64 + d0 * 32 + r32] = (bf16)(cvtpk_s(o[d0][r] * rli[r], 0.f) & 0xffffu); }
      asm volatile("s_waitcnt lgkmcnt(0)" ::: "memory");
#pragma unroll
      for (int i = 0; i < 4; ++i) { const int row = i * 8 + (lane >> 3), ch = lane & 7; const u32x4 v = *(const ALAS u32x4*)(stg + row * 64 + ch * 8); *(u32x4*)(Ow + (long)row * OPITCH + ch * 8) = v; } }
    if (tid == 0) *qslot = nxq;
    asm volatile("s_waitcnt vmcnt(0) lgkmcnt(0)\n\ts_barrier" ::: "memory");
#undef ADMA
}
#undef AWAIT_BAR
#undef ASBAR
}
namespace fox {
using bf16 = unsigned short;
using bf16x8 = __attribute__((ext_vector_type(8))) short;
using s16x4 = __attribute__((ext_vector_type(4))) short;
using f32x16 = __attribute__((ext_vector_type(16))) float;
using f32x4 = __attribute__((ext_vector_type(4))) float;
using u32x4 = __attribute__((ext_vector_type(4))) unsigned;
constexpr int SEQ = 4096, DM = 3072, OPITCH = 1024, D = 64, NW = 8, QBLK = 32, QB = 256, KVBLK = 64;
__device__ __forceinline__ int crow(int r,int hi){return (r&3)+8*(r>>2)+4*hi;}
#define SBAR() __builtin_amdgcn_sched_barrier(0)
__device__ __forceinline__ void cmask(f32x16&p0,f32x16&p1,int jb,int qrel,int hi){
  const float NEG=-INFINITY; int kb=64*jb+4*hi;
  #pragma unroll
  for(int r=0;r<16;++r){int kv=kb+(r&3)+8*(r>>2); if(kv>qrel)p0[r]=NEG; if(kv+32>qrel)p1[r]=NEG;}
}

__device__ __forceinline__ void glds16(const void*gsrc,unsigned lds_dst){unsigned keep;
  asm volatile("s_mov_b32 %0, m0\n\ts_mov_b32 m0, %2\n\ts_nop 0\n\tglobal_load_lds_dwordx4 %1, off\n\ts_mov_b32 m0, %0":"=&s"(keep):"v"(gsrc),"s"(lds_dst):"memory");}
__device__ __forceinline__ float max3f(float a,float b,float c){float r;asm("v_max3_f32 %0, %1, %2, %3":"=v"(r):"v"(a),"v"(b),"v"(c));return r;}
__device__ __forceinline__ float max2f(float a,float b){float r;asm("v_max_f32_e32 %0, %1, %2":"=v"(r):"v"(a),"v"(b));return r;}
__device__ __forceinline__ float fadd_s(float a,float b){float r;asm("v_add_f32_e32 %0, %1, %2":"=v"(r):"v"(a),"v"(b));return r;}
__device__ __forceinline__ float fsub_s(float a,float b){float r;asm("v_sub_f32_e32 %0, %1, %2":"=v"(r):"v"(a),"v"(b));return r;}
typedef float f32x2_t __attribute__((ext_vector_type(2))); typedef __bf16 bf16x2_t __attribute__((ext_vector_type(2)));
__device__ __forceinline__ unsigned cvtpk_s(float lo,float hi){f32x2_t v={lo,hi};bf16x2_t b=__builtin_convertvector(v,bf16x2_t);return __builtin_bit_cast(unsigned,b);}
#define WAIT_BAR(N) asm volatile("s_waitcnt vmcnt(" #N ") lgkmcnt(0)\n\ts_barrier":::"memory")
typedef __attribute__((address_space(3))) const char* lds_cptr;
typedef short v4i16_t __attribute__((ext_vector_type(4)));
__device__ __forceinline__ void kload8(bf16x8*kf,lds_cptr kp){
  kf[0]=*(const __attribute__((address_space(3))) bf16x8*)(kp);      kf[1]=*(const __attribute__((address_space(3))) bf16x8*)(kp+512);
  kf[2]=*(const __attribute__((address_space(3))) bf16x8*)(kp+2048); kf[3]=*(const __attribute__((address_space(3))) bf16x8*)(kp+2560);
  kf[4]=*(const __attribute__((address_space(3))) bf16x8*)(kp+4096); kf[5]=*(const __attribute__((address_space(3))) bf16x8*)(kp+4608);
  kf[6]=*(const __attribute__((address_space(3))) bf16x8*)(kp+6144); kf[7]=*(const __attribute__((address_space(3))) bf16x8*)(kp+6656);
}
__device__ __forceinline__ void kload2(bf16x8*kf,lds_cptr kp,int j){ kf[2*j]=*(const __attribute__((address_space(3))) bf16x8*)(kp+j*2048); kf[2*j+1]=*(const __attribute__((address_space(3))) bf16x8*)(kp+j*2048+512); }
__device__ __forceinline__ s16x4 vtr(lds_cptr p){ return __builtin_bit_cast(s16x4,__builtin_amdgcn_ds_read_tr16_b64_v4i16((__attribute__((address_space(3))) v4i16_t*)p)); }
__device__ __forceinline__ float rowmax(const f32x16&p0,const f32x16&p1){
  float a=max3f(p0[0],p0[1],p1[0]),b=max3f(p0[2],p0[3],p1[1]);a=max3f(a,p1[2],p1[3]);
  #pragma unroll
  for(int r=4;r<16;r+=4){a=max3f(a,p0[r],p0[r+1]);b=max3f(b,p0[r+2],p0[r+3]);a=max3f(a,p1[r],p1[r+1]);b=max3f(b,p1[r+2],p1[r+3]);}
  const float m=max2f(a,b);
  auto rr=__builtin_amdgcn_permlane32_swap(__float_as_uint(m),__float_as_uint(m),false,false);
  return max2f(__uint_as_float(rr[0]),__uint_as_float(rr[1]));
}

__device__ __forceinline__ void pvd(f32x16* o, int vb, bf16x8 pa0, bf16x8 pa1, bf16x8 pa2, bf16x8 pa3) {
#pragma unroll
  for (int d0 = 0; d0 < 2; ++d0) { s16x4 lo[4], hi[4];
#pragma unroll
    for (int ks = 0; ks < 4; ++ks) {
      asm volatile("ds_read_b64_tr_b16 %0,%1 offset:%c2" : "=&v"(lo[ks]) : "v"(vb), "i"(d0 * 4096 + ks * 1024) : "memory");
      asm volatile("ds_read_b64_tr_b16 %0,%1 offset:%c2" : "=&v"(hi[ks]) : "v"(vb), "i"(d0 * 4096 + ks * 1024 + 512) : "memory"); }
    asm volatile("s_waitcnt lgkmcnt(0)" ::: "memory"); SBAR();
#define PK(k) (bf16x8){lo[k][0], lo[k][1], lo[k][2], lo[k][3], hi[k][0], hi[k][1], hi[k][2], hi[k][3]}
    o[d0] = __builtin_amdgcn_mfma_f32_32x32x16_bf16(pa0, PK(0), o[d0], 0, 0, 0);
    o[d0] = __builtin_amdgcn_mfma_f32_32x32x16_bf16(pa1, PK(1), o[d0], 0, 0, 0);
    o[d0] = __builtin_amdgcn_mfma_f32_32x32x16_bf16(pa2, PK(2), o[d0], 0, 0, 0);
    o[d0] = __builtin_amdgcn_mfma_f32_32x32x16_bf16(pa3, PK(3), o[d0], 0, 0, 0);
#undef PK
  }
}

constexpr int NSLOT = 3, SLOTB = 8192, KSLOTB = 9216;
constexpr int LDS_K = 0, LDS_V = NSLOT * KSLOTB, LDS_WS = LDS_V + NSLOT * SLOTB, LDS_OST = LDS_WS + NW * 64 * 4, LDS_BYTES = LDS_OST + NW * 4096;
#define KOFF(sl) ((sl) + ((sl) >> 3))
#define WB(n0, n1) do { if (wid == 0) { WAIT_BAR(n0); } else { WAIT_BAR(n1); } } while (0)
typedef __attribute__((address_space(3))) unsigned char* lds_ptr;
template <int THRL> __device__ __forceinline__ void fox_unit(int b, int h, int qb, const bf16* __restrict__ QKV, const float* __restrict__ kbias, const u32x4* __restrict__ kb16,
                                                             float sbound, bf16* O, lds_ptr shm, unsigned* qc, volatile __attribute__((address_space(3))) unsigned* qslot) {
  int tid_ = threadIdx.x; asm volatile("" : "+v"(tid_)); const int tid = tid_, lane = tid & 63, r32 = lane & 31, hi = lane >> 5; const int wid = __builtin_amdgcn_readfirstlane(tid >> 6);
  const long rowbase = (long)b * SEQ; const int q0 = qb * QB; const int colq = 1536 + h * D;
  const bf16* Qw = QKV + (rowbase + q0 + wid * QBLK) * DM + colq;
  const bf16* Kh = QKV + rowbase * DM + colq + 512; const bf16* Vh = QKV + rowbase * DM + colq + 1024;
  const float* kbh = kbias + (long)(b * 8 + h) * SEQ; const u32x4* kb16h = kb16 + (long)(b * 8 + h) * SEQ;
  const unsigned lds0 = (unsigned)(uintptr_t)shm;
  __attribute__((address_space(3))) float* wsf = (__attribute__((address_space(3))) float*)(shm + LDS_WS) + wid * 64;
  const int NT = (q0 + QB) / KVBLK;
  int T0 = 0;
  {
    const int tc = 2 * ((lane & 31) + 1);
    const bool valid = (lane < 32) && (tc <= NT - 4);
    const float bk = valid ? kbh[64 * tc - 1] : 0.f, bq = kbh[q0];
    const bool dead = valid && (bk < bq - 150.0f - 2.0f * sbound);
    T0 = 2 * __popcll(__ballot(dead)); }
  T0 = __builtin_amdgcn_readfirstlane(T0);
  const bf16* ksrc = Kh + (long)lane * DM + wid * 8;
  const bf16* vsrc = Vh + (long)(16 * (wid & 3) + (lane >> 2)) * DM + (wid >> 2) * 32 + (lane & 3) * 8;
  const u32x4* asrc = kb16h + lane;
  const unsigned kdst = lds0 + LDS_K + wid * 1024, adst = lds0 + LDS_K + 8192, vdst = lds0 + LDS_V + wid * 1024;
#define DMA_K(t, slot) do { glds16(ksrc + (long)(t) * KVBLK * DM, (unsigned)__builtin_amdgcn_readfirstlane(kdst + KOFF(slot))); \
                            if (wid == 0) glds16(asrc + (long)(t) * KVBLK, (unsigned)__builtin_amdgcn_readfirstlane(adst + KOFF(slot))); } while (0)
#define DMA_V(t, slot) glds16(vsrc + (long)(t) * KVBLK * DM, (unsigned)__builtin_amdgcn_readfirstlane(vdst + (slot)))
  const lds_cptr shm3 = (lds_cptr)shm; const lds_cptr kp0 = shm3 + LDS_K + hi * 1024 + r32 * 16; const lds_cptr ka0 = shm3 + LDS_K + 8192 + r32 * 16;
  const lds_cptr vp0 = shm3 + LDS_V + ((lane >> 4) & 1) * 32 + (lane & 3) * 8 + (4 * hi + ((lane & 15) >> 2)) * 64;
  const int vb0 = (int)(lds0 + LDS_V) + ((lane >> 4) & 1) * 32 + (lane & 3) * 8 + (4 * hi + ((lane & 15) >> 2)) * 64;
  bf16x8 kf[8], ka[2];
#define ALOAD(sl) do { ka[0] = *(const __attribute__((address_space(3))) bf16x8*)(ka0 + KOFF(sl)); ka[1] = *(const __attribute__((address_space(3))) bf16x8*)(ka0 + KOFF(sl) + 512); } while (0)
  DMA_K(T0, 0); DMA_V(T0, 0); DMA_K(T0 + 1, SLOTB);
  bf16x8 qr[4];
#pragma unroll
  for (int d0 = 0; d0 < 4; ++d0) qr[d0] = *reinterpret_cast<const bf16x8*>(&Qw[(long)r32 * DM + d0 * 16 + hi * 8]);
  const short one = hi ? (short)0 : (short)0x3F80;
  bf16x8 qa = (bf16x8){one, one, one, 0, 0, 0, 0, 0}; asm volatile("" : "+v"(qa));
  float l_reg = 0.f; f32x16 o[2]; o[0] = f32x16{}; o[1] = f32x16{};
  const int qrel = wid * QBLK + r32;
  f32x16 negm; { const float nb = -(kbh[q0 + qrel] + fmaxf(sbound - 40.0f, 0.0f));
    _Pragma("unroll") for (int r = 0; r < 16; ++r) negm[r] = nb; } asm volatile("" : "+v"(negm));
#define CMASK(P0, P1, t) do { int jb_ = (t) - (NT - 4); if (jb_ >= 0) cmask(P0, P1, jb_, qrel, hi); } while (0)
#define START(P0, P1) do { _Pragma("unroll") for (int r = 0; r < 16; ++r) P0[r] = __builtin_amdgcn_exp2f(P0[r]); } while (0)
#define RESC() do {} while (0)
  f32x16 pA0, pA1, pB0, pB1;
  int sl_prev = 0, sl_cur = 0, sl_next = SLOTB;
#define ROT() do { sl_prev = sl_cur; sl_cur = sl_next; sl_next = (sl_next == (NSLOT - 1) * SLOTB) ? 0 : sl_next + SLOTB; } while (0)
  DMA_K(T0 + 2, 2 * SLOTB);
  WB(5, 3);
  { kload8(kf, kp0); ALOAD(0);
    pA0 = __builtin_amdgcn_mfma_f32_32x32x16_bf16(kf[0], qr[0], negm, 0, 0, 0); pA1 = __builtin_amdgcn_mfma_f32_32x32x16_bf16(kf[1], qr[0], negm, 0, 0, 0);
    pA0 = __builtin_amdgcn_mfma_f32_32x32x16_bf16(kf[2], qr[1], pA0, 0, 0, 0);  pA1 = __builtin_amdgcn_mfma_f32_32x32x16_bf16(kf[3], qr[1], pA1, 0, 0, 0);
    pA0 = __builtin_amdgcn_mfma_f32_32x32x16_bf16(kf[4], qr[2], pA0, 0, 0, 0);  pA1 = __builtin_amdgcn_mfma_f32_32x32x16_bf16(kf[5], qr[2], pA1, 0, 0, 0);
    pA0 = __builtin_amdgcn_mfma_f32_32x32x16_bf16(kf[6], qr[3], pA0, 0, 0, 0);  pA1 = __builtin_amdgcn_mfma_f32_32x32x16_bf16(kf[7], qr[3], pA1, 0, 0, 0);
    pA0 = __builtin_amdgcn_mfma_f32_32x32x16_bf16(ka[0], qa, pA0, 0, 0, 0);     pA1 = __builtin_amdgcn_mfma_f32_32x32x16_bf16(ka[1], qa, pA1, 0, 0, 0); }
  asm volatile("s_nop 15\n\ts_nop 7" : "+v"(pA0), "+v"(pA1)); CMASK(pA0, pA1, T0);
  START(pA0, pA1);
  _Pragma("unroll") for (int r = 0; r < 16; ++r) pA1[r] = __builtin_amdgcn_exp2f(pA1[r]);
  WAIT_BAR(0);
  DMA_K(T0 + 3, 0); DMA_V(T0 + 1, SLOTB);
  ROT();
  kload8(kf, kp0 + KOFF(sl_cur)); ALOAD(sl_cur);
  WB(3, 2);
  s16x4 vlo[8], vhi[8]; u32x4 pw0, pw1, pw2, pw3;
#define PKW(P, B) cvtpk_s(P[B], P[B + 1])
#define PAF(k) __builtin_bit_cast(bf16x8, pw##k)
#define VFR(i) (bf16x8){vlo[i][0], vlo[i][1], vlo[i][2], vlo[i][3], vhi[i][0], vhi[i][1], vhi[i][2], vhi[i][3]}
#define PIN(x) asm volatile("" : "+v"(x))
#define MX3(a, b, c) __builtin_fmaxf(__builtin_fmaxf((a), (b)), (c))
#define GAPA(MF, A0, A1, A2, A3, W0, W1, PW) do { MF; sacc += A0; sacc += A1; sacc += A2; sacc += A3; PIN(sacc); W0; W1; PIN(PW); SBAR(); } while (0)
#define EX(v) __builtin_amdgcn_exp2f(v)
#define GAPB(MF, X, B) do { MF; X[B] = EX(X[B]); X[B + 1] = EX(X[B + 1]); X[B + 2] = EX(X[B + 2]); X[B + 3] = EX(X[B + 3]); PIN(X); SBAR(); } while (0)
#define VRD(i) do { vlo[i] = vtr(vp_ + (((i) >> 2) * 4096 + ((i) & 3) * 1024)); vhi[i] = vtr(vp_ + (((i) >> 2) * 4096 + ((i) & 3) * 1024 + 512)); } while (0)
#define KRD(G, j) do { if (G) { kload2(kf, kp0 + KOFF(sl_next), j); SBAR(); } } while (0)
#define KRDA(G) do { if (G) { ALOAD(sl_next); SBAR(); } } while (0)
#define STEP(C0, C1, P0, P1, t, GK, GV, GL) do { SBAR(); \
    const lds_cptr vp_ = vp0 + sl_prev; \
    VRD(0); SBAR(); float sacc = (P0[0] + P0[1]); \
    GAPA(C0 = __builtin_amdgcn_mfma_f32_32x32x16_bf16(kf[0], qr[0], negm, 0, 0, 0), P0[2], P0[3], P0[4], P0[5],     pw0[0] = PKW(P0, 0), pw0[1] = PKW(P0, 2), pw0); \
    VRD(4); SBAR(); GAPA(C1 = __builtin_amdgcn_mfma_f32_32x32x16_bf16(kf[1], qr[0], negm, 0, 0, 0), P0[6], P0[7], P0[8], P0[9],     pw0[2] = PKW(P0, 4), pw0[3] = PKW(P0, 6), pw0); \
    VRD(1); SBAR(); GAPA(C0 = __builtin_amdgcn_mfma_f32_32x32x16_bf16(kf[2], qr[1], C0, 0, 0, 0),   P0[10], P0[11], P0[12], P0[13], pw1[0] = PKW(P0, 8), pw1[1] = PKW(P0, 10), pw1); \
    VRD(5); SBAR(); GAPA(C1 = __builtin_amdgcn_mfma_f32_32x32x16_bf16(kf[3], qr[1], C1, 0, 0, 0),   P0[14], P0[15], P1[0], P1[1],   pw1[2] = PKW(P0, 12), pw1[3] = PKW(P0, 14), pw1); \
    VRD(2); SBAR(); GAPA(C0 = __builtin_amdgcn_mfma_f32_32x32x16_bf16(kf[4], qr[2], C0, 0, 0, 0),   P1[2], P1[3], P1[4], P1[5],     pw2[0] = PKW(P1, 0), pw2[1] = PKW(P1, 2), pw2); \
    VRD(6); SBAR(); GAPA(C1 = __builtin_amdgcn_mfma_f32_32x32x16_bf16(kf[5], qr[2], C1, 0, 0, 0),   P1[6], P1[7], P1[8], P1[9],     pw2[2] = PKW(P1, 4), pw2[3] = PKW(P1, 6), pw2); \
    VRD(3); SBAR(); GAPA(C0 = __builtin_amdgcn_mfma_f32_32x32x16_bf16(kf[6], qr[3], C0, 0, 0, 0),   P1[10], P1[11], P1[12], P1[13], pw3[0] = PKW(P1, 8), pw3[1] = PKW(P1, 10), pw3); \
    VRD(7); SBAR(); GAPA(C1 = __builtin_amdgcn_mfma_f32_32x32x16_bf16(kf[7], qr[3], C1, 0, 0, 0),   P1[14], P1[15], 0.f, 0.f,       pw3[2] = PKW(P1, 12), pw3[3] = PKW(P1, 14), pw3); \
    C0 = __builtin_amdgcn_mfma_f32_32x32x16_bf16(ka[0], qa, C0, 0, 0, 0); C1 = __builtin_amdgcn_mfma_f32_32x32x16_bf16(ka[1], qa, C1, 0, 0, 0); SBAR(); \
    l_reg += sacc; \
    if (GK) { DMA_K((t) + 3, sl_cur); } if (GV) { DMA_V((t) + 1, sl_next); } \
    CMASK(C0, C1, t); \
    SBAR(); \
    GAPB(o[0] = __builtin_amdgcn_mfma_f32_32x32x16_bf16(PAF(0), VFR(0), o[0], 0, 0, 0), C0, 0); \
    GAPB(o[1] = __builtin_amdgcn_mfma_f32_32x32x16_bf16(PAF(0), VFR(4), o[1], 0, 0, 0), C0, 4); \
    KRD(GL, 0); GAPB(o[0] = __builtin_amdgcn_mfma_f32_32x32x16_bf16(PAF(1), VFR(1), o[0], 0, 0, 0), C0, 8); \
    KRD(GL, 1); GAPB(o[1] = __builtin_amdgcn_mfma_f32_32x32x16_bf16(PAF(1), VFR(5), o[1], 0, 0, 0), C0, 12); \
    KRD(GL, 2); GAPB(o[0] = __builtin_amdgcn_mfma_f32_32x32x16_bf16(PAF(2), VFR(2), o[0], 0, 0, 0), C1, 0); \
    KRD(GL, 3); GAPB(o[1] = __builtin_amdgcn_mfma_f32_32x32x16_bf16(PAF(2), VFR(6), o[1], 0, 0, 0), C1, 4); \
    KRDA(GL); GAPB(o[0] = __builtin_amdgcn_mfma_f32_32x32x16_bf16(PAF(3), VFR(3), o[0], 0, 0, 0), C1, 8); \
    GAPB(o[1] = __builtin_amdgcn_mfma_f32_32x32x16_bf16(PAF(3), VFR(7), o[1], 0, 0, 0), C1, 12); \
    } while (0)
  int t = T0 + 1;
#undef CMASK
#define CMASK(P0, P1, t) do {} while (0)
  for (; t + 5 < NT; t += 2) {
    STEP(pB0, pB1, pA0, pA1, t, true, true, true);     WB(3, 2); RESC(); ROT();
    STEP(pA0, pA1, pB0, pB1, t + 1, true, true, true); WB(3, 2); RESC(); ROT();
  }
#undef CMASK
#define CMASK(P0, P1, t) do { int jb_ = (t) - (NT - 4); if (jb_ >= 0) cmask(P0, P1, jb_, qrel, hi); } while (0)
#define ENDW(tt) do { if ((tt) + 3 < NT) { WB(3, 2); } else if ((tt) + 2 < NT) { WAIT_BAR(1); } else { WAIT_BAR(0); } } while (0)
  for (; t + 1 < NT; t += 2) {
    STEP(pB0, pB1, pA0, pA1, t, (t + 3 < NT), (t + 1 < NT), (t + 1 < NT));         ENDW(t);     RESC(); ROT();
    STEP(pA0, pA1, pB0, pB1, t + 1, (t + 4 < NT), (t + 2 < NT), (t + 2 < NT));     ENDW(t + 1); RESC(); ROT();
  }
  STEP(pB0, pB1, pA0, pA1, NT - 1, false, false, false); RESC();
  { float sacc = pB0[0] + pB0[1]; _Pragma("unroll") for (int r = 2; r < 16; ++r) sacc += pB0[r]; _Pragma("unroll") for (int r = 0; r < 16; ++r) sacc += pB1[r]; l_reg += sacc;
    pw0 = (u32x4){PKW(pB0, 0), PKW(pB0, 2), PKW(pB0, 4), PKW(pB0, 6)}; pw1 = (u32x4){PKW(pB0, 8), PKW(pB0, 10), PKW(pB0, 12), PKW(pB0, 14)};
    pw2 = (u32x4){PKW(pB1, 0), PKW(pB1, 2), PKW(pB1, 4), PKW(pB1, 6)}; pw3 = (u32x4){PKW(pB1, 8), PKW(pB1, 10), PKW(pB1, 12), PKW(pB1, 14)};
    SBAR(); pvd(o, vb0 + sl_cur, PAF(0), PAF(1), PAF(2), PAF(3)); }
  unsigned nxq = 0u; if (tid == 0) nxq = atomicAdd(qc, 1u);
  { auto rr = __builtin_amdgcn_permlane32_swap(__float_as_uint(l_reg), __float_as_uint(l_reg), false, false); l_reg = __uint_as_float(rr[0]) + __uint_as_float(rr[1]); }
  if (hi == 0) wsf[32 + r32] = l_reg; asm volatile("s_waitcnt lgkmcnt(0)" ::: "memory");
  float rli[16];
#pragma unroll
  for (int r = 0; r < 16; ++r) rli[r] = __builtin_amdgcn_rcpf(wsf[32 + crow(r, hi)]);
  bf16* Ow = O + (rowbase + q0 + wid * QBLK) * OPITCH + (8 + h) * D;
  { __attribute__((address_space(3))) bf16* stg = (__attribute__((address_space(3))) bf16*)(shm + LDS_OST) + wid * 2048;
#pragma unroll
    for (int r = 0; r < 16; ++r) { const int orow = crow(r, hi);
#pragma unroll
      for (int d0 = 0; d0 < 2; ++d0) stg[orow * 64 + d0 * 32 + r32] = (bf16)(cvtpk_s(o[d0][r] * rli[r], 0.f) & 0xffffu); }
    asm volatile("s_waitcnt lgkmcnt(0)" ::: "memory");
#pragma unroll
    for (int i = 0; i < 4; ++i) { const int row = i * 8 + (lane >> 3), ch = lane & 7; const u32x4 v = *(const __attribute__((address_space(3))) u32x4*)(stg + row * 64 + ch * 8); *(u32x4*)(Ow + (long)row * OPITCH + ch * 8) = v; } }
  if (tid == 0) *qslot = nxq;
  asm volatile("s_waitcnt vmcnt(0) lgkmcnt(0)\n\ts_barrier" ::: "memory");
#undef DMA_K
#undef DMA_V
#undef ALOAD
#undef CMASK
#undef START
#undef RESC
#undef ROT
#undef PKW
#undef PAF
#undef VFR
#undef PIN
#undef MX3
#undef GAPA
#undef GAPB
#undef EX
#undef VRD
#undef KRD
#undef KRDA
#undef STEP
#undef ENDW
}
#undef KOFF
#undef SBAR
#undef WAIT_BAR
}
constexpr int NWAVES = 8;
constexpr int BATCH = 8, SEQ = 4096, D = 1024, FF = 2816, M = BATCH * SEQ, NMOD = 9 * D, INW = 3080, NQKV = 3072;
constexpr float EPS = 1e-6f, LOG2E = 1.4426950408889634f;
constexpr size_t MiB = 1u << 20;
constexpr size_t WS_MOD = 0, WS_LF = 1 * MiB, WS_KB = 2 * MiB, WS_CTL = 3 * MiB, WS_W1GU = 4 * MiB, WS_W1D = 16 * MiB, WS_W2GU = 22 * MiB, WS_W2D = 34 * MiB, WS_WIN = 40 * MiB, WS_WO = 46 * MiB, WS_KB16 = 48 * MiB,
                 WS_H = 64 * MiB, WS_ACT = 128 * MiB, WS_X1 = 320 * MiB, WS_END = 384 * MiB;
constexpr int RING_BYTES = 131072, MISC_OFF = RING_BYTES + 320, LDS_BYTES = 147456;
static_assert(att::L_BYTES <= RING_BYTES && fox::LDS_BYTES <= RING_BYTES, "attention LDS");
#define LAS __attribute__((address_space(3)))
typedef unsigned short bf16;
typedef unsigned v4u __attribute__((ext_vector_type(4)));
typedef unsigned v2u __attribute__((ext_vector_type(2)));
typedef float f32x4 __attribute__((ext_vector_type(4)));
__device__ __forceinline__ unsigned f2bf(float f) { unsigned u = __builtin_bit_cast(unsigned, f); return (u + 0x7fffu + ((u >> 16) & 1u)) >> 16; }
__device__ __forceinline__ unsigned pk2(float lo, float hi) { return f2bf(lo) | (f2bf(hi) << 16); }
__device__ __forceinline__ float wave_sum(float v) {
#pragma unroll
    for (int o = 1; o < 64; o <<= 1) v += __shfl_xor(v, o);
    return v;
}
struct Params {
    const float *x, *c, *w_mod, *b_mod, *g_ffn1, *w1_gate, *w1_up, *w1_down, *g_mix, *w_in, *b_f, *g_q, *g_k, *w_o, *g_ffn2, *w2_gate, *w2_up, *w2_down;
    float* out; unsigned char* ws;
};
__device__ __forceinline__ void transpose_item(const float* W, int K, int ldw, bf16* WT, int k0, int n0, int dst_n0, float scale, LAS float* scr, int lane) {
#pragma unroll
    for (int i = 0; i < 32; ++i) { const int kk = 2 * i + (lane >> 5); scr[kk * 33 + (lane & 31)] = W[(size_t)(k0 + kk) * ldw + n0 + (lane & 31)] * scale; }
    asm volatile("s_waitcnt lgkmcnt(0)" ::: "memory");
    const int c = lane & 7;
#pragma unroll
    for (int j = 0; j < 4; ++j) { const int n = (lane >> 3) + 8 * j; const LAS float* s = scr + (8 * c) * 33 + n;
        v4u o; o.x = pk2(s[0 * 33], s[1 * 33]); o.y = pk2(s[2 * 33], s[3 * 33]); o.z = pk2(s[4 * 33], s[5 * 33]); o.w = pk2(s[6 * 33], s[7 * 33]);
        *(v4u*)(WT + (size_t)(dst_n0 + n) * K + k0 + 8 * c) = o; }
    asm volatile("s_waitcnt lgkmcnt(0)" ::: "memory");
}
__device__ __forceinline__ int dst_row_block(int mode, int n0) {
    if (mode == 1) return 256 * (n0 >> 7) + (n0 & 127);
    if (mode == 2) return 256 * (n0 >> 7) + 128 + (n0 & 127);
    if (mode == 3) { const int pn = n0 >> 8, wc = (n0 >> 6) & 3, bj = (n0 >> 5) & 1; return 256 * pn + 128 * bj + 32 * wc; }
    return n0;
}
__device__ __forceinline__ void convert_matrix(const float* W, int K, int ldw, int N, bf16* WT, int mode, int& base, int gw, int NGW, LAS float* scr, int lane) {
    const int nblk = N / 32, items = (K / 64) * nblk;
    const float scale = (mode == 1) ? -1.4426950408889634f : (mode == 2) ? -0.6931471805599453f : 1.0f;
    int first = (gw - base % NGW + NGW) % NGW;
    for (int it = first; it < items; it += NGW) { const int kb = it / nblk, nb = it % nblk; transpose_item(W, K, ldw, WT, 64 * kb, 32 * nb, dst_row_block(mode, 32 * nb), scale, scr, lane); }
    base += items;
}
__device__ __forceinline__ void mod_item(const Params& p, int nb, LAS unsigned char* lds, int tid) {
    LAS float* sc = (LAS float*)lds;
    LAS float* red = (LAS float*)(lds + 32768);
    for (int i = tid; i < 8192; i += 512) { const int k = i >> 3, b = i & 7; const float v = p.c[b * D + k]; sc[i] = v / (1.0f + __expf(-v)); }
    __syncthreads();
    const int kg = tid >> 5, cgp = tid & 31; const int col = nb * 128 + 4 * cgp;
    f32x4 acc[8];
#pragma unroll
    for (int b = 0; b < 8; ++b) acc[b] = (f32x4){0.f, 0.f, 0.f, 0.f};
#pragma unroll 8
    for (int kk = 0; kk < 64; ++kk) { const int k = kg * 64 + kk; const f32x4 w = *(const f32x4*)(p.w_mod + (size_t)k * NMOD + col);
        const f32x4 s0 = *(const LAS f32x4*)(sc + k * 8), s1 = *(const LAS f32x4*)(sc + k * 8 + 4);
        acc[0] += w * s0[0]; acc[1] += w * s0[1]; acc[2] += w * s0[2]; acc[3] += w * s0[3]; acc[4] += w * s1[0]; acc[5] += w * s1[1]; acc[6] += w * s1[2]; acc[7] += w * s1[3]; }
#pragma unroll
    for (int b = 0; b < 8; ++b) *(LAS f32x4*)(red + (kg * 8 + b) * 128 + 4 * cgp) = acc[b];
    __syncthreads();
    for (int o = tid; o < 1024; o += 512) { const int b = o >> 7, cc = o & 127; float s = p.b_mod[nb * 128 + cc];
#pragma unroll
        for (int g = 0; g < 16; ++g) s += red[(g * 8 + b) * 128 + cc];
        ((float*)(p.ws + WS_MOD))[b * NMOD + nb * 128 + cc] = s; }
    __syncthreads();
}
template <bool FOXF, bool XB16>
__device__ __forceinline__ void norm_phase(const Params& p, const void* X, const float* g, int sh_off, int sc_off, bf16* H, LAS unsigned char* lds, int gw, int NGW, int lane, int tid) {
    LAS float* wf = (LAS float*)lds;
    if (FOXF) { for (int i = tid; i < 8192; i += 512) wf[i] = p.w_in[(size_t)(i >> 3) * INW + NQKV + (i & 7)]; __syncthreads(); }
    const float* mod = (const float*)(p.ws + WS_MOD);
    for (int m0 = gw * 16; m0 < M; m0 += NGW * 16) {
    const int b = m0 / SEQ;
    f32x4 a[4], sh[4];
#pragma unroll
    for (int j = 0; j < 4; ++j) { const int col = 4 * lane + 256 * j; const f32x4 gv = *(const f32x4*)(g + col), sv = *(const f32x4*)(mod + (size_t)b * NMOD + sc_off + col);
        a[j] = gv * (sv + 1.0f); sh[j] = *(const f32x4*)(mod + (size_t)b * NMOD + sh_off + col); }
    for (int r4 = 0; r4 < 16; r4 += 4) {
        v2u rb[4][4]; f32x4 rf[4][4];
#pragma unroll
        for (int q = 0; q < 4; ++q)
#pragma unroll
            for (int j = 0; j < 4; ++j) {
                if (XB16) rb[q][j] = *(const v2u*)((const bf16*)X + (size_t)(m0 + r4 + q) * D + 4 * lane + 256 * j);
                else rf[q][j] = *(const f32x4*)((const float*)X + (size_t)(m0 + r4 + q) * D + 4 * lane + 256 * j); }
#pragma unroll
        for (int q = 0; q < 4; ++q) { const int m = m0 + r4 + q;
        f32x4 v[4]; float ss = 0.f;
#pragma unroll
        for (int j = 0; j < 4; ++j) {
            if (XB16) { const v2u w = rb[q][j]; v[j] = (f32x4){__uint_as_float(w.x << 16), __uint_as_float(w.x & 0xffff0000u), __uint_as_float(w.y << 16), __uint_as_float(w.y & 0xffff0000u)}; }
            else v[j] = rf[q][j];
            ss += (v[j].x * v[j].x + v[j].y * v[j].y) + (v[j].z * v[j].z + v[j].w * v[j].w); }
        const float rstd = __builtin_amdgcn_rsqf(wave_sum(ss) * (1.0f / D) + EPS);
#pragma unroll
        for (int j = 0; j < 4; ++j) { v[j] = v[j] * rstd * a[j] + sh[j];
            v2u o; o.x = pk2(v[j].x, v[j].y); o.y = pk2(v[j].z, v[j].w); *(v2u*)(H + (size_t)m * D + 4 * lane + 256 * j) = o; }
        if (FOXF) { float f[8];
#pragma unroll
            for (int qq = 0; qq < 8; ++qq) f[qq] = 0.f;
#pragma unroll
            for (int j = 0; j < 4; ++j)
#pragma unroll
                for (int e_ = 0; e_ < 4; ++e_) { const LAS float* wr = wf + (4 * lane + 256 * j + e_) * 8; const f32x4 w0 = *(const LAS f32x4*)wr, w1 = *(const LAS f32x4*)(wr + 4); const float hv = v[j][e_];
                    f[0] += hv * w0[0]; f[1] += hv * w0[1]; f[2] += hv * w0[2]; f[3] += hv * w0[3]; f[4] += hv * w1[0]; f[5] += hv * w1[1]; f[6] += hv * w1[2]; f[7] += hv * w1[3]; }
#pragma unroll
            for (int i = 0; i < 4; ++i) { const float snd = (lane & 1) ? f[i] : f[i + 4], kp = (lane & 1) ? f[i + 4] : f[i]; f[i] = kp + __shfl_xor(snd, 1); }
#pragma unroll
            for (int i = 0; i < 2; ++i) { const float snd = (lane & 2) ? f[i] : f[i + 2], kp = (lane & 2) ? f[i + 2] : f[i]; f[i] = kp + __shfl_xor(snd, 2); }
            { const float snd = (lane & 4) ? f[0] : f[1], kp = (lane & 4) ? f[1] : f[0]; f[0] = kp + __shfl_xor(snd, 4); }
            f[0] += __shfl_xor(f[0], 8); f[0] += __shfl_xor(f[0], 16); f[0] += __shfl_xor(f[0], 32);
            const int jidx = ((lane >> 2) & 1) + 2 * ((lane >> 1) & 1) + 4 * (lane & 1);
            if (lane < 8) { const float z = f[0] + p.b_f[jidx]; const float ls = fminf(z, 0.f) - log1pf(__expf(-fabsf(z))); ((float*)(p.ws + WS_LF))[(size_t)m * 8 + jidx] = ls; } }
        }
    }
    }
}
__device__ __forceinline__ void cumsum_item(const Params& p, int bh, LAS unsigned char* lds, int tid, int lane, int wave) {
    const float* LF = (const float*)(p.ws + WS_LF); float* KB = (float*)(p.ws + WS_KB);
    LAS float* wt = (LAS float*)lds;
    const int b = bh >> 3, h = bh & 7, s0 = tid * 8;
    float v[8]; float run = 0.f;
#pragma unroll
    for (int i = 0; i < 8; ++i) { run += LF[((size_t)b * SEQ + s0 + i) * 8 + h]; v[i] = run; }
    float inc = run;
    for (int o = 1; o < 64; o <<= 1) { const float t = __shfl_up(inc, o); if (lane >= o) inc += t; }
    if (lane == 63) wt[wave] = inc;
    __syncthreads();
    float pre = inc - run;
    for (int w = 0; w < wave; ++w) pre += wt[w];
    v4u* KB16 = (v4u*)(p.ws + WS_KB16);
#pragma unroll
    for (int i = 0; i < 8; ++i) { const float bv = -(pre + v[i]) * LOG2E; KB[(size_t)bh * SEQ + s0 + i] = bv;
        const unsigned h_ = f2bf(bv); const float r1 = bv - __uint_as_float(h_ << 16); const unsigned m_ = f2bf(r1); const float r2 = r1 - __uint_as_float(m_ << 16); const unsigned l_ = f2bf(r2);
        KB16[(size_t)bh * SEQ + s0 + i] = (v4u){h_ | (m_ << 16), l_, 0u, 0u}; }
    __syncthreads();
}

typedef __attribute__((address_space(1))) unsigned gu32;
#define XB_TMO      128
#define XB_XCNT(j)  (256  + 64 * (j))
#define XB_XSUB(j)  (1280 + 64 * (j))
#define XB_XGEN(j)  (2304 + 64 * (j))
#define XB_TOP      3328
#define XB_TOPGEN   3392
#define XCD_BAR_WORDS 3456
#define XB_SPIN_CAP (1u << 18)

__device__ __forceinline__ unsigned xb_ld(unsigned* p)              { return __hip_atomic_load(p, __ATOMIC_RELAXED, __HIP_MEMORY_SCOPE_AGENT); }
__device__ __forceinline__ unsigned xb_add(unsigned* p, unsigned v) { return __hip_atomic_fetch_add(p, v, __ATOMIC_RELAXED, __HIP_MEMORY_SCOPE_AGENT); }
__device__ __forceinline__ unsigned xb_xcc_id() { return (unsigned)__builtin_amdgcn_s_getreg((3 << 11) | 20) & 0xFu; }
#define XB_SPIN(cond, bar) do { unsigned _sp = 0; while (cond) { __builtin_amdgcn_s_sleep(1); \
    if ((++_sp & 255u) == 0u) { if (xb_ld(&(bar)[XB_TMO])) break; if (_sp > XB_SPIN_CAP) { atomicAdd(&(bar)[XB_TMO], 1u); break; } } } } while (0)

struct XcdBarrier {
    unsigned* bar; unsigned x;
    volatile LAS unsigned* st;
};

__device__ __forceinline__ XcdBarrier xcd_barrier_post(unsigned* bar, volatile LAS unsigned* st) {
    XcdBarrier b; b.bar = bar; b.x = xb_xcc_id(); b.st = st;
    if (threadIdx.x == 0) (void)xb_add(&bar[XB_XCNT(b.x)], 1u);
    return b;
}
__device__ __forceinline__ void xcd_barrier_complete(unsigned* bar, unsigned x, unsigned& nloc, unsigned& nx) {
    const unsigned G = gridDim.x * gridDim.y * gridDim.z;
    unsigned sum, cnt, mine, sp = 0u;
    for (;;) {
        sum = 0u; cnt = 0u; mine = 0u;
#pragma unroll
        for (unsigned j = 0; j < 16; ++j) { const unsigned c = xb_ld(&bar[XB_XCNT(j)]); sum += c; cnt += (c > 0u) ? 1u : 0u; mine = (j == x) ? c : mine; }
        if (sum == G) break;
        __builtin_amdgcn_s_sleep(1);
        if ((++sp & 255u) == 0u) { if (xb_ld(&bar[XB_TMO])) break; if (sp > XB_SPIN_CAP) { atomicAdd(&bar[XB_TMO], 1u); break; } }
    }
    nloc = mine > 0u ? mine : 1u; nx = cnt > 0u ? cnt : 1u;
}

__device__ __forceinline__ void xcd_barrier(const XcdBarrier& b) {
    asm volatile("s_waitcnt vmcnt(0)" ::: "memory");
    __syncthreads();
    if (threadIdx.x == 0) {
        unsigned* bar = b.bar;
        __builtin_amdgcn_s_waitcnt(0);
        unsigned nloc = b.st[0], nx = b.st[1];
        if (nloc == 0u) { xcd_barrier_complete(bar, b.x, nloc, nx); b.st[0] = nloc; b.st[1] = nx; }
        const unsigned old = xb_add(&bar[XB_XSUB(b.x)], 1u);
        const unsigned gen = old / nloc;
        if (old + 1u == (gen + 1u) * nloc) {
            __builtin_amdgcn_fence(__ATOMIC_RELEASE, "agent");
            asm volatile("s_waitcnt vmcnt(0)" ::: "memory");
            const unsigned og = xb_add(&bar[XB_TOP], 1u);
            const unsigned tg = og / nx;
            if (og + 1u == (tg + 1u) * nx) xb_add(&bar[XB_TOPGEN], 1u);
            else XB_SPIN(xb_ld(&bar[XB_TOPGEN]) == tg, bar);
            __builtin_amdgcn_fence(__ATOMIC_ACQUIRE, "agent");
            xb_add(&bar[XB_XGEN(b.x)], 1u);
            asm volatile("s_waitcnt vmcnt(0)" ::: "memory");
        } else {
            XB_SPIN(xb_ld(&bar[XB_XGEN(b.x)]) == gen, bar);
            __builtin_amdgcn_fence(__ATOMIC_ACQUIRE, "agent");
            asm volatile("s_waitcnt vmcnt(0)" ::: "memory");
        }
    }
    __syncthreads();
}

#ifndef GU_ALIGN
#define GU_ALIGN true
#endif
#ifndef RESID_ALIGN
#define RESID_ALIGN true
#endif
#ifndef FOX_PIPE
#define FOX_PIPE 1
#endif
#ifndef DUP_MISC
#define DUP_MISC 0
#endif
#ifndef DUP_ATT_FOX
#define DUP_ATT_FOX 0
#endif
#ifndef DUP_ATT_SB
#define DUP_ATT_SB 1
#endif
#ifndef DUP_GU
#define DUP_GU 0
#endif
#ifndef DUP_D1
#define DUP_D1 0
#endif
#ifndef DUP_SYNC
#define DUP_SYNC 0
#endif
__global__ void __launch_bounds__(NWAVES * 64, 2) hymba_fwd(Params p) {
    extern __shared__ __attribute__((aligned(16))) unsigned char lds_raw[];
    LAS unsigned char* lds = (LAS unsigned char*)lds_raw;
    cg::grid_group grid = cg::this_grid();
    const int wave = __builtin_amdgcn_readfirstlane((int)threadIdx.x >> 6);
    const int G = gridDim.x, bx = blockIdx.x;
#define FRESH_TID() int tid = threadIdx.x; asm volatile("" : "+v"(tid)); const int lane = tid & 63
    const int vcu = (G % 8 == 0) ? (bx % 8) * (G / 8) + bx / 8 : bx;
    const int gw = vcu * NWAVES + wave, NGW = G * NWAVES;
    unsigned char* ws = p.ws;
    volatile LAS unsigned* MISC = (volatile LAS unsigned*)(lds + MISC_OFF);
    if (threadIdx.x < 32) MISC[threadIdx.x] = 0u;
    unsigned* barw = (unsigned*)(ws + WS_CTL);
    __syncthreads();
    XcdBarrier xbar = xcd_barrier_post(barw, MISC + 8);
    if (ws == nullptr) grid.sync();
    float* mod = (float*)(ws + WS_MOD);
    bf16 *W1GU = (bf16*)(ws + WS_W1GU), *W1D = (bf16*)(ws + WS_W1D), *W2GU = (bf16*)(ws + WS_W2GU), *W2D = (bf16*)(ws + WS_W2D), *WIN = (bf16*)(ws + WS_WIN), *WO = (bf16*)(ws + WS_WO);
    bf16 *H = (bf16*)(ws + WS_H), *ACT = (bf16*)(ws + WS_ACT), *X1 = (bf16*)(ws + WS_X1);

    for (int rep_ = 0; rep_ < 1 + DUP_MISC; ++rep_)
    { FRESH_TID(); for (int nb = bx; nb < NMOD / 128; nb += G) mod_item(p, nb, lds, tid);
      LAS float* scr = (LAS float*)(lds + wave * 16384); int base = 0;
      convert_matrix(p.w1_gate, D, FF, FF, W1GU, 1, base, gw, NGW, scr, lane);
      convert_matrix(p.w1_up, D, FF, FF, W1GU, 2, base, gw, NGW, scr, lane);
      convert_matrix(p.w1_down, FF, D, D, W1D, 0, base, gw, NGW, scr, lane);
      convert_matrix(p.w_in, D, INW, NQKV, WIN, 3, base, gw, NGW, scr, lane);
      convert_matrix(p.w_o, D, D, D, WO, 0, base, gw, NGW, scr, lane);
      convert_matrix(p.w2_gate, D, FF, FF, W2GU, 1, base, gw, NGW, scr, lane);
      convert_matrix(p.w2_up, D, FF, FF, W2GU, 2, base, gw, NGW, scr, lane);
      convert_matrix(p.w2_down, FF, D, D, W2D, 0, base, gw, NGW, scr, lane); }
    xcd_barrier(xbar);
    for (int rep_ = 0; rep_ < 10 * DUP_SYNC; ++rep_) xcd_barrier(xbar);
    for (int rep_ = 0; rep_ < 1 + DUP_MISC; ++rep_)
    { FRESH_TID(); norm_phase<false, false>(p, p.x, p.g_ffn1, 0 * D, 1 * D, H, lds, gw, NGW, lane, tid); }
    xcd_barrier(xbar);
    for (int rep_ = 0; rep_ < 1 + DUP_GU; ++rep_)
    { pg8::Gemm g{H, W1GU, M, 2 * FF, D}; pg8::StaticOrder S; S.init(M, 2 * FF, G, bx); pg8::EpiSwiGLU E{ACT, FF};
      pg8::gemm_phase<pg8::EpiSwiGLU, pg8::StaticOrder, GU_ALIGN, true>(lds, g, S, E); }
    xcd_barrier(xbar);
    for (int rep_ = 0; rep_ < 1 + DUP_D1; ++rep_)
    { pg8::Gemm g{ACT, W1D, M, D, FF}; pg8::StaticOrder S; S.init(M, D, G, bx); pg8::EpiResid<false, true> E{p.x, X1, mod + 2 * D, 0.5f};
      pg8::gemm_phase<pg8::EpiResid<false, true>, pg8::StaticOrder, RESID_ALIGN, true>(lds, g, S, E); }
    xcd_barrier(xbar);
    for (int rep_ = 0; rep_ < 1 + DUP_MISC; ++rep_)
    { FRESH_TID(); norm_phase<true, true>(p, X1, p.g_mix, 3 * D, 4 * D, H, lds, gw, NGW, lane, tid); }
    xcd_barrier(xbar);
    if (bx < 64) { FRESH_TID(); cumsum_item(p, bx, lds, tid, lane, wave); }
    { pg8::Gemm g{H, WIN, M, NQKV, D}; pg8::StaticOrder S; S.init(M, NQKV, G, bx); pg8::EpiQKV E{ACT, p.g_q, p.g_k, 0.125f * LOG2E};
      pg8::gemm_phase<pg8::EpiQKV, pg8::StaticOrder, true, true>(lds, g, S, E); }
    xcd_barrier(xbar);
    { const float* KB = (const float*)(ws + WS_KB); unsigned* qctr = (unsigned*)(ws + WS_CTL + 65536);
      { FRESH_TID(); float a = fabsf(p.g_q[wave * 64 + lane]), c = fabsf(p.g_k[wave * 64 + lane]);
#pragma unroll
        for (int o_ = 1; o_ < 64; o_ <<= 1) { a = fmaxf(a, __shfl_xor(a, o_)); c = fmaxf(c, __shfl_xor(c, o_)); }
        if (lane == 0) MISC[24 + wave] = __float_as_uint(64.0f * 0.125f * LOG2E * a * c * 1.02f + 0.5f); }
      const unsigned home = xbar.x & 7u;
      for (unsigned kq = 0; kq < 8u; ++kq) {
          const unsigned qi = (home + kq) & 7u; unsigned* qc = qctr + 64 * qi;
          if (threadIdx.x == 0) MISC[16] = atomicAdd(qc, 1u);
          __syncthreads();
          for (;;) {
              const unsigned u = MISC[16];
              if (u >= 256u) break;
              const int kind = (u < 128u) ? 1 : 0, v = u & 127, qb = 15 - (v >> 3), b = (int)qi, h = v & 7;
              const float sbound = __uint_as_float(MISC[24 + h]);
              if (kind) fox::fox_unit<8>(b, h, qb, ACT, KB, (const fox::u32x4*)(ws + WS_KB16), sbound, H, lds, qc, MISC + 16);
              else att::attn_unit<false>(b, h, qb, ACT, KB, p.g_q, p.g_k, H, lds, qc, MISC + 16);
          }
          __syncthreads();
      } }
    xcd_barrier(xbar);
    { pg8::Gemm g{H, WO, M, D, D}; pg8::StaticOrder S; S.init(M, D, G, bx); pg8::EpiResid<true, true> E{X1, X1, mod + 5 * D, 1.0f};
      pg8::gemm_phase<pg8::EpiResid<true, true>, pg8::StaticOrder, RESID_ALIGN, true>(lds, g, S, E); }
    xcd_barrier(xbar);
    for (int rep_ = 0; rep_ < 1 + DUP_MISC; ++rep_)
    { FRESH_TID(); norm_phase<false, true>(p, X1, p.g_ffn2, 6 * D, 7 * D, H, lds, gw, NGW, lane, tid); }
    xcd_barrier(xbar);
    { pg8::Gemm g{H, W2GU, M, 2 * FF, D}; pg8::StaticOrder S; S.init(M, 2 * FF, G, bx); pg8::EpiSwiGLU E{ACT, FF};
      pg8::gemm_phase<pg8::EpiSwiGLU, pg8::StaticOrder, GU_ALIGN, true>(lds, g, S, E); }
    xcd_barrier(xbar);
    { pg8::Gemm g{ACT, W2D, M, D, FF}; pg8::StaticOrder S; S.init(M, D, G, bx); pg8::EpiResid<true, false> E{X1, p.out, mod + 8 * D, 0.5f};
      pg8::gemm_phase<pg8::EpiResid<true, false>, pg8::StaticOrder, RESID_ALIGN, true>(lds, g, S, E); }
}

extern "C" void kernel_launch(void* const* d_in, const int* in_sizes, int n_in, void* d_out, int out_size, void* d_ws, size_t ws_size, hipStream_t stream) {
    static int grid = 0;
    if (grid == 0) {
        if (n_in != 18 || in_sizes[0] != M * D || out_size != M * D || ws_size < WS_END) { fprintf(stderr, "kernel_launch: unexpected shapes (n_in %d, in0 %d, out %d, ws %zu)\n", n_in, n_in > 0 ? in_sizes[0] : -1, out_size, ws_size); grid = -1; return; }
        int dev = 0, cus = 0, per_cu = 0;
        (void)hipGetDevice(&dev); (void)hipDeviceGetAttribute(&cus, hipDeviceAttributeMultiprocessorCount, dev);
        if (hipFuncSetAttribute((const void*)hymba_fwd, hipFuncAttributeMaxDynamicSharedMemorySize, LDS_BYTES) != hipSuccess) { fprintf(stderr, "kernel_launch: hipFuncSetAttribute failed\n"); grid = -1; return; }
        if (hipOccupancyMaxActiveBlocksPerMultiprocessor(&per_cu, (const void*)hymba_fwd, NWAVES * 64, LDS_BYTES) != hipSuccess || per_cu < 1) { fprintf(stderr, "kernel_launch: occupancy query says %d\n", per_cu); per_cu = 1; }
        (void)hipGetLastError();
        grid = cus * per_cu;
    }
    if (grid < 0) return;
    if (hipMemsetAsync((char*)d_ws + WS_CTL, 0, 131072, stream) != hipSuccess) { fprintf(stderr, "kernel_launch: memset of control words failed\n"); return; }
    Params p{};
    const float** pp = (const float**)&p;
    for (int i = 0; i < 18; ++i) pp[i] = (const float*)d_in[i];
    p.out = (float*)d_out; p.ws = (unsigned char*)d_ws;
    void* args[] = {&p};
    hipError_t e = hipLaunchCooperativeKernel((const void*)hymba_fwd, dim3(grid), dim3(NWAVES * 64), args, LDS_BYTES, stream);
    if (e != hipSuccess) fprintf(stderr, "cooperative launch failed: %s (grid %d)\n", hipGetErrorString(e), grid);
}
```

```cpp
#include <hip/hip_runtime.h>
#include <hip/hip_cooperative_groups.h>
#include <hip/hip_bf16.h>
#include <cstdio>
#include <cstdint>
#include <cmath>
namespace cg = cooperative_groups;
namespace pg8 {
#define PG8_LAS __attribute__((address_space(3)))
typedef unsigned short bf16_t;
typedef short bf16x8 __attribute__((ext_vector_type(8)));
typedef float f32x4 __attribute__((ext_vector_type(4)));
typedef unsigned u32x4 __attribute__((ext_vector_type(4)));
constexpr int BM = 256, BK = 64, HALF = 128, HTB = HALF * BK * 2  , STAGE_BYTES = 8 * HTB, NXCD = 8, WGM = 8;

__host__ __device__ __forceinline__ int lds_byte(int r, int c) { const int st = (r >> 4) * 2 + (c >> 5), rr = r & 15, cc = c & 31, ob = rr * 64 + cc * 2; return st * 1024 + (ob ^ (((ob >> 9) & 1) << 5)); }
__host__ __device__ __forceinline__ void stage_rc(int b, int& R, int& C) { const int st = b / 1024, sb = b % 1024, swz = sb ^ (((sb >> 9) & 1) << 5); R = (st >> 1) * 16 + swz / 64; C = (st & 1) * 32 + (swz % 64) / 2; }
__host__ __device__ __forceinline__ int perm32(int rho) { const int n = rho >> 4, i = rho & 15; return 8 * (i >> 2) + 4 * n + (i & 3); }

struct Unit { int pm, pn; };
struct Gemm { const bf16_t* A; const bf16_t* Bt; int M, N, K; };

struct StaticOrder {
    int nM, nN, nwg, G, c;
    __host__ __device__ void init(int M, int N, int G_, int c_) { nM = M / BM; nN = N / BM; nwg = nM * nN; G = G_; c = c_; }
    __host__ __device__ bool next(int i, Unit& u) const {
        const long L = (long)i * G + c; if (L >= nwg) return false;
        int wgid = (int)L; { const int q = nwg / NXCD, r = nwg % NXCD, xcd = wgid % NXCD, off = wgid / NXCD; wgid = (xcd < r ? xcd * (q + 1) : r * (q + 1) + (xcd - r) * q) + off; }
        const int nig = WGM * nN, gid = wgid / nig, fm = gid * WGM, gsz = (nM - fm) < WGM ? (nM - fm) : WGM;
        u.pm = fm + ((wgid % nig) % gsz); u.pn = (wgid % nig) / gsz; return true;
    }
    __device__ __forceinline__ void a_ready(const Unit&) const {}
    __device__ __forceinline__ void done(const Unit&) const {}
};

__device__ __forceinline__ unsigned cvt_pk_bf16(float lo, float hi) { unsigned r; asm volatile("v_cvt_pk_bf16_f32 %0, %1, %2" : "=v"(r) : "v"(lo), "v"(hi)); return r; }
typedef float f32x2 __attribute__((ext_vector_type(2)));
typedef unsigned u32x2 __attribute__((ext_vector_type(2)));
__device__ __forceinline__ float fast_rcp(float x) { return __builtin_amdgcn_rcpf(x); }
__device__ __forceinline__ float fast_exp2(float x) { return __builtin_amdgcn_exp2f(x); }
struct EpiSwiGLU {
    static constexpr bool PERM = true, AFTER_DRAIN = false;
    bf16_t* O; int ldc;
    __device__ __forceinline__ void operator()(const f32x4 (&acc)[2][2][4][2], const Unit& u, int wr, int wc, int fr, int fq) const {
        typedef float f32x2v __attribute__((ext_vector_type(2)));
        const int row0 = u.pm * BM + wr * 64 + fr; const int col0 = u.pn * HALF + wc * 32 + 8 * fq;
#pragma unroll
        for (int ai = 0; ai < 2; ++ai)
#pragma unroll
            for (int m = 0; m < 4; ++m) {
                bf16_t* rowp = O + (size_t)(row0 + ai * HALF + m * 16) * ldc + col0;
                f32x2v r[4];
#pragma unroll
                for (int n = 0; n < 2; ++n)
#pragma unroll
                    for (int e = 0; e < 4; e += 2) { const f32x2v a = (f32x2v){acc[ai][0][m][n][e], acc[ai][0][m][n][e + 1]}, up = (f32x2v){acc[ai][1][m][n][e], acc[ai][1][m][n][e + 1]};
                        f32x2v t; t.x = fast_exp2(a.x); t.y = fast_exp2(a.y);
                        const f32x2v den = t + 1.0f; f32x2v rc; rc.x = fast_rcp(den.x); rc.y = fast_rcp(den.y);
                        r[n * 2 + (e >> 1)] = (a * up) * rc; }
                u32x4 w; w.x = cvt_pk_bf16(r[0].x, r[0].y); w.y = cvt_pk_bf16(r[1].x, r[1].y); w.z = cvt_pk_bf16(r[2].x, r[2].y); w.w = cvt_pk_bf16(r[3].x, r[3].y);
                *(u32x4*)rowp = w;
            }
    }
};
__device__ __forceinline__ f32x4 bf2f_lo(u32x2 w) { return (f32x4){__uint_as_float(w.x << 16), __uint_as_float(w.x & 0xffff0000u), __uint_as_float(w.y << 16), __uint_as_float(w.y & 0xffff0000u)}; }
template <bool BIN, bool BOUT> struct EpiResid {
    static constexpr bool PERM = true, AFTER_DRAIN = false;
    const void* base; void* out; const float* gate; float mul;
    __device__ __forceinline__ void operator()(const f32x4 (&acc)[2][2][4][2], const Unit& u, int wr, int wc, int fr, int fq) const {
        const int row0 = u.pm * BM + wr * 64 + fr; const int col0 = u.pn * BM + wc * 32 + 8 * fq;
        const float* grow = gate + (size_t)(u.pm >> 4) * 9216 + col0;
        f32x4 gv[2][2];
#pragma unroll
        for (int bj = 0; bj < 2; ++bj)
#pragma unroll
            for (int n = 0; n < 2; ++n) { const f32x4 g = *(const f32x4*)(grow + bj * HALF + 4 * n); gv[bj][n] = (g + 1.0f) * mul; }
        if (BIN) {
#pragma unroll
            for (int ai = 0; ai < 2; ++ai) {
                u32x4 bw[4][2];
#pragma unroll
                for (int m = 0; m < 4; ++m)
#pragma unroll
                    for (int bj = 0; bj < 2; ++bj) bw[m][bj] = *(const u32x4*)((const bf16_t*)base + (size_t)(row0 + ai * HALF + m * 16) * 1024 + col0 + bj * HALF);
                asm volatile("" ::: "memory");
#pragma unroll
                for (int m = 0; m < 4; ++m) { const size_t off = (size_t)(row0 + ai * HALF + m * 16) * 1024 + col0;
#pragma unroll
                    for (int bj = 0; bj < 2; ++bj) { const u32x4 w_ = bw[m][bj]; const f32x4 b0 = bf2f_lo((u32x2){w_.x, w_.y}), b1 = bf2f_lo((u32x2){w_.z, w_.w});
                        const f32x4 o0 = b0 + gv[bj][0] * acc[ai][bj][m][0], o1 = b1 + gv[bj][1] * acc[ai][bj][m][1];
                        if (BOUT) { u32x4 w; w.x = cvt_pk_bf16(o0[0], o0[1]); w.y = cvt_pk_bf16(o0[2], o0[3]); w.z = cvt_pk_bf16(o1[0], o1[1]); w.w = cvt_pk_bf16(o1[2], o1[3]); *(u32x4*)((bf16_t*)out + off + bj * HALF) = w; }
                        else { *(f32x4*)((float*)out + off + bj * HALF) = o0; *(f32x4*)((float*)out + off + bj * HALF + 4) = o1; } } }
                asm volatile("" ::: "memory");
            }
        } else {
#pragma unroll
            for (int ai = 0; ai < 2; ++ai)
#pragma unroll
                for (int m = 0; m < 4; ++m) { const size_t off = (size_t)(row0 + ai * HALF + m * 16) * 1024 + col0;
#pragma unroll
                    for (int bj = 0; bj < 2; ++bj) { const f32x4 b0 = *(const f32x4*)((const float*)base + off + bj * HALF), b1 = *(const f32x4*)((const float*)base + off + bj * HALF + 4);
                        const f32x4 o0 = b0 + gv[bj][0] * acc[ai][bj][m][0], o1 = b1 + gv[bj][1] * acc[ai][bj][m][1];
                        if (BOUT) { u32x4 w; w.x = cvt_pk_bf16(o0[0], o0[1]); w.y = cvt_pk_bf16(o0[2], o0[3]); w.z = cvt_pk_bf16(o1[0], o1[1]); w.w = cvt_pk_bf16(o1[2], o1[3]); *(u32x4*)((bf16_t*)out + off + bj * HALF) = w; }
                        else { *(f32x4*)((float*)out + off + bj * HALF) = o0; *(f32x4*)((float*)out + off + bj * HALF + 4) = o1; } }
                    if (m & 1) asm volatile("" ::: "memory"); }
        }
    }
};
struct EpiQKV {
    static constexpr bool PERM = true, AFTER_DRAIN = false;
    bf16_t* O; const float* gq; const float* gk; float qscale;
    __device__ __forceinline__ void operator()(const f32x4 (&acc)[2][2][4][2], const Unit& u, int wr, int wc, int fr, int fq) const {
        const int seg = u.pn >> 1, head = (u.pn & 1) * 4 + wc;
        const int row0 = u.pm * BM + wr * 64 + fr; const int col0 = u.pn * BM + wc * 64 + 8 * fq;
        const bool nrm = (seg == 3) || (seg == 4);
        const float sc = (seg == 0 || seg == 3) ? qscale : 1.0f;
        f32x4 gv[2][2];
#pragma unroll
        for (int bj = 0; bj < 2; ++bj)
#pragma unroll
            for (int n = 0; n < 2; ++n) { f32x4 g = (f32x4){1.f, 1.f, 1.f, 1.f};
                if (nrm) g = *(const f32x4*)((seg == 3 ? gq : gk) + head * 64 + bj * 32 + 8 * fq + 4 * n);
                gv[bj][n] = g * sc; }
#pragma unroll
        for (int ai = 0; ai < 2; ++ai)
#pragma unroll
            for (int m = 0; m < 4; ++m) {
                float rs = 1.0f;
                if (nrm) { float ss = 0.f;
#pragma unroll
                    for (int bj = 0; bj < 2; ++bj)
#pragma unroll
                        for (int n = 0; n < 2; ++n) { const f32x4 x = acc[ai][bj][m][n]; ss += (x[0] * x[0] + x[1] * x[1]) + (x[2] * x[2] + x[3] * x[3]); }
                    ss += __shfl_xor(ss, 16); ss += __shfl_xor(ss, 32);
                    rs = __builtin_amdgcn_rsqf(ss * (1.0f / 64.0f) + 1e-6f); }
                bf16_t* rowp = O + (size_t)(row0 + ai * HALF + m * 16) * 3072 + col0;
#pragma unroll
                for (int bj = 0; bj < 2; ++bj) { const f32x4 v0 = acc[ai][bj][m][0] * rs * gv[bj][0], v1 = acc[ai][bj][m][1] * rs * gv[bj][1];
                    u32x4 w; w.x = cvt_pk_bf16(v0[0], v0[1]); w.y = cvt_pk_bf16(v0[2], v0[3]); w.z = cvt_pk_bf16(v1[0], v1[1]); w.w = cvt_pk_bf16(v1[2], v1[3]);
                    *(u32x4*)(rowp + bj * 32) = w; }
            }
    }
};
template <class Epi, class Sched, bool ALIGN_EPI = false, bool SP2 = false>
__device__ __forceinline__ void gemm_phase(PG8_LAS unsigned char* lds, const Gemm g, const Sched& S, const Epi& E) {
    int tid_ = threadIdx.x; asm volatile("" : "+v"(tid_)); const int tid = tid_, wid = __builtin_amdgcn_readfirstlane(tid >> 6), lane = tid & 63, wr = wid >> 2, wc = wid & 3, fr = lane & 15, fq = lane >> 4;
    const int K = g.K, nt = K / BK;
    unsigned voffA[2], voffB[2];
#pragma unroll
    for (int i = 0; i < 2; ++i) { int R, C; stage_rc(tid * 16 + i * 8192, R, C); const int Rb = Epi::PERM ? ((R & ~31) + perm32(R & 31)) : R;
        voffA[i] = (unsigned)(R * K + C) * 2u; voffB[i] = (unsigned)(Rb * K + C) * 2u; }
    const size_t kstep = (size_t)(BK * 2);
    const size_t hstep = (size_t)HALF * K * 2;
    const size_t tstep = 2 * hstep;
    const unsigned ldsw = (unsigned)wid * 1024u;
    const int aoff = lds_byte(wr * 64 + fr, fq * 8), boff = lds_byte(wc * 32 + fr, fq * 8);
#define PG8_SA(b, h) (((b) * 2 + (h)) * HTB)
#define PG8_SB(b, h) ((4 + (b) * 2 + (h)) * HTB)
#define PG8_STAGE(bufoff, gbase, voff) do { _Pragma("unroll") for (int _i = 0; _i < 2; ++_i) \
        __builtin_amdgcn_global_load_lds((const unsigned*)((const char*)(gbase) + (voff)[_i]), (PG8_LAS unsigned*)(lds + (bufoff) + ldsw + _i * 8192), 16, 0, 0); } while (0)
#define PG8_LDA(dst, b, h) do { _Pragma("unroll") for (int m = 0; m < 4; ++m) _Pragma("unroll") for (int k = 0; k < 2; ++k) dst[m][k] = *(const PG8_LAS bf16x8*)(lds + PG8_SA(b, h) + aoff + m * 2048 + k * 1024); } while (0)
#define PG8_LDB(dst, b, h) do { _Pragma("unroll") for (int n = 0; n < 2; ++n) _Pragma("unroll") for (int k = 0; k < 2; ++k) dst[n][k] = *(const PG8_LAS bf16x8*)(lds + PG8_SB(b, h) + boff + n * 2048 + k * 1024); } while (0)
#define PG8_MMA(ai, bj, At, Bt) do { __builtin_amdgcn_s_setprio(1); _Pragma("unroll") for (int m = 0; m < 4; ++m) _Pragma("unroll") for (int n = 0; n < 2; ++n) _Pragma("unroll") for (int k = 0; k < 2; ++k) \
        acc[ai][bj][m][n] = __builtin_amdgcn_mfma_f32_16x16x32_bf16(Bt[n][k], At[m][k], acc[ai][bj][m][n], 0, 0, 0); __builtin_amdgcn_s_setprio(0); } while (0)
#define PG8_WAIT_V(n) asm volatile("s_waitcnt vmcnt(" #n ")" ::: "memory")
#define PG8_WAIT_L(n) asm volatile("s_waitcnt lgkmcnt(" #n ")" ::: "memory")
#define PG8_BAR __builtin_amdgcn_s_barrier()
#define PG8_SCHED __builtin_amdgcn_sched_barrier(0)
    Unit cur, nxt; int ui = 0;
    if (!S.next(0, cur)) return;
    f32x4 acc[2][2][4][2];
#pragma unroll
    for (int a = 0; a < 2; ++a)
#pragma unroll
        for (int b = 0; b < 2; ++b)
#pragma unroll
            for (int m = 0; m < 4; ++m)
#pragma unroll
                for (int n = 0; n < 2; ++n) acc[a][b][m][n] = (f32x4){0.f, 0.f, 0.f, 0.f};
    bf16x8 At[4][2], B0[2][2], B1[2][2];
    const char* cA = (const char*)g.A + (size_t)cur.pm * tstep; const char* cB = (const char*)g.Bt + (size_t)cur.pn * tstep;
    S.a_ready(cur);
    if constexpr (SP2) {
        PG8_STAGE(PG8_SB(0, 0), cB, voffB); PG8_STAGE(PG8_SB(0, 1), cB + hstep, voffB); PG8_STAGE(PG8_SA(0, 0), cA, voffA); PG8_STAGE(PG8_SA(0, 1), cA + hstep, voffA);
        if (wr == 1) PG8_BAR;
        PG8_WAIT_V(2); PG8_BAR;
        PG8_STAGE(PG8_SB(1, 0), cB + kstep, voffB); PG8_STAGE(PG8_SA(1, 0), cA + kstep, voffA); PG8_STAGE(PG8_SB(1, 1), cB + hstep + kstep, voffB);
        PG8_WAIT_V(6); PG8_BAR;
    } else {
        PG8_STAGE(PG8_SB(0, 0), cB, voffB); PG8_STAGE(PG8_SA(0, 0), cA, voffA); PG8_STAGE(PG8_SB(0, 1), cB + hstep, voffB); PG8_STAGE(PG8_SA(0, 1), cA + hstep, voffA);
        if (wr == 1) PG8_BAR;
        PG8_WAIT_V(4); PG8_BAR;
        PG8_STAGE(PG8_SB(1, 0), cB + kstep, voffB); PG8_STAGE(PG8_SA(1, 0), cA + kstep, voffA); PG8_STAGE(PG8_SB(1, 1), cB + hstep + kstep, voffB);
        PG8_WAIT_V(6); PG8_BAR;
    }
    for (;;) {
        const bool has_next = S.next(ui + 1, nxt);
        const char* nA = has_next ? (const char*)g.A + (size_t)nxt.pm * tstep : cA; const char* nB = has_next ? (const char*)g.Bt + (size_t)nxt.pn * tstep : cB;
        for (int t = 0; t < nt; t += 2) {
            const bool last = (t == nt - 2);
            const char* a1 = cA + (size_t)(t + 1) * kstep;
            const char* a2 = last ? nA : cA + (size_t)(t + 2) * kstep; const char* b2 = last ? nB : cB + (size_t)(t + 2) * kstep;
            const char* a3 = a2 + kstep; const char* b3 = b2 + kstep;
            if (last && has_next) S.a_ready(nxt);
            if constexpr (SP2) {
            PG8_LDB(B0, 0, 0); PG8_LDB(B1, 0, 1); PG8_SCHED; PG8_LDA(At, 0, 0); PG8_STAGE(PG8_SA(1, 1), a1 + hstep, voffA);
            PG8_WAIT_V(8); PG8_WAIT_L(0); PG8_BAR; PG8_MMA(0, 0, At, B0); PG8_MMA(0, 1, At, B1); PG8_BAR; PG8_SCHED;
            PG8_LDA(At, 0, 1); PG8_STAGE(PG8_SB(0, 0), b2, voffB); PG8_STAGE(PG8_SB(0, 1), b2 + hstep, voffB); PG8_STAGE(PG8_SA(0, 0), a2, voffA);
            PG8_WAIT_V(8); PG8_WAIT_L(0); PG8_BAR; PG8_MMA(1, 0, At, B0); PG8_MMA(1, 1, At, B1); PG8_BAR; PG8_SCHED;
            PG8_LDB(B0, 1, 0); PG8_LDB(B1, 1, 1); PG8_SCHED; PG8_LDA(At, 1, 0); PG8_STAGE(PG8_SA(0, 1), a2 + hstep, voffA);
            PG8_WAIT_V(8); PG8_WAIT_L(0); PG8_BAR; PG8_MMA(0, 0, At, B0); PG8_MMA(0, 1, At, B1); PG8_BAR; PG8_SCHED;
            PG8_LDA(At, 1, 1); PG8_STAGE(PG8_SB(1, 0), b3, voffB); PG8_STAGE(PG8_SB(1, 1), b3 + hstep, voffB); PG8_STAGE(PG8_SA(1, 0), a3, voffA);
            PG8_WAIT_V(8); PG8_WAIT_L(0); PG8_BAR; PG8_MMA(1, 0, At, B0); PG8_MMA(1, 1, At, B1); PG8_BAR; PG8_SCHED;
            } else {
            PG8_LDB(B0, 0, 0); PG8_SCHED; PG8_LDA(At, 0, 0); PG8_STAGE(PG8_SA(1, 1), a1 + hstep, voffA);
            PG8_WAIT_L(8); PG8_BAR; PG8_WAIT_L(0); PG8_MMA(0, 0, At, B0); PG8_BAR; PG8_SCHED;
            PG8_LDB(B1, 0, 1); PG8_STAGE(PG8_SB(0, 0), b2, voffB);
            PG8_BAR; PG8_WAIT_L(0); PG8_MMA(0, 1, At, B1); PG8_BAR;
            PG8_LDA(At, 0, 1); PG8_STAGE(PG8_SA(0, 0), a2, voffA);
            PG8_BAR; PG8_WAIT_L(0); PG8_MMA(1, 0, At, B0); PG8_BAR; PG8_SCHED;
            PG8_STAGE(PG8_SB(0, 1), b2 + hstep, voffB);
            PG8_WAIT_V(6); PG8_BAR; PG8_MMA(1, 1, At, B1); PG8_BAR;
            PG8_LDB(B0, 1, 0); PG8_SCHED; PG8_LDA(At, 1, 0); PG8_STAGE(PG8_SA(0, 1), a2 + hstep, voffA);
            PG8_WAIT_L(8); PG8_BAR; PG8_WAIT_L(0); PG8_MMA(0, 0, At, B0); PG8_BAR; PG8_SCHED;
            PG8_LDB(B1, 1, 1); PG8_STAGE(PG8_SB(1, 0), b3, voffB);
            PG8_BAR; PG8_WAIT_L(0); PG8_MMA(0, 1, At, B1); PG8_BAR;
            PG8_LDA(At, 1, 1); PG8_STAGE(PG8_SA(1, 0), a3, voffA);
            PG8_BAR; PG8_WAIT_L(0); PG8_MMA(1, 0, At, B0); PG8_BAR; PG8_SCHED;
            PG8_STAGE(PG8_SB(1, 1), b3 + hstep, voffB);
            PG8_WAIT_V(6); PG8_BAR; PG8_MMA(1, 1, At, B1); PG8_BAR;
            }
        }
        if constexpr (ALIGN_EPI) { if (wr == 0) PG8_BAR; }
        if constexpr (!Epi::AFTER_DRAIN) { E(acc, cur, wr, wc, fr, fq); S.done(cur); }
        if (!has_next) break;
#pragma unroll
        for (int a = 0; a < 2; ++a)
#pragma unroll
            for (int b = 0; b < 2; ++b)
#pragma unroll
                for (int m = 0; m < 4; ++m)
#pragma unroll
                    for (int n = 0; n < 2; ++n) acc[a][b][m][n] = (f32x4){0.f, 0.f, 0.f, 0.f};
        cur = nxt; cA = nA; cB = nB; ++ui;
        if constexpr (ALIGN_EPI) { if (wr == 1) PG8_BAR; }
    }
    PG8_WAIT_V(0);
    if constexpr (!ALIGN_EPI) { if (wr == 0) PG8_BAR; }
    PG8_BAR;
    if constexpr (Epi::AFTER_DRAIN) { E.fused(acc, cur, wr, wc, fr, fq, lds, wid, lane); S.done(cur); }
#undef PG8_SA
#undef PG8_SB
#undef PG8_STAGE
#undef PG8_LDA
#undef PG8_LDB
#undef PG8_MMA
#undef PG8_WAIT_V
#undef PG8_WAIT_L
#undef PG8_BAR
#undef PG8_SCHED
}
}
namespace att {
#define ALAS __attribute__((address_space(3)))
using bf16 = unsigned short;
using bf16x8 = __attribute__((ext_vector_type(8))) short;
using s16x4 = __attribute__((ext_vector_type(4))) short;
using f32x16 = __attribute__((ext_vector_type(16))) float;
using f32x4 = __attribute__((ext_vector_type(4))) float;
using u32x4 = __attribute__((ext_vector_type(4))) unsigned;
constexpr int SEQ = 4096, PITCH = 3072, OPITCH = 1024, QB = 256, KVBLK = 64;
constexpr int SLOTB = 8192;
constexpr int L_K = 0, L_V = 4 * SLOTB, L_B = 8 * SLOTB, L_WS = L_B + 512, L_FLAG = L_WS + 8 * 256, L_OST = L_FLAG + 64, L_BYTES = L_OST + 8 * 4096;
__device__ __forceinline__ int crow(int r, int hi) { return (r & 3) + 8 * (r >> 2) + 4 * hi; }
__device__ __forceinline__ void glds16(const void* gsrc, unsigned lds_dst) { unsigned keep;
    asm volatile("s_mov_b32 %0, m0\n\ts_mov_b32 m0, %2\n\ts_nop 0\n\tglobal_load_lds_dwordx4 %1, off\n\ts_mov_b32 m0, %0" : "=&s"(keep) : "v"(gsrc), "s"(lds_dst) : "memory"); }
__device__ __forceinline__ void glds4(const void* gsrc, unsigned lds_dst) { unsigned keep;
    asm volatile("s_mov_b32 %0, m0\n\ts_mov_b32 m0, %2\n\ts_nop 0\n\tglobal_load_lds_dword %1, off\n\ts_mov_b32 m0, %0" : "=&s"(keep) : "v"(gsrc), "s"(lds_dst) : "memory"); }
typedef float f32x2_t __attribute__((ext_vector_type(2))); typedef __bf16 bf16x2_t __attribute__((ext_vector_type(2)));
__device__ __forceinline__ unsigned cvtpk_s(float lo, float hi) { f32x2_t v = {lo, hi}; bf16x2_t b = __builtin_convertvector(v, bf16x2_t); return __builtin_bit_cast(unsigned, b); }
#define AWAIT_BAR() asm volatile("s_waitcnt vmcnt(0) lgkmcnt(0)\n\ts_barrier" ::: "memory")
#define ASBAR() __builtin_amdgcn_sched_barrier(0)
struct VFrag { s16x4 lo[8], hi[8]; };
__device__ __forceinline__ void v_issue(VFrag& f, int vb) {
#pragma unroll
    for (int i = 0; i < 8; ++i) {
        asm volatile("ds_read_b64_tr_b16 %0,%1 offset:%c2" : "=&v"(f.lo[i]) : "v"(vb), "i"((i >> 2) * 4096 + (i & 3) * 1024) : "memory");
        asm volatile("ds_read_b64_tr_b16 %0,%1 offset:%c2" : "=&v"(f.hi[i]) : "v"(vb), "i"((i >> 2) * 4096 + (i & 3) * 1024 + 512) : "memory"); }
}
__device__ __forceinline__ void pv_mma(f32x16* o, VFrag& f, bf16x8 pa0, bf16x8 pa1, bf16x8 pa2, bf16x8 pa3) {
    asm volatile("s_waitcnt lgkmcnt(0)" : "+v"(f.lo[0]), "+v"(f.lo[1]), "+v"(f.lo[2]), "+v"(f.lo[3]), "+v"(f.lo[4]), "+v"(f.lo[5]), "+v"(f.lo[6]), "+v"(f.lo[7]),
                                          "+v"(f.hi[0]), "+v"(f.hi[1]), "+v"(f.hi[2]), "+v"(f.hi[3]), "+v"(f.hi[4]), "+v"(f.hi[5]), "+v"(f.hi[6]), "+v"(f.hi[7]) :: "memory");
#define APK2(k) (bf16x8){f.lo[k][0], f.lo[k][1], f.lo[k][2], f.lo[k][3], f.hi[k][0], f.hi[k][1], f.hi[k][2], f.hi[k][3]}
    o[0] = __builtin_amdgcn_mfma_f32_32x32x16_bf16(pa0, APK2(0), o[0], 0, 0, 0); o[1] = __builtin_amdgcn_mfma_f32_32x32x16_bf16(pa0, APK2(4), o[1], 0, 0, 0);
    o[0] = __builtin_amdgcn_mfma_f32_32x32x16_bf16(pa1, APK2(1), o[0], 0, 0, 0); o[1] = __builtin_amdgcn_mfma_f32_32x32x16_bf16(pa1, APK2(5), o[1], 0, 0, 0);
    o[0] = __builtin_amdgcn_mfma_f32_32x32x16_bf16(pa2, APK2(2), o[0], 0, 0, 0); o[1] = __builtin_amdgcn_mfma_f32_32x32x16_bf16(pa2, APK2(6), o[1], 0, 0, 0);
    o[0] = __builtin_amdgcn_mfma_f32_32x32x16_bf16(pa3, APK2(3), o[0], 0, 0, 0); o[1] = __builtin_amdgcn_mfma_f32_32x32x16_bf16(pa3, APK2(7), o[1], 0, 0, 0);
#undef APK2
}
__device__ __forceinline__ void pv(f32x16* o, int vb, bf16x8 pa0, bf16x8 pa1, bf16x8 pa2, bf16x8 pa3) {
#pragma unroll
    for (int d0 = 0; d0 < 2; ++d0) { s16x4 lo[4], hi[4];
#pragma unroll
        for (int ks = 0; ks < 4; ++ks) {
            asm volatile("ds_read_b64_tr_b16 %0,%1 offset:%c2" : "=&v"(lo[ks]) : "v"(vb), "i"(d0 * 4096 + ks * 1024) : "memory");
            asm volatile("ds_read_b64_tr_b16 %0,%1 offset:%c2" : "=&v"(hi[ks]) : "v"(vb), "i"(d0 * 4096 + ks * 1024 + 512) : "memory"); }
        asm volatile("s_waitcnt lgkmcnt(0)" ::: "memory"); ASBAR();
#define APK(k) (bf16x8){lo[k][0], lo[k][1], lo[k][2], lo[k][3], hi[k][0], hi[k][1], hi[k][2], hi[k][3]}
        o[d0] = __builtin_amdgcn_mfma_f32_32x32x16_bf16(pa0, APK(0), o[d0], 0, 0, 0);
        o[d0] = __builtin_amdgcn_mfma_f32_32x32x16_bf16(pa1, APK(1), o[d0], 0, 0, 0);
        o[d0] = __builtin_amdgcn_mfma_f32_32x32x16_bf16(pa2, APK(2), o[d0], 0, 0, 0);
        o[d0] = __builtin_amdgcn_mfma_f32_32x32x16_bf16(pa3, APK(3), o[d0], 0, 0, 0);
#undef APK
    }
}
#ifndef SB_EARLY_EXIT
#define SB_EARLY_EXIT 1
#endif
#ifndef FOX_SKIP
#define FOX_SKIP 1
#endif
template <bool FOX>
__device__ __forceinline__ void attn_unit(int b, int h, int qb, const bf16* __restrict__ QKV, const float* __restrict__ kbias, const float* __restrict__ gq, const float* __restrict__ gk, bf16* O, ALAS unsigned char* lds, unsigned* qc, volatile ALAS unsigned* qslot) {
    int tid_ = threadIdx.x; asm volatile("" : "+v"(tid_)); const int tid = tid_, lane = tid & 63, r32 = lane & 31, hi = lane >> 5; const int wid = __builtin_amdgcn_readfirstlane(tid >> 6);
    const long rowbase = (long)b * SEQ; const int q0 = qb * QB;
    const int colq = (FOX ? 1536 : 0) + h * 64;
    const bf16* Qw = QKV + (rowbase + q0 + wid * 32) * PITCH + colq;
    const bf16* Kh = QKV + rowbase * PITCH + colq + 512; const bf16* Vh = QKV + rowbase * PITCH + colq + 1024;
    const unsigned lds0 = (unsigned)(uintptr_t)lds;
    ALAS float* wsf = (ALAS float*)(lds + L_WS) + wid * 64;
    ALAS unsigned* flags = (ALAS unsigned*)(lds + L_FLAG);
    const int kpos = lane, khi = (kpos >> 2) & 1, kr = (kpos & 3) + 4 * ((kpos & 31) >> 3), kkey = khi * 32 + (kpos >> 5) * 16 + kr;
    const bf16* ksrc = Kh + (long)kkey * PITCH + wid * 8;
    const int key16 = lane >> 2, vhi = (key16 >> 2) & 1, vj = (key16 & 3) + 4 * (key16 >> 3), vkey = vhi * 32 + (wid & 3) * 8 + vj;
    const bf16* vsrc = Vh + (long)vkey * PITCH + (wid >> 2) * 32 + (lane & 3) * 8;
    const float* bsrc = kbias + ((long)(b * 8 + h)) * SEQ + lane;
    const unsigned kdst = lds0 + L_K + wid * 1024, vdst = lds0 + L_V + wid * 1024, bdst = lds0 + L_B;
#define ADMA(t, slot) do { glds16(ksrc + (long)(t) * KVBLK * PITCH, (unsigned)__builtin_amdgcn_readfirstlane(kdst + (slot) * SLOTB)); \
                           glds16(vsrc + (long)(t) * KVBLK * PITCH, (unsigned)__builtin_amdgcn_readfirstlane(vdst + (slot) * SLOTB)); \
                           if (FOX && wid == 0) glds4(bsrc + (t) * KVBLK, (unsigned)__builtin_amdgcn_readfirstlane(bdst + (slot) * 256)); } while (0)
    const int vb0 = (int)(lds0 + L_V) + ((lane >> 4) & 1) * 32 + (lane & 3) * 8 + (4 * hi + ((lane & 15) >> 2)) * 64;
    const int NT = (q0 + QB) / KVBLK;
    if (lane == 0) flags[wid] = 0u;
    float sbound = 0.f;
    if (FOX && FOX_SKIP) { float a = fabsf(gq[h * 64 + lane]), c = fabsf(gk[h * 64 + lane]);
#pragma unroll
        for (int o_ = 1; o_ < 64; o_ <<= 1) { a = fmaxf(a, __shfl_xor(a, o_)); c = fmaxf(c, __shfl_xor(c, o_)); }
        sbound = 64.0f * 0.125f * 1.4426950408889634f * a * c * 1.02f + 0.5f; }
    if (FOX) { ADMA(NT - 1, 0); } else { ADMA(NT - 1, (NT - 1) & 3); ADMA(NT - 2, (NT - 2) & 3); ADMA(NT - 3, (NT - 3) & 3); }
    bf16x8 qr[4];
#pragma unroll
    for (int d0 = 0; d0 < 4; ++d0) qr[d0] = *reinterpret_cast<const bf16x8*>(&Qw[(long)r32 * PITCH + d0 * 16 + hi * 8]);
    f32x16 o[2]; o[0] = f32x16{}; o[1] = f32x16{};
    float m_run = -1e30f, l_run = 0.f, Rp = 1.0f;
    const int qpos = q0 + wid * 32 + r32;
    const int qlast = q0 + wid * 32 + 31;
    for (int it = 0; it < NT; ++it) {
        int t, slot;
        if (FOX) { t = NT - 1 - it; slot = it & 1; } else { t = (wid < 4) ? NT - 3 - it : NT - 1 - it; slot = t & 3; }
        AWAIT_BAR();
        if (FOX ? FOX_SKIP : SB_EARLY_EXIT) {
            const u32x4 f0 = *(ALAS const u32x4*)(flags), f1 = *(ALAS const u32x4*)(flags + 4);
            if ((f0.x & f0.y & f0.z & f0.w & f1.x & f1.y & f1.z & f1.w) != 0u) break;
        }
        if (FOX) { if (it + 1 < NT) ADMA(t - 1, slot ^ 1); }
        else { const int tn = NT - 4 - it; if (tn >= 0) ADMA(tn, tn & 3); if (t < 0) { if (lane == 0) flags[wid] = 1u; continue; } }
        if (KVBLK * t > qlast) continue;
        const bool band = (KVBLK * t + KVBLK - 1 > q0 + wid * 32 - (FOX ? 0 : 1));
        f32x16 p0, p1;
        if (FOX) { const ALAS f32x4* bp = (const ALAS f32x4*)(lds + L_B + slot * 256 + hi * 128);
            const f32x4 c0 = bp[0], c1 = bp[1], c2 = bp[2], c3 = bp[3], c4 = bp[4], c5 = bp[5], c6 = bp[6], c7 = bp[7];
            p0 = (f32x16){c0[0], c0[1], c0[2], c0[3], c1[0], c1[1], c1[2], c1[3], c2[0], c2[1], c2[2], c2[3], c3[0], c3[1], c3[2], c3[3]};
            p1 = (f32x16){c4[0], c4[1], c4[2], c4[3], c5[0], c5[1], c5[2], c5[3], c6[0], c6[1], c6[2], c6[3], c7[0], c7[1], c7[2], c7[3]};
        } else { p0 = f32x16{}; p1 = f32x16{}; }
        VFrag vf; v_issue(vf, vb0 + slot * SLOTB);
        { const ALAS unsigned char* kp = lds + L_K + slot * SLOTB + hi * 1024 + r32 * 16;
#pragma unroll
          for (int d0 = 0; d0 < 4; ++d0) { const bf16x8 b0 = *(const ALAS bf16x8*)(kp + d0 * 2048), b1 = *(const ALAS bf16x8*)(kp + d0 * 2048 + 512);
              p0 = __builtin_amdgcn_mfma_f32_32x32x16_bf16(b0, qr[d0], p0, 0, 0, 0); p1 = __builtin_amdgcn_mfma_f32_32x32x16_bf16(b1, qr[d0], p1, 0, 0, 0); } }
        const int kbase = KVBLK * t + hi * 32;
        if (FOX) {
            if (band) {
#pragma unroll
                for (int r = 0; r < 16; ++r) { if (kbase + r > qpos) p0[r] = -INFINITY; if (kbase + 16 + r > qpos) p1[r] = -INFINITY; } }
            float mx = fmaxf(p0[0], p1[0]);
#pragma unroll
            for (int r = 1; r < 16; ++r) mx = fmaxf(mx, fmaxf(p0[r], p1[r]));
            { auto rr = __builtin_amdgcn_permlane32_swap(__float_as_uint(mx), __float_as_uint(mx), false, false); mx = fmaxf(__uint_as_float(rr[0]), __uint_as_float(rr[1])); }
            const float m_new = fmaxf(m_run, mx);
            if (__any(m_new > m_run)) {
                const float alpha = __builtin_amdgcn_exp2f(m_run - m_new); l_run *= alpha; m_run = m_new;
                if (hi == 0) wsf[r32] = alpha;
                asm volatile("s_waitcnt lgkmcnt(0)" ::: "memory");
#pragma unroll
                for (int g = 0; g < 4; ++g) { const f32x4 a = *(const ALAS f32x4*)(wsf + 8 * g + 4 * hi);
#pragma unroll
                    for (int e = 0; e < 4; ++e) { o[0][4 * g + e] *= a[e]; o[1][4 * g + e] *= a[e]; } }
            }
            float sacc = 0.f;
#pragma unroll
            for (int r = 0; r < 16; ++r) { p0[r] = __builtin_amdgcn_exp2f(p0[r] - m_run); p1[r] = __builtin_amdgcn_exp2f(p1[r] - m_run); sacc += p0[r] + p1[r]; }
            l_run += sacc;
            if (FOX_SKIP) {
                const float b0 = *(const ALAS float*)(lds + L_B + slot * 256);
                const bool dead = __all(sbound + b0 - m_run < -150.0f);
                if (lane == 0) flags[wid] = dead ? 1u : 0u; }
        } else {
            float acc = 1.0f;
#pragma unroll
            for (int e = 31; e >= 0; --e) {
                const float tt = __builtin_amdgcn_exp2f(e < 16 ? p0[e] : p1[e - 16]);
                float kp_ = __builtin_amdgcn_rcpf(1.0f + tt);
                if (band) { const bool dead = (kbase + e >= qpos); kp_ = dead ? 1.0f : kp_; }
                const float accn = acc * kp_; const float w = acc - accn; acc = accn;
                if (e < 16) p0[e] = w; else p1[e - 16] = w;
            }
            auto rr = __builtin_amdgcn_permlane32_swap(__float_as_uint(acc), __float_as_uint(acc), false, false);
            const float t_lo = __uint_as_float(rr[0]), t_hi = __uint_as_float(rr[1]);
            const float off = hi ? Rp : Rp * t_hi;
#pragma unroll
            for (int r = 0; r < 16; ++r) { p0[r] *= off; p1[r] *= off; }
            Rp = Rp * t_lo * t_hi;
            if (SB_EARLY_EXIT) { const bool alldead = __all(Rp == 0.0f); if (lane == 0) flags[wid] = alldead ? 1u : 0u; }
        }
        u32x4 pw0, pw1, pw2, pw3;
        pw0 = (u32x4){cvtpk_s(p0[0], p0[1]), cvtpk_s(p0[2], p0[3]), cvtpk_s(p0[4], p0[5]), cvtpk_s(p0[6], p0[7])};
        pw1 = (u32x4){cvtpk_s(p0[8], p0[9]), cvtpk_s(p0[10], p0[11]), cvtpk_s(p0[12], p0[13]), cvtpk_s(p0[14], p0[15])};
        pw2 = (u32x4){cvtpk_s(p1[0], p1[1]), cvtpk_s(p1[2], p1[3]), cvtpk_s(p1[4], p1[5]), cvtpk_s(p1[6], p1[7])};
        pw3 = (u32x4){cvtpk_s(p1[8], p1[9]), cvtpk_s(p1[10], p1[11]), cvtpk_s(p1[12], p1[13]), cvtpk_s(p1[14], p1[15])};
        pv_mma(o, vf, __builtin_bit_cast(bf16x8, pw0), __builtin_bit_cast(bf16x8, pw1), __builtin_bit_cast(bf16x8, pw2), __builtin_bit_cast(bf16x8, pw3));
    }
    unsigned nxq = 0u; if (tid == 0) nxq = atomicAdd(qc, 1u);
    float rli[16];
    if (FOX) {
        { auto rr = __builtin_amdgcn_permlane32_swap(__float_as_uint(l_run), __float_as_uint(l_run), false, false); l_run = __uint_as_float(rr[0]) + __uint_as_float(rr[1]); }
        if (hi == 0) wsf[32 + r32] = l_run;
        asm volatile("s_waitcnt lgkmcnt(0)" ::: "memory");
#pragma unroll
        for (int r = 0; r < 16; ++r) rli[r] = __builtin_amdgcn_rcpf(wsf[32 + crow(r, hi)]);
    } else {
#pragma unroll
        for (int r = 0; r < 16; ++r) rli[r] = 1.0f;
    }
    bf16* Ow = O + (rowbase + q0 + wid * 32) * OPITCH + ((FOX ? 8 : 0) + h) * 64;
    { ALAS bf16* stg = (ALAS bf16*)(lds + L_OST) + wid * 2048;
#pragma unroll
      for (int r = 0; r < 16; ++r) { const int orow = crow(r, hi);
#pragma unroll
          for (int d0 = 0; d0 < 2; ++d0) stg[orow * 64 + d0 * 32 + r32] = (bf16)(cvtpk_s(o[d0][r] * rli[r], 0.f) & 0xffffu); }
      asm volatile("s_waitcnt lgkmcnt(0)" ::: "memory");
#pragma unroll
      for (int i = 0; i < 4; ++i) { const int row = i * 8 + (lane >> 3), ch = lane & 7; const u32x4 v = *(const ALAS u32x4*)(stg + row * 64 + ch * 8); *(u32x4*)(Ow + (long)row * OPITCH + ch * 8) = v; } }
    if (tid == 0) *qslot = nxq;
    asm volatile("s_waitcnt vmcnt(0) lgkmcnt(0)\n\ts_barrier" ::: "memory");
#undef ADMA
}
#undef AWAIT_BAR
#undef ASBAR
}
namespace fox {
using bf16 = unsigned short;
using bf16x8 = __attribute__((ext_vector_type(8))) short;
using s16x4 = __attribute__((ext_vector_type(4))) short;
using f32x16 = __attribute__((ext_vector_type(16))) float;
using f32x4 = __attribute__((ext_vector_type(4))) float;
using u32x4 = __attribute__((ext_vector_type(4))) unsigned;
constexpr int SEQ = 4096, DM = 3072, OPITCH = 1024, D = 64, NW = 8, QBLK = 32, QB = 256, KVBLK = 64;
__device__ __forceinline__ int crow(int r,int hi){return (r&3)+8*(r>>2)+4*hi;}
#define SBAR() __builtin_amdgcn_sched_barrier(0)
__device__ __forceinline__ void cmask(f32x16&p0,f32x16&p1,int jb,int qrel,int hi){
  const float NEG=-INFINITY; int kb=64*jb+4*hi;
  #pragma unroll
  for(int r=0;r<16;++r){int kv=kb+(r&3)+8*(r>>2); if(kv>qrel)p0[r]=NEG; if(kv+32>qrel)p1[r]=NEG;}
}

__device__ __forceinline__ void glds16(const void*gsrc,unsigned lds_dst){unsigned keep;
  asm volatile("s_mov_b32 %0, m0\n\ts_mov_b32 m0, %2\n\ts_nop 0\n\tglobal_load_lds_dwordx4 %1, off\n\ts_mov_b32 m0, %0":"=&s"(keep):"v"(gsrc),"s"(lds_dst):"memory");}
__device__ __forceinline__ float max3f(float a,float b,float c){float r;asm("v_max3_f32 %0, %1, %2, %3":"=v"(r):"v"(a),"v"(b),"v"(c));return r;}
__device__ __forceinline__ float max2f(float a,float b){float r;asm("v_max_f32_e32 %0, %1, %2":"=v"(r):"v"(a),"v"(b));return r;}
__device__ __forceinline__ float fadd_s(float a,float b){float r;asm("v_add_f32_e32 %0, %1, %2":"=v"(r):"v"(a),"v"(b));return r;}
__device__ __forceinline__ float fsub_s(float a,float b){float r;asm("v_sub_f32_e32 %0, %1, %2":"=v"(r):"v"(a),"v"(b));return r;}
typedef float f32x2_t __attribute__((ext_vector_type(2))); typedef __bf16 bf16x2_t __attribute__((ext_vector_type(2)));
__device__ __forceinline__ unsigned cvtpk_s(float lo,float hi){f32x2_t v={lo,hi};bf16x2_t b=__builtin_convertvector(v,bf16x2_t);return __builtin_bit_cast(unsigned,b);}
#define WAIT_BAR(N) asm volatile("s_waitcnt vmcnt(" #N ") lgkmcnt(0)\n\ts_barrier":::"memory")
typedef __attribute__((address_space(3))) const char* lds_cptr;
typedef short v4i16_t __attribute__((ext_vector_type(4)));
__device__ __forceinline__ void kload8(bf16x8*kf,lds_cptr kp){
  kf[0]=*(const __attribute__((address_space(3))) bf16x8*)(kp);      kf[1]=*(const __attribute__((address_space(3))) bf16x8*)(kp+512);
  kf[2]=*(const __attribute__((address_space(3))) bf16x8*)(kp+2048); kf[3]=*(const __attribute__((address_space(3))) bf16x8*)(kp+2560);
  kf[4]=*(const __attribute__((address_space(3))) bf16x8*)(kp+4096); kf[5]=*(const __attribute__((address_space(3))) bf16x8*)(kp+4608);
  kf[6]=*(const __attribute__((address_space(3))) bf16x8*)(kp+6144); kf[7]=*(const __attribute__((address_space(3))) bf16x8*)(kp+6656);
}
__device__ __forceinline__ void kload2(bf16x8*kf,lds_cptr kp,int j){ kf[2*j]=*(const __attribute__((address_space(3))) bf16x8*)(kp+j*2048); kf[2*j+1]=*(const __attribute__((address_space(3))) bf16x8*)(kp+j*2048+512); }
__device__ __forceinline__ s16x4 vtr(lds_cptr p){ return __builtin_bit_cast(s16x4,__builtin_amdgcn_ds_read_tr16_b64_v4i16((__attribute__((address_space(3))) v4i16_t*)p)); }
__device__ __forceinline__ float rowmax(const f32x16&p0,const f32x16&p1){
  float a=max3f(p0[0],p0[1],p1[0]),b=max3f(p0[2],p0[3],p1[1]);a=max3f(a,p1[2],p1[3]);
  #pragma unroll
  for(int r=4;r<16;r+=4){a=max3f(a,p0[r],p0[r+1]);b=max3f(b,p0[r+2],p0[r+3]);a=max3f(a,p1[r],p1[r+1]);b=max3f(b,p1[r+2],p1[r+3]);}
  const float m=max2f(a,b);
  auto rr=__builtin_amdgcn_permlane32_swap(__float_as_uint(m),__float_as_uint(m),false,false);
  return max2f(__uint_as_float(rr[0]),__uint_as_float(rr[1]));
}

__device__ __forceinline__ void pvd(f32x16* o, int vb, bf16x8 pa0, bf16x8 pa1, bf16x8 pa2, bf16x8 pa3) {
#pragma unroll
  for (int d0 = 0; d0 < 2; ++d0) { s16x4 lo[4], hi[4];
#pragma unroll
    for (int ks = 0; ks < 4; ++ks) {
      asm volatile("ds_read_b64_tr_b16 %0,%1 offset:%c2" : "=&v"(lo[ks]) : "v"(vb), "i"(d0 * 4096 + ks * 1024) : "memory");
      asm volatile("ds_read_b64_tr_b16 %0,%1 offset:%c2" : "=&v"(hi[ks]) : "v"(vb), "i"(d0 * 4096 + ks * 1024 + 512) : "memory"); }
    asm volatile("s_waitcnt lgkmcnt(0)" ::: "memory"); SBAR();
#define PK(k) (bf16x8){lo[k][0], lo[k][1], lo[k][2], lo[k][3], hi[k][0], hi[k][1], hi[k][2], hi[k][3]}
    o[d0] = __builtin_amdgcn_mfma_f32_32x32x16_bf16(pa0, PK(0), o[d0], 0, 0, 0);
    o[d0] = __builtin_amdgcn_mfma_f32_32x32x16_bf16(pa1, PK(1), o[d0], 0, 0, 0);
    o[d0] = __builtin_amdgcn_mfma_f32_32x32x16_bf16(pa2, PK(2), o[d0], 0, 0, 0);
    o[d0] = __builtin_amdgcn_mfma_f32_32x32x16_bf16(pa3, PK(3), o[d0], 0, 0, 0);
#undef PK
  }
}

constexpr int NSLOT = 3, SLOTB = 8192, KSLOTB = 9216;
constexpr int LDS_K = 0, LDS_V = NSLOT * KSLOTB, LDS_WS = LDS_V + NSLOT * SLOTB, LDS_OST = LDS_WS + NW * 64 * 4, LDS_BYTES = LDS_OST + NW * 4096;
#define KOFF(sl) ((sl) + ((sl) >> 3))
#define WB(n0, n1) do { if (wid == 0) { WAIT_BAR(n0); } else { WAIT_BAR(n1); } } while (0)
typedef __attribute__((address_space(3))) unsigned char* lds_ptr;
template <int THRL> __device__ __forceinline__ void fox_unit(int b, int h, int qb, const bf16* __restrict__ QKV, const float* __restrict__ kbias, const u32x4* __restrict__ kb16,
                                                             float sbound, bf16* O, lds_ptr shm, unsigned* qc, volatile __attribute__((address_space(3))) unsigned* qslot) {
  int tid_ = threadIdx.x; asm volatile("" : "+v"(tid_)); const int tid = tid_, lane = tid & 63, r32 = lane & 31, hi = lane >> 5; const int wid = __builtin_amdgcn_readfirstlane(tid >> 6);
  const long rowbase = (long)b * SEQ; const int q0 = qb * QB; const int colq = 1536 + h * D;
  const bf16* Qw = QKV + (rowbase + q0 + wid * QBLK) * DM + colq;
  const bf16* Kh = QKV + rowbase * DM + colq + 512; const bf16* Vh = QKV + rowbase * DM + colq + 1024;
  const float* kbh = kbias + (long)(b * 8 + h) * SEQ; const u32x4* kb16h = kb16 + (long)(b * 8 + h) * SEQ;
  const unsigned lds0 = (unsigned)(uintptr_t)shm;
  __attribute__((address_space(3))) float* wsf = (__attribute__((address_space(3))) float*)(shm + LDS_WS) + wid * 64;
  const int NT = (q0 + QB) / KVBLK;
  int T0 = 0;
  {
    const int tc = 2 * ((lane & 31) + 1);
    const bool valid = (lane < 32) && (tc <= NT - 4);
    const float bk = valid ? kbh[64 * tc - 1] : 0.f, bq = kbh[q0];
    const bool dead = valid && (bk < bq - 150.0f - 2.0f * sbound);
    T0 = 2 * __popcll(__ballot(dead)); }
  T0 = __builtin_amdgcn_readfirstlane(T0);
  const bf16* ksrc = Kh + (long)lane * DM + wid * 8;
  const bf16* vsrc = Vh + (long)(16 * (wid & 3) + (lane >> 2)) * DM + (wid >> 2) * 32 + (lane & 3) * 8;
  const u32x4* asrc = kb16h + lane;
  const unsigned kdst = lds0 + LDS_K + wid * 1024, adst = lds0 + LDS_K + 8192, vdst = lds0 + LDS_V + wid * 1024;
#define DMA_K(t, slot) do { glds16(ksrc + (long)(t) * KVBLK * DM, (unsigned)__builtin_amdgcn_readfirstlane(kdst + KOFF(slot))); \
                            if (wid == 0) glds16(asrc + (long)(t) * KVBLK, (unsigned)__builtin_amdgcn_readfirstlane(adst + KOFF(slot))); } while (0)
#define DMA_V(t, slot) glds16(vsrc + (long)(t) * KVBLK * DM, (unsigned)__builtin_amdgcn_readfirstlane(vdst + (slot)))
  const lds_cptr shm3 = (lds_cptr)shm; const lds_cptr kp0 = shm3 + LDS_K + hi * 1024 + r32 * 16; const lds_cptr ka0 = shm3 + LDS_K + 8192 + r32 * 16;
  const lds_cptr vp0 = shm3 + LDS_V + ((lane >> 4) & 1) * 32 + (lane & 3) * 8 + (4 * hi + ((lane & 15) >> 2)) * 64;
  const int vb0 = (int)(lds0 + LDS_V) + ((lane >> 4) & 1) * 32 + (lane & 3) * 8 + (4 * hi + ((lane & 15) >> 2)) * 64;
  bf16x8 kf[8], ka[2];
#define ALOAD(sl) do { ka[0] = *(const __attribute__((address_space(3))) bf16x8*)(ka0 + KOFF(sl)); ka[1] = *(const __attribute__((address_space(3))) bf16x8*)(ka0 + KOFF(sl) + 512); } while (0)
  DMA_K(T0, 0); DMA_V(T0, 0); DMA_K(T0 + 1, SLOTB);
  bf16x8 qr[4];
#pragma unroll
  for (int d0 = 0; d0 < 4; ++d0) qr[d0] = *reinterpret_cast<const bf16x8*>(&Qw[(long)r32 * DM + d0 * 16 + hi * 8]);
  const short one = hi ? (short)0 : (short)0x3F80;
  bf16x8 qa = (bf16x8){one, one, one, 0, 0, 0, 0, 0}; asm volatile("" : "+v"(qa));
  float l_reg = 0.f; f32x16 o[2]; o[0] = f32x16{}; o[1] = f32x16{};
  const int qrel = wid * QBLK + r32;
  f32x16 negm; { const float nb = -(kbh[q0 + qrel] + fmaxf(sbound - 40.0f, 0.0f));
    _Pragma("unroll") for (int r = 0; r < 16; ++r) negm[r] = nb; } asm volatile("" : "+v"(negm));
#define CMASK(P0, P1, t) do { int jb_ = (t) - (NT - 4); if (jb_ >= 0) cmask(P0, P1, jb_, qrel, hi); } while (0)
#define START(P0, P1) do { _Pragma("unroll") for (int r = 0; r < 16; ++r) P0[r] = __builtin_amdgcn_exp2f(P0[r]); } while (0)
#define RESC() do {} while (0)
  f32x16 pA0, pA1, pB0, pB1;
  int sl_prev = 0, sl_cur = 0, sl_next = SLOTB;
#define ROT() do { sl_prev = sl_cur; sl_cur = sl_next; sl_next = (sl_next == (NSLOT - 1) * SLOTB) ? 0 : sl_next + SLOTB; } while (0)
  DMA_K(T0 + 2, 2 * SLOTB);
  WB(5, 3);
  { kload8(kf, kp0); ALOAD(0);
    pA0 = __builtin_amdgcn_mfma_f32_32x32x16_bf16(kf[0], qr[0], negm, 0, 0, 0); pA1 = __builtin_amdgcn_mfma_f32_32x32x16_bf16(kf[1], qr[0], negm, 0, 0, 0);
    pA0 = __builtin_amdgcn_mfma_f32_32x32x16_bf16(kf[2], qr[1], pA0, 0, 0, 0);  pA1 = __builtin_amdgcn_mfma_f32_32x32x16_bf16(kf[3], qr[1], pA1, 0, 0, 0);
    pA0 = __builtin_amdgcn_mfma_f32_32x32x16_bf16(kf[4], qr[2], pA0, 0, 0, 0);  pA1 = __builtin_amdgcn_mfma_f32_32x32x16_bf16(kf[5], qr[2], pA1, 0, 0, 0);
    pA0 = __builtin_amdgcn_mfma_f32_32x32x16_bf16(kf[6], qr[3], pA0, 0, 0, 0);  pA1 = __builtin_amdgcn_mfma_f32_32x32x16_bf16(kf[7], qr[3], pA1, 0, 0, 0);
    pA0 = __builtin_amdgcn_mfma_f32_32x32x16_bf16(ka[0], qa, pA0, 0, 0, 0);     pA1 = __builtin_amdgcn_mfma_f32_32x32x16_bf16(ka[1], qa, pA1, 0, 0, 0); }
  asm volatile("s_nop 15\n\ts_nop 7" : "+v"(pA0), "+v"(pA1)); CMASK(pA0, pA1, T0);
  START(pA0, pA1);
  _Pragma("unroll") for (int r = 0; r < 16; ++r) pA1[r] = __builtin_amdgcn_exp2f(pA1[r]);
  WAIT_BAR(0);
  DMA_K(T0 + 3, 0); DMA_V(T0 + 1, SLOTB);
  ROT();
  kload8(kf, kp0 + KOFF(sl_cur)); ALOAD(sl_cur);
  WB(3, 2);
  s16x4 vlo[8], vhi[8]; u32x4 pw0, pw1, pw2, pw3;
#define PKW(P, B) cvtpk_s(P[B], P[B + 1])
#define PAF(k) __builtin_bit_cast(bf16x8, pw##k)
#define VFR(i) (bf16x8){vlo[i][0], vlo[i][1], vlo[i][2], vlo[i][3], vhi[i][0], vhi[i][1], vhi[i][2], vhi[i][3]}
#define PIN(x) asm volatile("" : "+v"(x))
#define MX3(a, b, c) __builtin_fmaxf(__builtin_fmaxf((a), (b)), (c))
#define GAPA(MF, A0, A1, A2, A3, W0, W1, PW) do { MF; sacc += A0; sacc += A1; sacc += A2; sacc += A3; PIN(sacc); W0; W1; PIN(PW); SBAR(); } while (0)
#define EX(v) __builtin_amdgcn_exp2f(v)
#define GAPB(MF, X, B) do { MF; X[B] = EX(X[B]); X[B + 1] = EX(X[B + 1]); X[B + 2] = EX(X[B + 2]); X[B + 3] = EX(X[B + 3]); PIN(X); SBAR(); } while (0)
#define VRD(i) do { vlo[i] = vtr(vp_ + (((i) >> 2) * 4096 + ((i) & 3) * 1024)); vhi[i] = vtr(vp_ + (((i) >> 2) * 4096 + ((i) & 3) * 1024 + 512)); } while (0)
#define KRD(G, j) do { if (G) { kload2(kf, kp0 + KOFF(sl_next), j); SBAR(); } } while (0)
#define KRDA(G) do { if (G) { ALOAD(sl_next); SBAR(); } } while (0)
#define STEP(C0, C1, P0, P1, t, GK, GV, GL) do { SBAR(); \
    const lds_cptr vp_ = vp0 + sl_prev; \
    VRD(0); SBAR(); float sacc = (P0[0] + P0[1]); \
    GAPA(C0 = __builtin_amdgcn_mfma_f32_32x32x16_bf16(kf[0], qr[0], negm, 0, 0, 0), P0[2], P0[3], P0[4], P0[5],     pw0[0] = PKW(P0, 0), pw0[1] = PKW(P0, 2), pw0); \
    VRD(4); SBAR(); GAPA(C1 = __builtin_amdgcn_mfma_f32_32x32x16_bf16(kf[1], qr[0], negm, 0, 0, 0), P0[6], P0[7], P0[8], P0[9],     pw0[2] = PKW(P0, 4), pw0[3] = PKW(P0, 6), pw0); \
    VRD(1); SBAR(); GAPA(C0 = __builtin_amdgcn_mfma_f32_32x32x16_bf16(kf[2], qr[1], C0, 0, 0, 0),   P0[10], P0[11], P0[12], P0[13], pw1[0] = PKW(P0, 8), pw1[1] = PKW(P0, 10), pw1); \
    VRD(5); SBAR(); GAPA(C1 = __builtin_amdgcn_mfma_f32_32x32x16_bf16(kf[3], qr[1], C1, 0, 0, 0),   P0[14], P0[15], P1[0], P1[1],   pw1[2] = PKW(P0, 12), pw1[3] = PKW(P0, 14), pw1); \
    VRD(2); SBAR(); GAPA(C0 = __builtin_amdgcn_mfma_f32_32x32x16_bf16(kf[4], qr[2], C0, 0, 0, 0),   P1[2], P1[3], P1[4], P1[5],     pw2[0] = PKW(P1, 0), pw2[1] = PKW(P1, 2), pw2); \
    VRD(6); SBAR(); GAPA(C1 = __builtin_amdgcn_mfma_f32_32x32x16_bf16(kf[5], qr[2], C1, 0, 0, 0),   P1[6], P1[7], P1[8], P1[9],     pw2[2] = PKW(P1, 4), pw2[3] = PKW(P1, 6), pw2); \
    VRD(3); SBAR(); GAPA(C0 = __builtin_amdgcn_mfma_f32_32x32x16_bf16(kf[6], qr[3], C0, 0, 0, 0),   P1[10], P1[11], P1[12], P1[13], pw3[0] = PKW(P1, 8), pw3[1] = PKW(P1, 10), pw3); \
    VRD(7); SBAR(); GAPA(C1 = __builtin_amdgcn_mfma_f32_32x32x16_bf16(kf[7], qr[3], C1, 0, 0, 0),   P1[14], P1[15], 0.f, 0.f,       pw3[2] = PKW(P1, 12), pw3[3] = PKW(P1, 14), pw3); \
    C0 = __builtin_amdgcn_mfma_f32_32x32x16_bf16(ka[0], qa, C0, 0, 0, 0); C1 = __builtin_amdgcn_mfma_f32_32x32x16_bf16(ka[1], qa, C1, 0, 0, 0); SBAR(); \
    l_reg += sacc; \
    if (GK) { DMA_K((t) + 3, sl_cur); } if (GV) { DMA_V((t) + 1, sl_next); } \
    CMASK(C0, C1, t); \
    SBAR(); \
    GAPB(o[0] = __builtin_amdgcn_mfma_f32_32x32x16_bf16(PAF(0), VFR(0), o[0], 0, 0, 0), C0, 0); \
    GAPB(o[1] = __builtin_amdgcn_mfma_f32_32x32x16_bf16(PAF(0), VFR(4), o[1], 0, 0, 0), C0, 4); \
    KRD(GL, 0); GAPB(o[0] = __builtin_amdgcn_mfma_f32_32x32x16_bf16(PAF(1), VFR(1), o[0], 0, 0, 0), C0, 8); \
    KRD(GL, 1); GAPB(o[1] = __builtin_amdgcn_mfma_f32_32x32x16_bf16(PAF(1), VFR(5), o[1], 0, 0, 0), C0, 12); \
    KRD(GL, 2); GAPB(o[0] = __builtin_amdgcn_mfma_f32_32x32x16_bf16(PAF(2), VFR(2), o[0], 0, 0, 0), C1, 0); \
    KRD(GL, 3); GAPB(o[1] = __builtin_amdgcn_mfma_f32_32x32x16_bf16(PAF(2), VFR(6), o[1], 0, 0, 0), C1, 4); \
    KRDA(GL); GAPB(o[0] = __builtin_amdgcn_mfma_f32_32x32x16_bf16(PAF(3), VFR(3), o[0], 0, 0, 0), C1, 8); \
    GAPB(o[1] = __builtin_amdgcn_mfma_f32_32x32x16_bf16(PAF(3), VFR(7), o[1], 0, 0, 0), C1, 12); \
    } while (0)
  int t = T0 + 1;
#undef CMASK
#define CMASK(P0, P1, t) do {} while (0)
  for (; t + 5 < NT; t += 2) {
    STEP(pB0, pB1, pA0, pA1, t, true, true, true);     WB(3, 2); RESC(); ROT();
    STEP(pA0, pA1, pB0, pB1, t + 1, true, true, true); WB(3, 2); RESC(); ROT();
  }
#undef CMASK
#define CMASK(P0, P1, t) do { int jb_ = (t) - (NT - 4); if (jb_ >= 0) cmask(P0, P1, jb_, qrel, hi); } while (0)
#define ENDW(tt) do { if ((tt) + 3 < NT) { WB(3, 2); } else if ((tt) + 2 < NT) { WAIT_BAR(1); } else { WAIT_BAR(0); } } while (0)
  for (; t + 1 < NT; t += 2) {
    STEP(pB0, pB1, pA0, pA1, t, (t + 3 < NT), (t + 1 < NT), (t + 1 < NT));         ENDW(t);     RESC(); ROT();
    STEP(pA0, pA1, pB0, pB1, t + 1, (t + 4 < NT), (t + 2 < NT), (t + 2 < NT));     ENDW(t + 1); RESC(); ROT();
  }
  STEP(pB0, pB1, pA0, pA1, NT - 1, false, false, false); RESC();
  { float sacc = pB0[0] + pB0[1]; _Pragma("unroll") for (int r = 2; r < 16; ++r) sacc += pB0[r]; _Pragma("unroll") for (int r = 0; r < 16; ++r) sacc += pB1[r]; l_reg += sacc;
    pw0 = (u32x4){PKW(pB0, 0), PKW(pB0, 2), PKW(pB0, 4), PKW(pB0, 6)}; pw1 = (u32x4){PKW(pB0, 8), PKW(pB0, 10), PKW(pB0, 12), PKW(pB0, 14)};
    pw2 = (u32x4){PKW(pB1, 0), PKW(pB1, 2), PKW(pB1, 4), PKW(pB1, 6)}; pw3 = (u32x4){PKW(pB1, 8), PKW(pB1, 10), PKW(pB1, 12), PKW(pB1, 14)};
    SBAR(); pvd(o, vb0 + sl_cur, PAF(0), PAF(1), PAF(2), PAF(3)); }
  unsigned nxq = 0u; if (tid == 0) nxq = atomicAdd(qc, 1u);
  { auto rr = __builtin_amdgcn_permlane32_swap(__float_as_uint(l_reg), __float_as_uint(l_reg), false, false); l_reg = __uint_as_float(rr[0]) + __uint_as_float(rr[1]); }
  if (hi == 0) wsf[32 + r32] = l_reg; asm volatile("s_waitcnt lgkmcnt(0)" ::: "memory");
  float rli[16];
#pragma unroll
  for (int r = 0; r < 16; ++r) rli[r] = __builtin_amdgcn_rcpf(wsf[32 + crow(r, hi)]);
  bf16* Ow = O + (rowbase + q0 + wid * QBLK) * OPITCH + (8 + h) * D;
  { __attribute__((address_space(3))) bf16* stg = (__attribute__((address_space(3))) bf16*)(shm + LDS_OST) + wid * 2048;
#pragma unroll
    for (int r = 0; r < 16; ++r) { const int orow = crow(r, hi);
#pragma unroll
      for (int d0 = 0; d0 < 2; ++d0) stg[orow * 64 + d0 * 32 + r32] = (bf16)(cvtpk_s(o[d0][r] * rli[r], 0.f) & 0xffffu); }
    asm volatile("s_waitcnt lgkmcnt(0)" ::: "memory");
#pragma unroll
    for (int i = 0; i < 4; ++i) { const int row = i * 8 + (lane >> 3), ch = lane & 7; const u32x4 v = *(const __attribute__((address_space(3))) u32x4*)(stg + row * 64 + ch * 8); *(u32x4*)(Ow + (long)row * OPITCH + ch * 8) = v; } }
  if (tid == 0) *qslot = nxq;
  asm volatile("s_waitcnt vmcnt(0) lgkmcnt(0)\n\ts_barrier" ::: "memory");
#undef DMA_K
#undef DMA_V
#undef ALOAD
#undef CMASK
#undef START
#undef RESC
#undef ROT
#undef PKW
#undef PAF
#undef VFR
#undef PIN
#undef MX3
#undef GAPA
#undef GAPB
#undef EX
#undef VRD
#undef KRD
#undef KRDA
#undef STEP
#undef ENDW
}
#undef KOFF
#undef SBAR
#undef WAIT_BAR
}
constexpr int NWAVES = 8;
constexpr int BATCH = 8, SEQ = 4096, D = 1024, FF = 2816, M = BATCH * SEQ, NMOD = 9 * D, INW = 3080, NQKV = 3072;
constexpr float EPS = 1e-6f, LOG2E = 1.4426950408889634f;
constexpr size_t MiB = 1u << 20;
constexpr size_t WS_MOD = 0, WS_LF = 1 * MiB, WS_KB = 2 * MiB, WS_CTL = 3 * MiB, WS_W1GU = 4 * MiB, WS_W1D = 16 * MiB, WS_W2GU = 22 * MiB, WS_W2D = 34 * MiB, WS_WIN = 40 * MiB, WS_WO = 46 * MiB, WS_KB16 = 48 * MiB,
                 WS_H = 64 * MiB, WS_ACT = 128 * MiB, WS_X1 = 320 * MiB, WS_END = 384 * MiB;
constexpr int RING_BYTES = 131072, MISC_OFF = RING_BYTES + 320, LDS_BYTES = 147456;
static_assert(att::L_BYTES <= RING_BYTES && fox::LDS_BYTES <= RING_BYTES, "attention LDS");
#define LAS __attribute__((address_space(3)))
typedef unsigned short bf16;
typedef unsigned v4u __attribute__((ext_vector_type(4)));
typedef unsigned v2u __attribute__((ext_vector_type(2)));
typedef float f32x4 __attribute__((ext_vector_type(4)));
__device__ __forceinline__ unsigned f2bf(float f) { unsigned u = __builtin_bit_cast(unsigned, f); return (u + 0x7fffu + ((u >> 16) & 1u)) >> 16; }
__device__ __forceinline__ unsigned pk2(float lo, float hi) { return f2bf(lo) | (f2bf(hi) << 16); }
__device__ __forceinline__ float wave_sum(float v) {
#pragma unroll
    for (int o = 1; o < 64; o <<= 1) v += __shfl_xor(v, o);
    return v;
}
struct Params {
    const float *x, *c, *w_mod, *b_mod, *g_ffn1, *w1_gate, *w1_up, *w1_down, *g_mix, *w_in, *b_f, *g_q, *g_k, *w_o, *g_ffn2, *w2_gate, *w2_up, *w2_down;
    float* out; unsigned char* ws;
};
__device__ __forceinline__ void transpose_item(const float* W, int K, int ldw, bf16* WT, int k0, int n0, int dst_n0, float scale, LAS float* scr, int lane) {
#pragma unroll
    for (int i = 0; i < 32; ++i) { const int kk = 2 * i + (lane >> 5); scr[kk * 33 + (lane & 31)] = W[(size_t)(k0 + kk) * ldw + n0 + (lane & 31)] * scale; }
    asm volatile("s_waitcnt lgkmcnt(0)" ::: "memory");
    const int c = lane & 7;
#pragma unroll
    for (int j = 0; j < 4; ++j) { const int n = (lane >> 3) + 8 * j; const LAS float* s = scr + (8 * c) * 33 + n;
        v4u o; o.x = pk2(s[0 * 33], s[1 * 33]); o.y = pk2(s[2 * 33], s[3 * 33]); o.z = pk2(s[4 * 33], s[5 * 33]); o.w = pk2(s[6 * 33], s[7 * 33]);
        *(v4u*)(WT + (size_t)(dst_n0 + n) * K + k0 + 8 * c) = o; }
    asm volatile("s_waitcnt lgkmcnt(0)" ::: "memory");
}
__device__ __forceinline__ int dst_row_block(int mode, int n0) {
    if (mode == 1) return 256 * (n0 >> 7) + (n0 & 127);
    if (mode == 2) return 256 * (n0 >> 7) + 128 + (n0 & 127);
    if (mode == 3) { const int pn = n0 >> 8, wc = (n0 >> 6) & 3, bj = (n0 >> 5) & 1; return 256 * pn + 128 * bj + 32 * wc; }
    return n0;
}
__device__ __forceinline__ void convert_matrix(const float* W, int K, int ldw, int N, bf16* WT, int mode, int& base, int gw, int NGW, LAS float* scr, int lane) {
    const int nblk = N / 32, items = (K / 64) * nblk;
    const float scale = (mode == 1) ? -1.4426950408889634f : (mode == 2) ? -0.6931471805599453f : 1.0f;
    int first = (gw - base % NGW + NGW) % NGW;
    for (int it = first; it < items; it += NGW) { const int kb = it / nblk, nb = it % nblk; transpose_item(W, K, ldw, WT, 64 * kb, 32 * nb, dst_row_block(mode, 32 * nb), scale, scr, lane); }
    base += items;
}
__device__ __forceinline__ void mod_item(const Params& p, int nb, LAS unsigned char* lds, int tid) {
    LAS float* sc = (LAS float*)lds;
    LAS float* red = (LAS float*)(lds + 32768);
    for (int i = tid; i < 8192; i += 512) { const int k = i >> 3, b = i & 7; const float v = p.c[b * D + k]; sc[i] = v / (1.0f + __expf(-v)); }
    __syncthreads();
    const int kg = tid >> 5, cgp = tid & 31; const int col = nb * 128 + 4 * cgp;
    f32x4 acc[8];
#pragma unroll
    for (int b = 0; b < 8; ++b) acc[b] = (f32x4){0.f, 0.f, 0.f, 0.f};
#pragma unroll 8
    for (int kk = 0; kk < 64; ++kk) { const int k = kg * 64 + kk; const f32x4 w = *(const f32x4*)(p.w_mod + (size_t)k * NMOD + col);
        const f32x4 s0 = *(const LAS f32x4*)(sc + k * 8), s1 = *(const LAS f32x4*)(sc + k * 8 + 4);
        acc[0] += w * s0[0]; acc[1] += w * s0[1]; acc[2] += w * s0[2]; acc[3] += w * s0[3]; acc[4] += w * s1[0]; acc[5] += w * s1[1]; acc[6] += w * s1[2]; acc[7] += w * s1[3]; }
#pragma unroll
    for (int b = 0; b < 8; ++b) *(LAS f32x4*)(red + (kg * 8 + b) * 128 + 4 * cgp) = acc[b];
    __syncthreads();
    for (int o = tid; o < 1024; o += 512) { const int b = o >> 7, cc = o & 127; float s = p.b_mod[nb * 128 + cc];
#pragma unroll
        for (int g = 0; g < 16; ++g) s += red[(g * 8 + b) * 128 + cc];
        ((float*)(p.ws + WS_MOD))[b * NMOD + nb * 128 + cc] = s; }
    __syncthreads();
}
template <bool FOXF, bool XB16>
__device__ __forceinline__ void norm_phase(const Params& p, const void* X, const float* g, int sh_off, int sc_off, bf16* H, LAS unsigned char* lds, int gw, int NGW, int lane, int tid) {
    LAS float* wf = (LAS float*)lds;
    if (FOXF) { for (int i = tid; i < 8192; i += 512) wf[i] = p.w_in[(size_t)(i >> 3) * INW + NQKV + (i & 7)]; __syncthreads(); }
    const float* mod = (const float*)(p.ws + WS_MOD);
    for (int m0 = gw * 16; m0 < M; m0 += NGW * 16) {
    const int b = m0 / SEQ;
    f32x4 a[4], sh[4];
#pragma unroll
    for (int j = 0; j < 4; ++j) { const int col = 4 * lane + 256 * j; const f32x4 gv = *(const f32x4*)(g + col), sv = *(const f32x4*)(mod + (size_t)b * NMOD + sc_off + col);
        a[j] = gv * (sv + 1.0f); sh[j] = *(const f32x4*)(mod + (size_t)b * NMOD + sh_off + col); }
    for (int r4 = 0; r4 < 16; r4 += 4) {
        v2u rb[4][4]; f32x4 rf[4][4];
#pragma unroll
        for (int q = 0; q < 4; ++q)
#pragma unroll
            for (int j = 0; j < 4; ++j) {
                if (XB16) rb[q][j] = *(const v2u*)((const bf16*)X + (size_t)(m0 + r4 + q) * D + 4 * lane + 256 * j);
                else rf[q][j] = *(const f32x4*)((const float*)X + (size_t)(m0 + r4 + q) * D + 4 * lane + 256 * j); }
#pragma unroll
        for (int q = 0; q < 4; ++q) { const int m = m0 + r4 + q;
        f32x4 v[4]; float ss = 0.f;
#pragma unroll
        for (int j = 0; j < 4; ++j) {
            if (XB16) { const v2u w = rb[q][j]; v[j] = (f32x4){__uint_as_float(w.x << 16), __uint_as_float(w.x & 0xffff0000u), __uint_as_float(w.y << 16), __uint_as_float(w.y & 0xffff0000u)}; }
            else v[j] = rf[q][j];
            ss += (v[j].x * v[j].x + v[j].y * v[j].y) + (v[j].z * v[j].z + v[j].w * v[j].w); }
        const float rstd = __builtin_amdgcn_rsqf(wave_sum(ss) * (1.0f / D) + EPS);
#pragma unroll
        for (int j = 0; j < 4; ++j) { v[j] = v[j] * rstd * a[j] + sh[j];
            v2u o; o.x = pk2(v[j].x, v[j].y); o.y = pk2(v[j].z, v[j].w); *(v2u*)(H + (size_t)m * D + 4 * lane + 256 * j) = o; }
        if (FOXF) { float f[8];
#pragma unroll
            for (int qq = 0; qq < 8; ++qq) f[qq] = 0.f;
#pragma unroll
            for (int j = 0; j < 4; ++j)
#pragma unroll
                for (int e_ = 0; e_ < 4; ++e_) { const LAS float* wr = wf + (4 * lane + 256 * j + e_) * 8; const f32x4 w0 = *(const LAS f32x4*)wr, w1 = *(const LAS f32x4*)(wr + 4); const float hv = v[j][e_];
                    f[0] += hv * w0[0]; f[1] += hv * w0[1]; f[2] += hv * w0[2]; f[3] += hv * w0[3]; f[4] += hv * w1[0]; f[5] += hv * w1[1]; f[6] += hv * w1[2]; f[7] += hv * w1[3]; }
#pragma unroll
            for (int i = 0; i < 4; ++i) { const float snd = (lane & 1) ? f[i] : f[i + 4], kp = (lane & 1) ? f[i + 4] : f[i]; f[i] = kp + __shfl_xor(snd, 1); }
#pragma unroll
            for (int i = 0; i < 2; ++i) { const float snd = (lane & 2) ? f[i] : f[i + 2], kp = (lane & 2) ? f[i + 2] : f[i]; f[i] = kp + __shfl_xor(snd, 2); }
            { const float snd = (lane & 4) ? f[0] : f[1], kp = (lane & 4) ? f[1] : f[0]; f[0] = kp + __shfl_xor(snd, 4); }
            f[0] += __shfl_xor(f[0], 8); f[0] += __shfl_xor(f[0], 16); f[0] += __shfl_xor(f[0], 32);
            const int jidx = ((lane >> 2) & 1) + 2 * ((lane >> 1) & 1) + 4 * (lane & 1);
            if (lane < 8) { const float z = f[0] + p.b_f[jidx]; const float ls = fminf(z, 0.f) - log1pf(__expf(-fabsf(z))); ((float*)(p.ws + WS_LF))[(size_t)m * 8 + jidx] = ls; } }
        }
    }
    }
}
__device__ __forceinline__ void cumsum_item(const Params& p, int bh, LAS unsigned char* lds, int tid, int lane, int wave) {
    const float* LF = (const float*)(p.ws + WS_LF); float* KB = (float*)(p.ws + WS_KB);
    LAS float* wt = (LAS float*)lds;
    const int b = bh >> 3, h = bh & 7, s0 = tid * 8;
    float v[8]; float run = 0.f;
#pragma unroll
    for (int i = 0; i < 8; ++i) { run += LF[((size_t)b * SEQ + s0 + i) * 8 + h]; v[i] = run; }
    float inc = run;
    for (int o = 1; o < 64; o <<= 1) { const float t = __shfl_up(inc, o); if (lane >= o) inc += t; }
    if (lane == 63) wt[wave] = inc;
    __syncthreads();
    float pre = inc - run;
    for (int w = 0; w < wave; ++w) pre += wt[w];
    v4u* KB16 = (v4u*)(p.ws + WS_KB16);
#pragma unroll
    for (int i = 0; i < 8; ++i) { const float bv = -(pre + v[i]) * LOG2E; KB[(size_t)bh * SEQ + s0 + i] = bv;
        const unsigned h_ = f2bf(bv); const float r1 = bv - __uint_as_float(h_ << 16); const unsigned m_ = f2bf(r1); const float r2 = r1 - __uint_as_float(m_ << 16); const unsigned l_ = f2bf(r2);
        KB16[(size_t)bh * SEQ + s0 + i] = (v4u){h_ | (m_ << 16), l_, 0u, 0u}; }
    __syncthreads();
}

typedef __attribute__((address_space(1))) unsigned gu32;
#define XB_TMO      128
#define XB_XCNT(j)  (256  + 64 * (j))
#define XB_XSUB(j)  (1280 + 64 * (j))
#define XB_XGEN(j)  (2304 + 64 * (j))
#define XB_TOP      3328
#define XB_TOPGEN   3392
#define XCD_BAR_WORDS 3456
#define XB_SPIN_CAP (1u << 18)

__device__ __forceinline__ unsigned xb_ld(unsigned* p)              { return __hip_atomic_load(p, __ATOMIC_RELAXED, __HIP_MEMORY_SCOPE_AGENT); }
__device__ __forceinline__ unsigned xb_add(unsigned* p, unsigned v) { return __hip_atomic_fetch_add(p, v, __ATOMIC_RELAXED, __HIP_MEMORY_SCOPE_AGENT); }
__device__ __forceinline__ unsigned xb_xcc_id() { return (unsigned)__builtin_amdgcn_s_getreg((3 << 11) | 20) & 0xFu; }
#define XB_SPIN(cond, bar) do { unsigned _sp = 0; while (cond) { __builtin_amdgcn_s_sleep(1); \
    if ((++_sp & 255u) == 0u) { if (xb_ld(&(bar)[XB_TMO])) break; if (_sp > XB_SPIN_CAP) { atomicAdd(&(bar)[XB_TMO], 1u); break; } } } } while (0)

struct XcdBarrier {
    unsigned* bar; unsigned x;
    volatile LAS unsigned* st;
};

__device__ __forceinline__ XcdBarrier xcd_barrier_post(unsigned* bar, volatile LAS unsigned* st) {
    XcdBarrier b; b.bar = bar; b.x = xb_xcc_id(); b.st = st;
    if (threadIdx.x == 0) (void)xb_add(&bar[XB_XCNT(b.x)], 1u);
    return b;
}
__device__ __forceinline__ void xcd_barrier_complete(unsigned* bar, unsigned x, unsigned& nloc, unsigned& nx) {
    const unsigned G = gridDim.x * gridDim.y * gridDim.z;
    unsigned sum, cnt, mine, sp = 0u;
    for (;;) {
        sum = 0u; cnt = 0u; mine = 0u;
#pragma unroll
        for (unsigned j = 0; j < 16; ++j) { const unsigned c = xb_ld(&bar[XB_XCNT(j)]); sum += c; cnt += (c > 0u) ? 1u : 0u; mine = (j == x) ? c : mine; }
        if (sum == G) break;
        __builtin_amdgcn_s_sleep(1);
        if ((++sp & 255u) == 0u) { if (xb_ld(&bar[XB_TMO])) break; if (sp > XB_SPIN_CAP) { atomicAdd(&bar[XB_TMO], 1u); break; } }
    }
    nloc = mine > 0u ? mine : 1u; nx = cnt > 0u ? cnt : 1u;
}

__device__ __forceinline__ void xcd_barrier(const XcdBarrier& b) {
    asm volatile("s_waitcnt vmcnt(0)" ::: "memory");
    __syncthreads();
    if (threadIdx.x == 0) {
        unsigned* bar = b.bar;
        __builtin_amdgcn_s_waitcnt(0);
        unsigned nloc = b.st[0], nx = b.st[1];
        if (nloc == 0u) { xcd_barrier_complete(bar, b.x, nloc, nx); b.st[0] = nloc; b.st[1] = nx; }
        const unsigned old = xb_add(&bar[XB_XSUB(b.x)], 1u);
        const unsigned gen = old / nloc;
        if (old + 1u == (gen + 1u) * nloc) {
            __builtin_amdgcn_fence(__ATOMIC_RELEASE, "agent");
            asm volatile("s_waitcnt vmcnt(0)" ::: "memory");
            const unsigned og = xb_add(&bar[XB_TOP], 1u);
            const unsigned tg = og / nx;
            if (og + 1u == (tg + 1u) * nx) xb_add(&bar[XB_TOPGEN], 1u);
            else XB_SPIN(xb_ld(&bar[XB_TOPGEN]) == tg, bar);
            __builtin_amdgcn_fence(__ATOMIC_ACQUIRE, "agent");
            xb_add(&bar[XB_XGEN(b.x)], 1u);
            asm volatile("s_waitcnt vmcnt(0)" ::: "memory");
        } else {
            XB_SPIN(xb_ld(&bar[XB_XGEN(b.x)]) == gen, bar);
            __builtin_amdgcn_fence(__ATOMIC_ACQUIRE, "agent");
            asm volatile("s_waitcnt vmcnt(0)" ::: "memory");
        }
    }
    __syncthreads();
}

#ifndef GU_ALIGN
#define GU_ALIGN true
#endif
#ifndef RESID_ALIGN
#define RESID_ALIGN true
#endif
#ifndef FOX_PIPE
#define FOX_PIPE 1
#endif
#ifndef DUP_MISC
#define DUP_MISC 0
#endif
#ifndef DUP_ATT_FOX
#define DUP_ATT_FOX 0
#endif
#ifndef DUP_ATT_SB
#define DUP_ATT_SB 1
#endif
#ifndef DUP_GU
#define DUP_GU 0
#endif
#ifndef DUP_D1
#define DUP_D1 0
#endif
#ifndef DUP_SYNC
#define DUP_SYNC 0
#endif
__global__ void __launch_bounds__(NWAVES * 64, 2) hymba_fwd(Params p) {
    extern __shared__ __attribute__((aligned(16))) unsigned char lds_raw[];
    LAS unsigned char* lds = (LAS unsigned char*)lds_raw;
    cg::grid_group grid = cg::this_grid();
    const int wave = __builtin_amdgcn_readfirstlane((int)threadIdx.x >> 6);
    const int G = gridDim.x, bx = blockIdx.x;
#define FRESH_TID() int tid = threadIdx.x; asm volatile("" : "+v"(tid)); const int lane = tid & 63
    const int vcu = (G % 8 == 0) ? (bx % 8) * (G / 8) + bx / 8 : bx;
    const int gw = vcu * NWAVES + wave, NGW = G * NWAVES;
    unsigned char* ws = p.ws;
    volatile LAS unsigned* MISC = (volatile LAS unsigned*)(lds + MISC_OFF);
    if (threadIdx.x < 32) MISC[threadIdx.x] = 0u;
    unsigned* barw = (unsigned*)(ws + WS_CTL);
    __syncthreads();
    XcdBarrier xbar = xcd_barrier_post(barw, MISC + 8);
    if (ws == nullptr) grid.sync();
    float* mod = (float*)(ws + WS_MOD);
    bf16 *W1GU = (bf16*)(ws + WS_W1GU), *W1D = (bf16*)(ws + WS_W1D), *W2GU = (bf16*)(ws + WS_W2GU), *W2D = (bf16*)(ws + WS_W2D), *WIN = (bf16*)(ws + WS_WIN), *WO = (bf16*)(ws + WS_WO);
    bf16 *H = (bf16*)(ws + WS_H), *ACT = (bf16*)(ws + WS_ACT), *X1 = (bf16*)(ws + WS_X1);

    for (int rep_ = 0; rep_ < 1 + DUP_MISC; ++rep_)
    { FRESH_TID(); for (int nb = bx; nb < NMOD / 128; nb += G) mod_item(p, nb, lds, tid);
      LAS float* scr = (LAS float*)(lds + wave * 16384); int base = 0;
      convert_matrix(p.w1_gate, D, FF, FF, W1GU, 1, base, gw, NGW, scr, lane);
      convert_matrix(p.w1_up, D, FF, FF, W1GU, 2, base, gw, NGW, scr, lane);
      convert_matrix(p.w1_down, FF, D, D, W1D, 0, base, gw, NGW, scr, lane);
      convert_matrix(p.w_in, D, INW, NQKV, WIN, 3, base, gw, NGW, scr, lane);
      convert_matrix(p.w_o, D, D, D, WO, 0, base, gw, NGW, scr, lane);
      convert_matrix(p.w2_gate, D, FF, FF, W2GU, 1, base, gw, NGW, scr, lane);
      convert_matrix(p.w2_up, D, FF, FF, W2GU, 2, base, gw, NGW, scr, lane);
      convert_matrix(p.w2_down, FF, D, D, W2D, 0, base, gw, NGW, scr, lane); }
    xcd_barrier(xbar);
    for (int rep_ = 0; rep_ < 10 * DUP_SYNC; ++rep_) xcd_barrier(xbar);
    for (int rep_ = 0; rep_ < 1 + DUP_MISC; ++rep_)
    { FRESH_TID(); norm_phase<false, false>(p, p.x, p.g_ffn1, 0 * D, 1 * D, H, lds, gw, NGW, lane, tid); }
    xcd_barrier(xbar);
    for (int rep_ = 0; rep_ < 1 + DUP_GU; ++rep_)
    { pg8::Gemm g{H, W1GU, M, 2 * FF, D}; pg8::StaticOrder S; S.init(M, 2 * FF, G, bx); pg8::EpiSwiGLU E{ACT, FF};
      pg8::gemm_phase<pg8::EpiSwiGLU, pg8::StaticOrder, GU_ALIGN, true>(lds, g, S, E); }
    xcd_barrier(xbar);
    for (int rep_ = 0; rep_ < 1 + DUP_D1; ++rep_)
    { pg8::Gemm g{ACT, W1D, M, D, FF}; pg8::StaticOrder S; S.init(M, D, G, bx); pg8::EpiResid<false, true> E{p.x, X1, mod + 2 * D, 0.5f};
      pg8::gemm_phase<pg8::EpiResid<false, true>, pg8::StaticOrder, RESID_ALIGN, true>(lds, g, S, E); }
    xcd_barrier(xbar);
    for (int rep_ = 0; rep_ < 1 + DUP_MISC; ++rep_)
    { FRESH_TID(); norm_phase<true, true>(p, X1, p.g_mix, 3 * D, 4 * D, H, lds, gw, NGW, lane, tid); }
    xcd_barrier(xbar);
    if (bx < 64) { FRESH_TID(); cumsum_item(p, bx, lds, tid, lane, wave); }
    { pg8::Gemm g{H, WIN, M, NQKV, D}; pg8::StaticOrder S; S.init(M, NQKV, G, bx); pg8::EpiQKV E{ACT, p.g_q, p.g_k, 0.125f * LOG2E};
      pg8::gemm_phase<pg8::EpiQKV, pg8::StaticOrder, true, true>(lds, g, S, E); }
    xcd_barrier(xbar);
    { const float* KB = (const float*)(ws + WS_KB); unsigned* qctr = (unsigned*)(ws + WS_CTL + 65536);
      { FRESH_TID(); float a = fabsf(p.g_q[wave * 64 + lane]), c = fabsf(p.g_k[wave * 64 + lane]);
#pragma unroll
        for (int o_ = 1; o_ < 64; o_ <<= 1) { a = fmaxf(a, __shfl_xor(a, o_)); c = fmaxf(c, __shfl_xor(c, o_)); }
        if (lane == 0) MISC[24 + wave] = __float_as_uint(64.0f * 0.125f * LOG2E * a * c * 1.02f + 0.5f); }
      const unsigned home = xbar.x & 7u;
      for (unsigned kq = 0; kq < 8u; ++kq) {
          const unsigned qi = (home + kq) & 7u; unsigned* qc = qctr + 64 * qi;
          if (threadIdx.x == 0) MISC[16] = atomicAdd(qc, 1u);
          __syncthreads();
          for (;;) {
              const unsigned u = MISC[16];
              if (u >= 256u) break;
              const int kind = (u < 128u) ? 1 : 0, v = u & 127, qb = 15 - (v >> 3), b = (int)qi, h = v & 7;
              const float sbound = __uint_as_float(MISC[24 + h]);
              if (kind) fox::fox_unit<8>(b, h, qb, ACT, KB, (const fox::u32x4*)(ws + WS_KB16), sbound, H, lds, qc, MISC + 16);
              else att::attn_unit<false>(b, h, qb, ACT, KB, p.g_q, p.g_k, H, lds, qc, MISC + 16);
          }
          __syncthreads();
      } }
    xcd_barrier(xbar);
    { pg8::Gemm g{H, WO, M, D, D}; pg8::StaticOrder S; S.init(M, D, G, bx); pg8::EpiResid<true, true> E{X1, X1, mod + 5 * D, 1.0f};
      pg8::gemm_phase<pg8::EpiResid<true, true>, pg8::StaticOrder, RESID_ALIGN, true>(lds, g, S, E); }
    xcd_barrier(xbar);
    for (int rep_ = 0; rep_ < 1 + DUP_MISC; ++rep_)
    { FRESH_TID(); norm_phase<false, true>(p, X1, p.g_ffn2, 6 * D, 7 * D, H, lds, gw, NGW, lane, tid); }
    xcd_barrier(xbar);
    { pg8::Gemm g{H, W2GU, M, 2 * FF, D}; pg8::StaticOrder S; S.init(M, 2 * FF, G, bx); pg8::EpiSwiGLU E{ACT, FF};
      pg8::gemm_phase<pg8::EpiSwiGLU, pg8::StaticOrder, GU_ALIGN, true>(lds, g, S, E); }
    xcd_barrier(xbar);
    { pg8::Gemm g{ACT, W2D, M, D, FF}; pg8::StaticOrder S; S.init(M, D, G, bx); pg8::EpiResid<true, false> E{X1, p.out, mod + 8 * D, 0.5f};
      pg8::gemm_phase<pg8::EpiResid<true, false>, pg8::StaticOrder, RESID_ALIGN, true>(lds, g, S, E); }
}

extern "C" void kernel_launch(void* const* d_in, const int* in_sizes, int n_in, void* d_out, int out_size, void* d_ws, size_t ws_size, hipStream_t stream) {
    static int grid = 0;
    if (grid == 0) {
        if (n_in != 18 || in_sizes[0] != M * D || out_size != M * D || ws_size < WS_END) { fprintf(stderr, "kernel_launch: unexpected shapes (n_in %d, in0 %d, out %d, ws %zu)\n", n_in, n_in > 0 ? in_sizes[0] : -1, out_size, ws_size); grid = -1; return; }
        int dev = 0, cus = 0, per_cu = 0;
        (void)hipGetDevice(&dev); (void)hipDeviceGetAttribute(&cus, hipDeviceAttributeMultiprocessorCount, dev);
        if (hipFuncSetAttribute((const void*)hymba_fwd, hipFuncAttributeMaxDynamicSharedMemorySize, LDS_BYTES) != hipSuccess) { fprintf(stderr, "kernel_launch: hipFuncSetAttribute failed\n"); grid = -1; return; }
        if (hipOccupancyMaxActiveBlocksPerMultiprocessor(&per_cu, (const void*)hymba_fwd, NWAVES * 64, LDS_BYTES) != hipSuccess || per_cu < 1) { fprintf(stderr, "kernel_launch: occupancy query says %d\n", per_cu); per_cu = 1; }
        (void)hipGetLastError();
        grid = cus * per_cu;
    }
    if (grid < 0) return;
    if (hipMemsetAsync((char*)d_ws + WS_CTL, 0, 131072, stream) != hipSuccess) { fprintf(stderr, "kernel_launch: memset of control words failed\n"); return; }
    Params p{};
    const float** pp = (const float**)&p;
    for (int i = 0; i < 18; ++i) pp[i] = (const float*)d_in[i];
    p.out = (float*)d_out; p.ws = (unsigned char*)d_ws;
    void* args[] = {&p};
    hipError_t e = hipLaunchCooperativeKernel((const void*)hymba_fwd, dim3(grid), dim3(NWAVES * 64), args, LDS_BYTES, stream);
    if (e != hipSuccess) fprintf(stderr, "cooperative launch failed: %s (grid %d)\n", hipGetErrorString(e), grid);
}
```

```cpp
#include <hip/hip_runtime.h>
#include <hip/hip_cooperative_groups.h>
#include <hip/hip_bf16.h>
#include <cstdio>
#include <cstdint>
#include <cmath>
namespace cg = cooperative_groups;
namespace pg8 {
#define PG8_LAS __attribute__((address_space(3)))
typedef unsigned short bf16_t;
typedef short bf16x8 __attribute__((ext_vector_type(8)));
typedef float f32x4 __attribute__((ext_vector_type(4)));
typedef unsigned u32x4 __attribute__((ext_vector_type(4)));
constexpr int BM = 256, BK = 64, HALF = 128, HTB = HALF * BK * 2  , STAGE_BYTES = 8 * HTB, NXCD = 8, WGM = 8;

__host__ __device__ __forceinline__ int lds_byte(int r, int c) { const int st = (r >> 4) * 2 + (c >> 5), rr = r & 15, cc = c & 31, ob = rr * 64 + cc * 2; return st * 1024 + (ob ^ (((ob >> 9) & 1) << 5)); }
__host__ __device__ __forceinline__ void stage_rc(int b, int& R, int& C) { const int st = b / 1024, sb = b % 1024, swz = sb ^ (((sb >> 9) & 1) << 5); R = (st >> 1) * 16 + swz / 64; C = (st & 1) * 32 + (swz % 64) / 2; }
__host__ __device__ __forceinline__ int perm32(int rho) { const int n = rho >> 4, i = rho & 15; return 8 * (i >> 2) + 4 * n + (i & 3); }

struct Unit { int pm, pn; };
struct Gemm { const bf16_t* A; const bf16_t* Bt; int M, N, K; };

struct StaticOrder {
    int nM, nN, nwg, G, c;
    __host__ __device__ void init(int M, int N, int G_, int c_) { nM = M / BM; nN = N / BM; nwg = nM * nN; G = G_; c = c_; }
    __host__ __device__ bool next(int i, Unit& u) const {
        const long L = (long)i * G + c; if (L >= nwg) return false;
        int wgid = (int)L; { const int q = nwg / NXCD, r = nwg % NXCD, xcd = wgid % NXCD, off = wgid / NXCD; wgid = (xcd < r ? xcd * (q + 1) : r * (q + 1) + (xcd - r) * q) + off; }
        const int nig = WGM * nN, gid = wgid / nig, fm = gid * WGM, gsz = (nM - fm) < WGM ? (nM - fm) : WGM;
        u.pm = fm + ((wgid % nig) % gsz); u.pn = (wgid % nig) / gsz; return true;
    }
    __device__ __forceinline__ void a_ready(const Unit&) const {}
    __device__ __forceinline__ void done(const Unit&) const {}
};

__device__ __forceinline__ unsigned cvt_pk_bf16(float lo, float hi) { unsigned r; asm volatile("v_cvt_pk_bf16_f32 %0, %1, %2" : "=v"(r) : "v"(lo), "v"(hi)); return r; }
typedef float f32x2 __attribute__((ext_vector_type(2)));
typedef unsigned u32x2 __attribute__((ext_vector_type(2)));
__device__ __forceinline__ float fast_rcp(float x) { return __builtin_amdgcn_rcpf(x); }
__device__ __forceinline__ float fast_exp2(float x) { return __builtin_amdgcn_exp2f(x); }
struct EpiSwiGLU {
    static constexpr bool PERM = true, AFTER_DRAIN = false;
    bf16_t* O; int ldc;
    __device__ __forceinline__ void operator()(const f32x4 (&acc)[2][2][4][2], const Unit& u, int wr, int wc, int fr, int fq) const {
        typedef float f32x2v __attribute__((ext_vector_type(2)));
        const int row0 = u.pm * BM + wr * 64 + fr; const int col0 = u.pn * HALF + wc * 32 + 8 * fq;
#pragma unroll
        for (int ai = 0; ai < 2; ++ai)
#pragma unroll
            for (int m = 0; m < 4; ++m) {
                bf16_t* rowp = O + (size_t)(row0 + ai * HALF + m * 16) * ldc + col0;
                f32x2v r[4];
#pragma unroll
                for (int n = 0; n < 2; ++n)
#pragma unroll
                    for (int e = 0; e < 4; e += 2) { const f32x2v a = (f32x2v){acc[ai][0][m][n][e], acc[ai][0][m][n][e + 1]}, up = (f32x2v){acc[ai][1][m][n][e], acc[ai][1][m][n][e + 1]};
                        f32x2v t; t.x = fast_exp2(a.x); t.y = fast_exp2(a.y);
                        const f32x2v den = t + 1.0f; f32x2v rc; rc.x = fast_rcp(den.x); rc.y = fast_rcp(den.y);
                        r[n * 2 + (e >> 1)] = (a * up) * rc; }
                u32x4 w; w.x = cvt_pk_bf16(r[0].x, r[0].y); w.y = cvt_pk_bf16(r[1].x, r[1].y); w.z = cvt_pk_bf16(r[2].x, r[2].y); w.w = cvt_pk_bf16(r[3].x, r[3].y);
                *(u32x4*)rowp = w;
            }
    }
};
__device__ __forceinline__ f32x4 bf2f_lo(u32x2 w) { return (f32x4){__uint_as_float(w.x << 16), __uint_as_float(w.x & 0xffff0000u), __uint_as_float(w.y << 16), __uint_as_float(w.y & 0xffff0000u)}; }
template <bool BIN, bool BOUT> struct EpiResid {
    static constexpr bool PERM = true, AFTER_DRAIN = false;
    const void* base; void* out; const float* gate; float mul;
    __device__ __forceinline__ void operator()(const f32x4 (&acc)[2][2][4][2], const Unit& u, int wr, int wc, int fr, int fq) const {
        const int row0 = u.pm * BM + wr * 64 + fr; const int col0 = u.pn * BM + wc * 32 + 8 * fq;
        const float* grow = gate + (size_t)(u.pm >> 4) * 9216 + col0;
        f32x4 gv[2][2];
#pragma unroll
        for (int bj = 0; bj < 2; ++bj)
#pragma unroll
            for (int n = 0; n < 2; ++n) { const f32x4 g = *(const f32x4*)(grow + bj * HALF + 4 * n); gv[bj][n] = (g + 1.0f) * mul; }
        if (BIN) {
#pragma unroll
            for (int ai = 0; ai < 2; ++ai) {
                u32x4 bw[4][2];
#pragma unroll
                for (int m = 0; m < 4; ++m)
#pragma unroll
                    for (int bj = 0; bj < 2; ++bj) bw[m][bj] = *(const u32x4*)((const bf16_t*)base + (size_t)(row0 + ai * HALF + m * 16) * 1024 + col0 + bj * HALF);
                asm volatile("" ::: "memory");
#pragma unroll
                for (int m = 0; m < 4; ++m) { const size_t off = (size_t)(row0 + ai * HALF + m * 16) * 1024 + col0;
#pragma unroll
                    for (int bj = 0; bj < 2; ++bj) { const u32x4 w_ = bw[m][bj]; const f32x4 b0 = bf2f_lo((u32x2){w_.x, w_.y}), b1 = bf2f_lo((u32x2){w_.z, w_.w});
                        const f32x4 o0 = b0 + gv[bj][0] * acc[ai][bj][m][0], o1 = b1 + gv[bj][1] * acc[ai][bj][m][1];
                        if (BOUT) { u32x4 w; w.x = cvt_pk_bf16(o0[0], o0[1]); w.y = cvt_pk_bf16(o0[2], o0[3]); w.z = cvt_pk_bf16(o1[0], o1[1]); w.w = cvt_pk_bf16(o1[2], o1[3]); *(u32x4*)((bf16_t*)out + off + bj * HALF) = w; }
                        else { *(f32x4*)((float*)out + off + bj * HALF) = o0; *(f32x4*)((float*)out + off + bj * HALF + 4) = o1; } } }
                asm volatile("" ::: "memory");
            }
        } else {
#pragma unroll
            for (int ai = 0; ai < 2; ++ai)
#pragma unroll
                for (int m = 0; m < 4; ++m) { const size_t off = (size_t)(row0 + ai * HALF + m * 16) * 1024 + col0;
#pragma unroll
                    for (int bj = 0; bj < 2; ++bj) { const f32x4 b0 = *(const f32x4*)((const float*)base + off + bj * HALF), b1 = *(const f32x4*)((const float*)base + off + bj * HALF + 4);
                        const f32x4 o0 = b0 + gv[bj][0] * acc[ai][bj][m][0], o1 = b1 + gv[bj][1] * acc[ai][bj][m][1];
                        if (BOUT) { u32x4 w; w.x = cvt_pk_bf16(o0[0], o0[1]); w.y = cvt_pk_bf16(o0[2], o0[3]); w.z = cvt_pk_bf16(o1[0], o1[1]); w.w = cvt_pk_bf16(o1[2], o1[3]); *(u32x4*)((bf16_t*)out + off + bj * HALF) = w; }
                        else { *(f32x4*)((float*)out + off + bj * HALF) = o0; *(f32x4*)((float*)out + off + bj * HALF + 4) = o1; } }
                    if (m & 1) asm volatile("" ::: "memory"); }
        }
    }
};
struct EpiQKV {
    static constexpr bool PERM = true, AFTER_DRAIN = false;
    bf16_t* O; const float* gq; const float* gk; float qscale;
    __device__ __forceinline__ void operator()(const f32x4 (&acc)[2][2][4][2], const Unit& u, int wr, int wc, int fr, int fq) const {
        const int seg = u.pn >> 1, head = (u.pn & 1) * 4 + wc;
        const int row0 = u.pm * BM + wr * 64 + fr; const int col0 = u.pn * BM + wc * 64 + 8 * fq;
        const bool nrm = (seg == 3) || (seg == 4);
        const float sc = (seg == 0 || seg == 3) ? qscale : 1.0f;
        f32x4 gv[2][2];
#pragma unroll
        for (int bj = 0; bj < 2; ++bj)
#pragma unroll
            for (int n = 0; n < 2; ++n) { f32x4 g = (f32x4){1.f, 1.f, 1.f, 1.f};
                if (nrm) g = *(const f32x4*)((seg == 3 ? gq : gk) + head * 64 + bj * 32 + 8 * fq + 4 * n);
                gv[bj][n] = g * sc; }
#pragma unroll
        for (int ai = 0; ai < 2; ++ai)
#pragma unroll
            for (int m = 0; m < 4; ++m) {
                float rs = 1.0f;
                if (nrm) { float ss = 0.f;
#pragma unroll
                    for (int bj = 0; bj < 2; ++bj)
#pragma unroll
                        for (int n = 0; n < 2; ++n) { const f32x4 x = acc[ai][bj][m][n]; ss += (x[0] * x[0] + x[1] * x[1]) + (x[2] * x[2] + x[3] * x[3]); }
                    ss += __shfl_xor(ss, 16); ss += __shfl_xor(ss, 32);
                    rs = __builtin_amdgcn_rsqf(ss * (1.0f / 64.0f) + 1e-6f); }
                bf16_t* rowp = O + (size_t)(row0 + ai * HALF + m * 16) * 3072 + col0;
#pragma unroll
                for (int bj = 0; bj < 2; ++bj) { const f32x4 v0 = acc[ai][bj][m][0] * rs * gv[bj][0], v1 = acc[ai][bj][m][1] * rs * gv[bj][1];
                    u32x4 w; w.x = cvt_pk_bf16(v0[0], v0[1]); w.y = cvt_pk_bf16(v0[2], v0[3]); w.z = cvt_pk_bf16(v1[0], v1[1]); w.w = cvt_pk_bf16(v1[2], v1[3]);
                    *(u32x4*)(rowp + bj * 32) = w; }
            }
    }
};
template <class Epi, class Sched, bool ALIGN_EPI = false, bool SP2 = false>
__device__ __forceinline__ void gemm_phase(PG8_LAS unsigned char* lds, const Gemm g, const Sched& S, const Epi& E) {
    int tid_ = threadIdx.x; asm volatile("" : "+v"(tid_)); const int tid = tid_, wid = __builtin_amdgcn_readfirstlane(tid >> 6), lane = tid & 63, wr = wid >> 2, wc = wid & 3, fr = lane & 15, fq = lane >> 4;
    const int K = g.K, nt = K / BK;
    unsigned voffA[2], voffB[2];
#pragma unroll
    for (int i = 0; i < 2; ++i) { int R, C; stage_rc(tid * 16 + i * 8192, R, C); const int Rb = Epi::PERM ? ((R & ~31) + perm32(R & 31)) : R;
        voffA[i] = (unsigned)(R * K + C) * 2u; voffB[i] = (unsigned)(Rb * K + C) * 2u; }
    const size_t kstep = (size_t)(BK * 2);
    const size_t hstep = (size_t)HALF * K * 2;
    const size_t tstep = 2 * hstep;
    const unsigned ldsw = (unsigned)wid * 1024u;
    const int aoff = lds_byte(wr * 64 + fr, fq * 8), boff = lds_byte(wc * 32 + fr, fq * 8);
#define PG8_SA(b, h) (((b) * 2 + (h)) * HTB)
#define PG8_SB(b, h) ((4 + (b) * 2 + (h)) * HTB)
#define PG8_STAGE(bufoff, gbase, voff) do { _Pragma("unroll") for (int _i = 0; _i < 2; ++_i) \
        __builtin_amdgcn_global_load_lds((const unsigned*)((const char*)(gbase) + (voff)[_i]), (PG8_LAS unsigned*)(lds + (bufoff) + ldsw + _i * 8192), 16, 0, 0); } while (0)
#define PG8_LDA(dst, b, h) do { _Pragma("unroll") for (int m = 0; m < 4; ++m) _Pragma("unroll") for (int k = 0; k < 2; ++k) dst[m][k] = *(const PG8_LAS bf16x8*)(lds + PG8_SA(b, h) + aoff + m * 2048 + k * 1024); } while (0)
#define PG8_LDB(dst, b, h) do { _Pragma("unroll") for (int n = 0; n < 2; ++n) _Pragma("unroll") for (int k = 0; k < 2; ++k) dst[n][k] = *(const PG8_LAS bf16x8*)(lds + PG8_SB(b, h) + boff + n * 2048 + k * 1024); } while (0)
#define PG8_MMA(ai, bj, At, Bt) do { __builtin_amdgcn_s_setprio(1); _Pragma("unroll") for (int m = 0; m < 4; ++m) _Pragma("unroll") for (int n = 0; n < 2; ++n) _Pragma("unroll") for (int k = 0; k < 2; ++k) \
        acc[ai][bj][m][n] = __builtin_amdgcn_mfma_f32_16x16x32_bf16(Bt[n][k], At[m][k], acc[ai][bj][m][n], 0, 0, 0); __builtin_amdgcn_s_setprio(0); } while (0)
#define PG8_WAIT_V(n) asm volatile("s_waitcnt vmcnt(" #n ")" ::: "memory")
#define PG8_WAIT_L(n) asm volatile("s_waitcnt lgkmcnt(" #n ")" ::: "memory")
#define PG8_BAR __builtin_amdgcn_s_barrier()
#define PG8_SCHED __builtin_amdgcn_sched_barrier(0)
    Unit cur, nxt; int ui = 0;
    if (!S.next(0, cur)) return;
    f32x4 acc[2][2][4][2];
#pragma unroll
    for (int a = 0; a < 2; ++a)
#pragma unroll
        for (int b = 0; b < 2; ++b)
#pragma unroll
            for (int m = 0; m < 4; ++m)
#pragma unroll
                for (int n = 0; n < 2; ++n) acc[a][b][m][n] = (f32x4){0.f, 0.f, 0.f, 0.f};
    bf16x8 At[4][2], B0[2][2], B1[2][2];
    const char* cA = (const char*)g.A + (size_t)cur.pm * tstep; const char* cB = (const char*)g.Bt + (size_t)cur.pn * tstep;
    S.a_ready(cur);
    if constexpr (SP2) {
        PG8_STAGE(PG8_SB(0, 0), cB, voffB); PG8_STAGE(PG8_SB(0, 1), cB + hstep, voffB); PG8_STAGE(PG8_SA(0, 0), cA, voffA); PG8_STAGE(PG8_SA(0, 1), cA + hstep, voffA);
        if (wr == 1) PG8_BAR;
        PG8_WAIT_V(2); PG8_BAR;
        PG8_STAGE(PG8_SB(1, 0), cB + kstep, voffB); PG8_STAGE(PG8_SA(1, 0), cA + kstep, voffA); PG8_STAGE(PG8_SB(1, 1), cB + hstep + kstep, voffB);
        PG8_WAIT_V(6); PG8_BAR;
    } else {
        PG8_STAGE(PG8_SB(0, 0), cB, voffB); PG8_STAGE(PG8_SA(0, 0), cA, voffA); PG8_STAGE(PG8_SB(0, 1), cB + hstep, voffB); PG8_STAGE(PG8_SA(0, 1), cA + hstep, voffA);
        if (wr == 1) PG8_BAR;
        PG8_WAIT_V(4); PG8_BAR;
        PG8_STAGE(PG8_SB(1, 0), cB + kstep, voffB); PG8_STAGE(PG8_SA(1, 0), cA + kstep, voffA); PG8_STAGE(PG8_SB(1, 1), cB + hstep + kstep, voffB);
        PG8_WAIT_V(6); PG8_BAR;
    }
    for (;;) {
        const bool has_next = S.next(ui + 1, nxt);
        const char* nA = has_next ? (const char*)g.A + (size_t)nxt.pm * tstep : cA; const char* nB = has_next ? (const char*)g.Bt + (size_t)nxt.pn * tstep : cB;
        for (int t = 0; t < nt; t += 2) {
            const bool last = (t == nt - 2);
            const char* a1 = cA + (size_t)(t + 1) * kstep;
            const char* a2 = last ? nA : cA + (size_t)(t + 2) * kstep; const char* b2 = last ? nB : cB + (size_t)(t + 2) * kstep;
            const char* a3 = a2 + kstep; const char* b3 = b2 + kstep;
            if (last && has_next) S.a_ready(nxt);
            if constexpr (SP2) {
            PG8_LDB(B0, 0, 0); PG8_LDB(B1, 0, 1); PG8_SCHED; PG8_LDA(At, 0, 0); PG8_STAGE(PG8_SA(1, 1), a1 + hstep, voffA);
            PG8_WAIT_V(8); PG8_WAIT_L(0); PG8_BAR; PG8_MMA(0, 0, At, B0); PG8_MMA(0, 1, At, B1); PG8_BAR; PG8_SCHED;
            PG8_LDA(At, 0, 1); PG8_STAGE(PG8_SB(0, 0), b2, voffB); PG8_STAGE(PG8_SB(0, 1), b2 + hstep, voffB); PG8_STAGE(PG8_SA(0, 0), a2, voffA);
            PG8_WAIT_V(8); PG8_WAIT_L(0); PG8_BAR; PG8_MMA(1, 0, At, B0); PG8_MMA(1, 1, At, B1); PG8_BAR; PG8_SCHED;
            PG8_LDB(B0, 1, 0); PG8_LDB(B1, 1, 1); PG8_SCHED; PG8_LDA(At, 1, 0); PG8_STAGE(PG8_SA(0, 1), a2 + hstep, voffA);
            PG8_WAIT_V(8); PG8_WAIT_L(0); PG8_BAR; PG8_MMA(0, 0, At, B0); PG8_MMA(0, 1, At, B1); PG8_BAR; PG8_SCHED;
            PG8_LDA(At, 1, 1); PG8_STAGE(PG8_SB(1, 0), b3, voffB); PG8_STAGE(PG8_SB(1, 1), b3 + hstep, voffB); PG8_STAGE(PG8_SA(1, 0), a3, voffA);
            PG8_WAIT_V(8); PG8_WAIT_L(0); PG8_BAR; PG8_MMA(1, 0, At, B0); PG8_MMA(1, 1, At, B1); PG8_BAR; PG8_SCHED;
            } else {
            PG8_LDB(B0, 0, 0); PG8_SCHED; PG8_LDA(At, 0, 0); PG8_STAGE(PG8_SA(1, 1), a1 + hstep, voffA);
            PG8_WAIT_L(8); PG8_BAR; PG8_WAIT_L(0); PG8_MMA(0, 0, At, B0); PG8_BAR; PG8_SCHED;
            PG8_LDB(B1, 0, 1); PG8_STAGE(PG8_SB(0, 0), b2, voffB);
            PG8_BAR; PG8_WAIT_L(0); PG8_MMA(0, 1, At, B1); PG8_BAR;
            PG8_LDA(At, 0, 1); PG8_STAGE(PG8_SA(0, 0), a2, voffA);
            PG8_BAR; PG8_WAIT_L(0); PG8_MMA(1, 0, At, B0); PG8_BAR; PG8_SCHED;
            PG8_STAGE(PG8_SB(0, 1), b2 + hstep, voffB);
            PG8_WAIT_V(6); PG8_BAR; PG8_MMA(1, 1, At, B1); PG8_BAR;
            PG8_LDB(B0, 1, 0); PG8_SCHED; PG8_LDA(At, 1, 0); PG8_STAGE(PG8_SA(0, 1), a2 + hstep, voffA);
            PG8_WAIT_L(8); PG8_BAR; PG8_WAIT_L(0); PG8_MMA(0, 0, At, B0); PG8_BAR; PG8_SCHED;
            PG8_LDB(B1, 1, 1); PG8_STAGE(PG8_SB(1, 0), b3, voffB);
            PG8_BAR; PG8_WAIT_L(0); PG8_MMA(0, 1, At, B1); PG8_BAR;
            PG8_LDA(At, 1, 1); PG8_STAGE(PG8_SA(1, 0), a3, voffA);
            PG8_BAR; PG8_WAIT_L(0); PG8_MMA(1, 0, At, B0); PG8_BAR; PG8_SCHED;
            PG8_STAGE(PG8_SB(1, 1), b3 + hstep, voffB);
            PG8_WAIT_V(6); PG8_BAR; PG8_MMA(1, 1, At, B1); PG8_BAR;
            }
        }
        if constexpr (ALIGN_EPI) { if (wr == 0) PG8_BAR; }
        if constexpr (!Epi::AFTER_DRAIN) { E(acc, cur, wr, wc, fr, fq); S.done(cur); }
        if (!has_next) break;
#pragma unroll
        for (int a = 0; a < 2; ++a)
#pragma unroll
            for (int b = 0; b < 2; ++b)
#pragma unroll
                for (int m = 0; m < 4; ++m)
#pragma unroll
                    for (int n = 0; n < 2; ++n) acc[a][b][m][n] = (f32x4){0.f, 0.f, 0.f, 0.f};
        cur = nxt; cA = nA; cB = nB; ++ui;
        if constexpr (ALIGN_EPI) { if (wr == 1) PG8_BAR; }
    }
    PG8_WAIT_V(0);
    if constexpr (!ALIGN_EPI) { if (wr == 0) PG8_BAR; }
    PG8_BAR;
    if constexpr (Epi::AFTER_DRAIN) { E.fused(acc, cur, wr, wc, fr, fq, lds, wid, lane); S.done(cur); }
#undef PG8_SA
#undef PG8_SB
#undef PG8_STAGE
#undef PG8_LDA
#undef PG8_LDB
#undef PG8_MMA
#undef PG8_WAIT_V
#undef PG8_WAIT_L
#undef PG8_BAR
#undef PG8_SCHED
}
}
namespace att {
#define ALAS __attribute__((address_space(3)))
using bf16 = unsigned short;
using bf16x8 = __attribute__((ext_vector_type(8))) short;
using s16x4 = __attribute__((ext_vector_type(4))) short;
using f32x16 = __attribute__((ext_vector_type(16))) float;
using f32x4 = __attribute__((ext_vector_type(4))) float;
using u32x4 = __attribute__((ext_vector_type(4))) unsigned;
constexpr int SEQ = 4096, PITCH = 3072, OPITCH = 1024, QB = 256, KVBLK = 64;
constexpr int SLOTB = 8192;
constexpr int L_K = 0, L_V = 4 * SLOTB, L_B = 8 * SLOTB, L_WS = L_B + 512, L_FLAG = L_WS + 8 * 256, L_OST = L_FLAG + 64, L_BYTES = L_OST + 8 * 4096;
__device__ __forceinline__ int crow(int r, int hi) { return (r & 3) + 8 * (r >> 2) + 4 * hi; }
__device__ __forceinline__ void glds16(const void* gsrc, unsigned lds_dst) { unsigned keep;
    asm volatile("s_mov_b32 %0, m0\n\ts_mov_b32 m0, %2\n\ts_nop 0\n\tglobal_load_lds_dwordx4 %1, off\n\ts_mov_b32 m0, %0" : "=&s"(keep) : "v"(gsrc), "s"(lds_dst) : "memory"); }
__device__ __forceinline__ void glds4(const void* gsrc, unsigned lds_dst) { unsigned keep;
    asm volatile("s_mov_b32 %0, m0\n\ts_mov_b32 m0, %2\n\ts_nop 0\n\tglobal_load_lds_dword %1, off\n\ts_mov_b32 m0, %0" : "=&s"(keep) : "v"(gsrc), "s"(lds_dst) : "memory"); }
typedef float f32x2_t __attribute__((ext_vector_type(2))); typedef __bf16 bf16x2_t __attribute__((ext_vector_type(2)));
__device__ __forceinline__ unsigned cvtpk_s(float lo, float hi) { f32x2_t v = {lo, hi}; bf16x2_t b = __builtin_convertvector(v, bf16x2_t); return __builtin_bit_cast(unsigned, b); }
#define AWAIT_BAR() asm volatile("s_waitcnt vmcnt(0) lgkmcnt(0)\n\ts_barrier" ::: "memory")
#define ASBAR() __builtin_amdgcn_sched_barrier(0)
struct VFrag { s16x4 lo[8], hi[8]; };
__device__ __forceinline__ void v_issue(VFrag& f, int vb) {
#pragma unroll
    for (int i = 0; i < 8; ++i) {
        asm volatile("ds_read_b64_tr_b16 %0,%1 offset:%c2" : "=&v"(f.lo[i]) : "v"(vb), "i"((i >> 2) * 4096 + (i & 3) * 1024) : "memory");
        asm volatile("ds_read_b64_tr_b16 %0,%1 offset:%c2" : "=&v"(f.hi[i]) : "v"(vb), "i"((i >> 2) * 4096 + (i & 3) * 1024 + 512) : "memory"); }
}
__device__ __forceinline__ void pv_mma(f32x16* o, VFrag& f, bf16x8 pa0, bf16x8 pa1, bf16x8 pa2, bf16x8 pa3) {
    asm volatile("s_waitcnt lgkmcnt(0)" : "+v"(f.lo[0]), "+v"(f.lo[1]), "+v"(f.lo[2]), "+v"(f.lo[3]), "+v"(f.lo[4]), "+v"(f.lo[5]), "+v"(f.lo[6]), "+v"(f.lo[7]),
                                          "+v"(f.hi[0]), "+v"(f.hi[1]), "+v"(f.hi[2]), "+v"(f.hi[3]), "+v"(f.hi[4]), "+v"(f.hi[5]), "+v"(f.hi[6]), "+v"(f.hi[7]) :: "memory");
#define APK2(k) (bf16x8){f.lo[k][0], f.lo[k][1], f.lo[k][2], f.lo[k][3], f.hi[k][0], f.hi[k][1], f.hi[k][2], f.hi[k][3]}
    o[0] = __builtin_amdgcn_mfma_f32_32x32x16_bf16(pa0, APK2(0), o[0], 0, 0, 0); o[1] = __builtin_amdgcn_mfma_f32_32x32x16_bf16(pa0, APK2(4), o[1], 0, 0, 0);
    o[0] = __builtin_amdgcn_mfma_f32_32x32x16_bf16(pa1, APK2(1), o[0], 0, 0, 0); o[1] = __builtin_amdgcn_mfma_f32_32x32x16_bf16(pa1, APK2(5), o[1], 0, 0, 0);
    o[0] = __builtin_amdgcn_mfma_f32_32x32x16_bf16(pa2, APK2(2), o[0], 0, 0, 0); o[1] = __builtin_amdgcn_mfma_f32_32x32x16_bf16(pa2, APK2(6), o[1], 0, 0, 0);
    o[0] = __builtin_amdgcn_mfma_f32_32x32x16_bf16(pa3, APK2(3), o[0], 0, 0, 0); o[1] = __builtin_amdgcn_mfma_f32_32x32x16_bf16(pa3, APK2(7), o[1], 0, 0, 0);
#undef APK2
}
__device__ __forceinline__ void pv(f32x16* o, int vb, bf16x8 pa0, bf16x8 pa1, bf16x8 pa2, bf16x8 pa3) {
#pragma unroll
    for (int d0 = 0; d0 < 2; ++d0) { s16x4 lo[4], hi[4];
#pragma unroll
        for (int ks = 0; ks < 4; ++ks) {
            asm volatile("ds_read_b64_tr_b16 %0,%1 offset:%c2" : "=&v"(lo[ks]) : "v"(vb), "i"(d0 * 4096 + ks * 1024) : "memory");
            asm volatile("ds_read_b64_tr_b16 %0,%1 offset:%c2" : "=&v"(hi[ks]) : "v"(vb), "i"(d0 * 4096 + ks * 1024 + 512) : "memory"); }
        asm volatile("s_waitcnt lgkmcnt(0)" ::: "memory"); ASBAR();
#define APK(k) (bf16x8){lo[k][0], lo[k][1], lo[k][2], lo[k][3], hi[k][0], hi[k][1], hi[k][2], hi[k][3]}
        o[d0] = __builtin_amdgcn_mfma_f32_32x32x16_bf16(pa0, APK(0), o[d0], 0, 0, 0);
        o[d0] = __builtin_amdgcn_mfma_f32_32x32x16_bf16(pa1, APK(1), o[d0], 0, 0, 0);
        o[d0] = __builtin_amdgcn_mfma_f32_32x32x16_bf16(pa2, APK(2), o[d0], 0, 0, 0);
        o[d0] = __builtin_amdgcn_mfma_f32_32x32x16_bf16(pa3, APK(3), o[d0], 0, 0, 0);
#undef APK
    }
}
#ifndef SB_EARLY_EXIT
#define SB_EARLY_EXIT 1
#endif
#ifndef FOX_SKIP
#define FOX_SKIP 1
#endif
template <bool FOX>
__device__ __forceinline__ void attn_unit(int b, int h, int qb, const bf16* __restrict__ QKV, const float* __restrict__ kbias, const float* __restrict__ gq, const float* __restrict__ gk, bf16* O, ALAS unsigned char* lds, unsigned* qc, volatile ALAS unsigned* qslot) {
    int tid_ = threadIdx.x; asm volatile("" : "+v"(tid_)); const int tid = tid_, lane = tid & 63, r32 = lane & 31, hi = lane >> 5; const int wid = __builtin_amdgcn_readfirstlane(tid >> 6);
    const long rowbase = (long)b * SEQ; const int q0 = qb * QB;
    const int colq = (FOX ? 1536 : 0) + h * 64;
    const bf16* Qw = QKV + (rowbase + q0 + wid * 32) * PITCH + colq;
    const bf16* Kh = QKV + rowbase * PITCH + colq + 512; const bf16* Vh = QKV + rowbase * PITCH + colq + 1024;
    const unsigned lds0 = (unsigned)(uintptr_t)lds;
    ALAS float* wsf = (ALAS float*)(lds + L_WS) + wid * 64;
    ALAS unsigned* flags = (ALAS unsigned*)(lds + L_FLAG);
    const int kpos = lane, khi = (kpos >> 2) & 1, kr = (kpos & 3) + 4 * ((kpos & 31) >> 3), kkey = khi * 32 + (kpos >> 5) * 16 + kr;
    const bf16* ksrc = Kh + (long)kkey * PITCH + wid * 8;
    const int key16 = lane >> 2, vhi = (key16 >> 2) & 1, vj = (key16 & 3) + 4 * (key16 >> 3), vkey = vhi * 32 + (wid & 3) * 8 + vj;
    const bf16* vsrc = Vh + (long)vkey * PITCH + (wid >> 2) * 32 + (lane & 3) * 8;
    const float* bsrc = kbias + ((long)(b * 8 + h)) * SEQ + lane;
    const unsigned kdst = lds0 + L_K + wid * 1024, vdst = lds0 + L_V + wid * 1024, bdst = lds0 + L_B;
#define ADMA(t, slot) do { glds16(ksrc + (long)(t) * KVBLK * PITCH, (unsigned)__builtin_amdgcn_readfirstlane(kdst + (slot) * SLOTB)); \
                           glds16(vsrc + (long)(t) * KVBLK * PITCH, (unsigned)__builtin_amdgcn_readfirstlane(vdst + (slot) * SLOTB)); \
                           if (FOX && wid == 0) glds4(bsrc + (t) * KVBLK, (unsigned)__builtin_amdgcn_readfirstlane(bdst + (slot) * 256)); } while (0)
    const int vb0 = (int)(lds0 + L_V) + ((lane >> 4) & 1) * 32 + (lane & 3) * 8 + (4 * hi + ((lane & 15) >> 2)) * 64;
    const int NT = (q0 + QB) / KVBLK;
    if (lane == 0) flags[wid] = 0u;
    float sbound = 0.f;
    if (FOX && FOX_SKIP) { float a = fabsf(gq[h * 64 + lane]), c = fabsf(gk[h * 64 + lane]);
#pragma unroll
        for (int o_ = 1; o_ < 64; o_ <<= 1) { a = fmaxf(a, __shfl_xor(a, o_)); c = fmaxf(c, __shfl_xor(c, o_)); }
        sbound = 64.0f * 0.125f * 1.4426950408889634f * a * c * 1.02f + 0.5f; }
    if (FOX) { ADMA(NT - 1, 0); } else { ADMA(NT - 1, (NT - 1) & 3); ADMA(NT - 2, (NT - 2) & 3); ADMA(NT - 3, (NT - 3) & 3); }
    bf16x8 qr[4];
#pragma unroll
    for (int d0 = 0; d0 < 4; ++d0) qr[d0] = *reinterpret_cast<const bf16x8*>(&Qw[(long)r32 * PITCH + d0 * 16 + hi * 8]);
    f32x16 o[2]; o[0] = f32x16{}; o[1] = f32x16{};
    float m_run = -1e30f, l_run = 0.f, Rp = 1.0f;
    const int qpos = q0 + wid * 32 + r32;
    const int qlast = q0 + wid * 32 + 31;
    for (int it = 0; it < NT; ++it) {
        int t, slot;
        if (FOX) { t = NT - 1 - it; slot = it & 1; } else { t = (wid < 4) ? NT - 3 - it : NT - 1 - it; slot = t & 3; }
        AWAIT_BAR();
        if (FOX ? FOX_SKIP : SB_EARLY_EXIT) {
            const u32x4 f0 = *(ALAS const u32x4*)(flags), f1 = *(ALAS const u32x4*)(flags + 4);
            if ((f0.x & f0.y & f0.z & f0.w & f1.x & f1.y & f1.z & f1.w) != 0u) break;
        }
        if (FOX) { if (it + 1 < NT) ADMA(t - 1, slot ^ 1); }
        else { const int tn = NT - 4 - it; if (tn >= 0) ADMA(tn, tn & 3); if (t < 0) { if (lane == 0) flags[wid] = 1u; continue; } }
        if (KVBLK * t > qlast) continue;
        const bool band = (KVBLK * t + KVBLK - 1 > q0 + wid * 32 - (FOX ? 0 : 1));
        f32x16 p0, p1;
        if (FOX) { const ALAS f32x4* bp = (const ALAS f32x4*)(lds + L_B + slot * 256 + hi * 128);
            const f32x4 c0 = bp[0], c1 = bp[1], c2 = bp[2], c3 = bp[3], c4 = bp[4], c5 = bp[5], c6 = bp[6], c7 = bp[7];
            p0 = (f32x16){c0[0], c0[1], c0[2], c0[3], c1[0], c1[1], c1[2], c1[3], c2[0], c2[1], c2[2], c2[3], c3[0], c3[1], c3[2], c3[3]};
            p1 = (f32x16){c4[0], c4[1], c4[2], c4[3], c5[0], c5[1], c5[2], c5[3], c6[0], c6[1], c6[2], c6[3], c7[0], c7[1], c7[2], c7[3]};
        } else { p0 = f32x16{}; p1 = f32x16{}; }
        VFrag vf; v_issue(vf, vb0 + slot * SLOTB);
        { const ALAS unsigned char* kp = lds + L_K + slot * SLOTB + hi * 1024 + r32 * 16;
#pragma unroll
          for (int d0 = 0; d0 < 4; ++d0) { const bf16x8 b0 = *(const ALAS bf16x8*)(kp + d0 * 2048), b1 = *(const ALAS bf16x8*)(kp + d0 * 2048 + 512);
              p0 = __builtin_amdgcn_mfma_f32_32x32x16_bf16(b0, qr[d0], p0, 0, 0, 0); p1 = __builtin_amdgcn_mfma_f32_32x32x16_bf16(b1, qr[d0], p1, 0, 0, 0); } }
        const int kbase = KVBLK * t + hi * 32;
        if (FOX) {
            if (band) {
#pragma unroll
                for (int r = 0; r < 16; ++r) { if (kbase + r > qpos) p0[r] = -INFINITY; if (kbase + 16 + r > qpos) p1[r] = -INFINITY; } }
            float mx = fmaxf(p0[0], p1[0]);
#pragma unroll
            for (int r = 1; r < 16; ++r) mx = fmaxf(mx, fmaxf(p0[r], p1[r]));
            { auto rr = __builtin_amdgcn_permlane32_swap(__float_as_uint(mx), __float_as_uint(mx), false, false); mx = fmaxf(__uint_as_float(rr[0]), __uint_as_float(rr[1])); }
            const float m_new = fmaxf(m_run, mx);
            if (__any(m_new > m_run)) {
                const float alpha = __builtin_amdgcn_exp2f(m_run - m_new); l_run *= alpha; m_run = m_new;
                if (hi == 0) wsf[r32] = alpha;
                asm volatile("s_waitcnt lgkmcnt(0)" ::: "memory");
#pragma unroll
                for (int g = 0; g < 4; ++g) { const f32x4 a = *(const ALAS f32x4*)(wsf + 8 * g + 4 * hi);
#pragma unroll
                    for (int e = 0; e < 4; ++e) { o[0][4 * g + e] *= a[e]; o[1][4 * g + e] *= a[e]; } }
            }
            float sacc = 0.f;
#pragma unroll
            for (int r = 0; r < 16; ++r) { p0[r] = __builtin_amdgcn_exp2f(p0[r] - m_run); p1[r] = __builtin_amdgcn_exp2f(p1[r] - m_run); sacc += p0[r] + p1[r]; }
            l_run += sacc;
            if (FOX_SKIP) {
                const float b0 = *(const ALAS float*)(lds + L_B + slot * 256);
                const bool dead = __all(sbound + b0 - m_run < -150.0f);
                if (lane == 0) flags[wid] = dead ? 1u : 0u; }
        } else {
            float acc = 1.0f;
#pragma unroll
            for (int e = 31; e >= 0; --e) {
                const float tt = __builtin_amdgcn_exp2f(e < 16 ? p0[e] : p1[e - 16]);
                float kp_ = __builtin_amdgcn_rcpf(1.0f + tt);
                if (band) { const bool dead = (kbase + e >= qpos); kp_ = dead ? 1.0f : kp_; }
                const float accn = acc * kp_; const float w = acc - accn; acc = accn;
                if (e < 16) p0[e] = w; else p1[e - 16] = w;
            }
            auto rr = __builtin_amdgcn_permlane32_swap(__float_as_uint(acc), __float_as_uint(acc), false, false);
            const float t_lo = __uint_as_float(rr[0]), t_hi = __uint_as_float(rr[1]);
            const float off = hi ? Rp : Rp * t_hi;
#pragma unroll
            for (int r = 0; r < 16; ++r) { p0[r] *= off; p1[r] *= off; }
            Rp = Rp * t_lo * t_hi;
            if (SB_EARLY_EXIT) { const bool alldead = __all(Rp == 0.0f); if (lane == 0) flags[wid] = alldead ? 1u : 0u; }
        }
        u32x4 pw0, pw1, pw2, pw3;
        pw0 = (u32x4){cvtpk_s(p0[0], p0[1]), cvtpk_s(p0[2], p0[3]), cvtpk_s(p0[4], p0[5]), cvtpk_s(p0[6], p0[7])};
        pw1 = (u32x4){cvtpk_s(p0[8], p0[9]), cvtpk_s(p0[10], p0[11]), cvtpk_s(p0[12], p0[13]), cvtpk_s(p0[14], p0[15])};
        pw2 = (u32x4){cvtpk_s(p1[0], p1[1]), cvtpk_s(p1[2], p1[3]), cvtpk_s(p1[4], p1[5]), cvtpk_s(p1[6], p1[7])};
        pw3 = (u32x4){cvtpk_s(p1[8], p1[9]), cvtpk_s(p1[10], p1[11]), cvtpk_s(p1[12], p1[13]), cvtpk_s(p1[14], p1[15])};
        pv_mma(o, vf, __builtin_bit_cast(bf16x8, pw0), __builtin_bit_cast(bf16x8, pw1), __builtin_bit_cast(bf16x8, pw2), __builtin_bit_cast(bf16x8, pw3));
    }
    unsigned nxq = 0u; if (tid == 0) nxq = atomicAdd(qc, 1u);
    float rli[16];
    if (FOX) {
        { auto rr = __builtin_amdgcn_permlane32_swap(__float_as_uint(l_run), __float_as_uint(l_run), false, false); l_run = __uint_as_float(rr[0]) + __uint_as_float(rr[1]); }
        if (hi == 0) wsf[32 + r32] = l_run;
        asm volatile("s_waitcnt lgkmcnt(0)" ::: "memory");
#pragma unroll
        for (int r = 0; r < 16; ++r) rli[r] = __builtin_amdgcn_rcpf(wsf[32 + crow(r, hi)]);
    } else {
#pragma unroll
        for (int r = 0; r < 16; ++r) rli[r] = 1.0f;
    }
    bf16* Ow = O + (rowbase + q0 + wid * 32) * OPITCH + ((FOX ? 8 : 0) + h) * 64;
    { ALAS bf16* stg = (ALAS bf16*)(lds + L_OST) + wid * 2048;
#pragma unroll
      for (int r = 0; r < 16; ++r) { const int orow = crow(r, hi);
#pragma unroll
          for (int d0 = 0; d0 < 2; ++d0) stg[orow * 64 + d0 * 32 + r32] = (bf16)(cvtpk_s(o[d0][r] * rli[r], 0.f) & 0xffffu); }
      asm volatile("s_waitcnt lgkmcnt(0)" ::: "memory");
#pragma unroll
      for (int i = 0; i < 4; ++i) { const int row = i * 8 + (lane >> 3), ch = lane & 7; const u32x4 v = *(const ALAS u32x4*)(stg + row * 64 + ch * 8); *(u32x4*)(Ow + (long)row * OPITCH + ch * 8) = v; } }
    if (tid == 0) *qslot = nxq;
    asm volatile("s_waitcnt lgkmcnt(0)\n\ts_barrier" ::: "memory");
#undef ADMA
}
#undef AWAIT_BAR
#undef ASBAR
}
namespace fox {
using bf16 = unsigned short;
using bf16x8 = __attribute__((ext_vector_type(8))) short;
using s16x4 = __attribute__((ext_vector_type(4))) short;
using f32x16 = __attribute__((ext_vector_type(16))) float;
using f32x4 = __attribute__((ext_vector_type(4))) float;
using u32x4 = __attribute__((ext_vector_type(4))) unsigned;
constexpr int SEQ = 4096, DM = 3072, OPITCH = 1024, D = 64, NW = 8, QBLK = 32, QB = 256, KVBLK = 64;
__device__ __forceinline__ int crow(int r,int hi){return (r&3)+8*(r>>2)+4*hi;}
#define SBAR() __builtin_amdgcn_sched_barrier(0)
__device__ __forceinline__ void cmask(f32x16&p0,f32x16&p1,int jb,int qrel,int hi){
  const float NEG=-INFINITY; int kb=64*jb+4*hi;
  #pragma unroll
  for(int r=0;r<16;++r){int kv=kb+(r&3)+8*(r>>2); if(kv>qrel)p0[r]=NEG; if(kv+32>qrel)p1[r]=NEG;}
}

__device__ __forceinline__ void glds16(const void*gsrc,unsigned lds_dst){unsigned keep;
  asm volatile("s_mov_b32 %0, m0\n\ts_mov_b32 m0, %2\n\ts_nop 0\n\tglobal_load_lds_dwordx4 %1, off\n\ts_mov_b32 m0, %0":"=&s"(keep):"v"(gsrc),"s"(lds_dst):"memory");}
__device__ __forceinline__ float max3f(float a,float b,float c){float r;asm("v_max3_f32 %0, %1, %2, %3":"=v"(r):"v"(a),"v"(b),"v"(c));return r;}
__device__ __forceinline__ float max2f(float a,float b){float r;asm("v_max_f32_e32 %0, %1, %2":"=v"(r):"v"(a),"v"(b));return r;}
__device__ __forceinline__ float fadd_s(float a,float b){float r;asm("v_add_f32_e32 %0, %1, %2":"=v"(r):"v"(a),"v"(b));return r;}
__device__ __forceinline__ float fsub_s(float a,float b){float r;asm("v_sub_f32_e32 %0, %1, %2":"=v"(r):"v"(a),"v"(b));return r;}
typedef float f32x2_t __attribute__((ext_vector_type(2))); typedef __bf16 bf16x2_t __attribute__((ext_vector_type(2)));
__device__ __forceinline__ unsigned cvtpk_s(float lo,float hi){f32x2_t v={lo,hi};bf16x2_t b=__builtin_convertvector(v,bf16x2_t);return __builtin_bit_cast(unsigned,b);}
#define WAIT_BAR(N) asm volatile("s_waitcnt vmcnt(" #N ") lgkmcnt(0)\n\ts_barrier":::"memory")
typedef __attribute__((address_space(3))) const char* lds_cptr;
typedef short v4i16_t __attribute__((ext_vector_type(4)));
__device__ __forceinline__ void kload8(bf16x8*kf,lds_cptr kp){
  kf[0]=*(const __attribute__((address_space(3))) bf16x8*)(kp);      kf[1]=*(const __attribute__((address_space(3))) bf16x8*)(kp+512);
  kf[2]=*(const __attribute__((address_space(3))) bf16x8*)(kp+2048); kf[3]=*(const __attribute__((address_space(3))) bf16x8*)(kp+2560);
  kf[4]=*(const __attribute__((address_space(3))) bf16x8*)(kp+4096); kf[5]=*(const __attribute__((address_space(3))) bf16x8*)(kp+4608);
  kf[6]=*(const __attribute__((address_space(3))) bf16x8*)(kp+6144); kf[7]=*(const __attribute__((address_space(3))) bf16x8*)(kp+6656);
}
__device__ __forceinline__ void kload2(bf16x8*kf,lds_cptr kp,int j){ kf[2*j]=*(const __attribute__((address_space(3))) bf16x8*)(kp+j*2048); kf[2*j+1]=*(const __attribute__((address_space(3))) bf16x8*)(kp+j*2048+512); }
__device__ __forceinline__ s16x4 vtr(lds_cptr p){ return __builtin_bit_cast(s16x4,__builtin_amdgcn_ds_read_tr16_b64_v4i16((__attribute__((address_space(3))) v4i16_t*)p)); }
__device__ __forceinline__ float rowmax(const f32x16&p0,const f32x16&p1){
  float a=max3f(p0[0],p0[1],p1[0]),b=max3f(p0[2],p0[3],p1[1]);a=max3f(a,p1[2],p1[3]);
  #pragma unroll
  for(int r=4;r<16;r+=4){a=max3f(a,p0[r],p0[r+1]);b=max3f(b,p0[r+2],p0[r+3]);a=max3f(a,p1[r],p1[r+1]);b=max3f(b,p1[r+2],p1[r+3]);}
  const float m=max2f(a,b);
  auto rr=__builtin_amdgcn_permlane32_swap(__float_as_uint(m),__float_as_uint(m),false,false);
  return max2f(__uint_as_float(rr[0]),__uint_as_float(rr[1]));
}

__device__ __forceinline__ void pvd(f32x16* o, int vb, bf16x8 pa0, bf16x8 pa1, bf16x8 pa2, bf16x8 pa3) {
#pragma unroll
  for (int d0 = 0; d0 < 2; ++d0) { s16x4 lo[4], hi[4];
#pragma unroll
    for (int ks = 0; ks < 4; ++ks) {
      asm volatile("ds_read_b64_tr_b16 %0,%1 offset:%c2" : "=&v"(lo[ks]) : "v"(vb), "i"(d0 * 4096 + ks * 1024) : "memory");
      asm volatile("ds_read_b64_tr_b16 %0,%1 offset:%c2" : "=&v"(hi[ks]) : "v"(vb), "i"(d0 * 4096 + ks * 1024 + 512) : "memory"); }
    asm volatile("s_waitcnt lgkmcnt(0)" ::: "memory"); SBAR();
#define PK(k) (bf16x8){lo[k][0], lo[k][1], lo[k][2], lo[k][3], hi[k][0], hi[k][1], hi[k][2], hi[k][3]}
    o[d0] = __builtin_amdgcn_mfma_f32_32x32x16_bf16(pa0, PK(0), o[d0], 0, 0, 0);
    o[d0] = __builtin_amdgcn_mfma_f32_32x32x16_bf16(pa1, PK(1), o[d0], 0, 0, 0);
    o[d0] = __builtin_amdgcn_mfma_f32_32x32x16_bf16(pa2, PK(2), o[d0], 0, 0, 0);
    o[d0] = __builtin_amdgcn_mfma_f32_32x32x16_bf16(pa3, PK(3), o[d0], 0, 0, 0);
#undef PK
  }
}

constexpr int NSLOT = 3, SLOTB = 8192, KSLOTB = 9216;
constexpr int LDS_K = 0, LDS_V = NSLOT * KSLOTB, LDS_WS = LDS_V + NSLOT * SLOTB, LDS_OST = LDS_WS + NW * 64 * 4, LDS_BYTES = LDS_OST + NW * 4096;
#define KOFF(sl) ((sl) + ((sl) >> 3))
#define WB(n0, n1) do { if (wid == 0) { WAIT_BAR(n0); } else { WAIT_BAR(n1); } } while (0)
typedef __attribute__((address_space(3))) unsigned char* lds_ptr;
template <int THRL> __device__ __forceinline__ void fox_unit(int b, int h, int qb, const bf16* __restrict__ QKV, const float* __restrict__ kbias, const u32x4* __restrict__ kb16,
                                                             float sbound, bf16* O, lds_ptr shm, unsigned* qc, volatile __attribute__((address_space(3))) unsigned* qslot) {
  int tid_ = threadIdx.x; asm volatile("" : "+v"(tid_)); const int tid = tid_, lane = tid & 63, r32 = lane & 31, hi = lane >> 5; const int wid = __builtin_amdgcn_readfirstlane(tid >> 6);
  const long rowbase = (long)b * SEQ; const int q0 = qb * QB; const int colq = 1536 + h * D;
  const bf16* Qw = QKV + (rowbase + q0 + wid * QBLK) * DM + colq;
  const bf16* Kh = QKV + rowbase * DM + colq + 512; const bf16* Vh = QKV + rowbase * DM + colq + 1024;
  const float* kbh = kbias + (long)(b * 8 + h) * SEQ; const u32x4* kb16h = kb16 + (long)(b * 8 + h) * SEQ;
  const unsigned lds0 = (unsigned)(uintptr_t)shm;
  __attribute__((address_space(3))) float* wsf = (__attribute__((address_space(3))) float*)(shm + LDS_WS) + wid * 64;
  const int NT = (q0 + QB) / KVBLK;
  bf16x8 qr[4];
#pragma unroll
  for (int d0 = 0; d0 < 4; ++d0) qr[d0] = *reinterpret_cast<const bf16x8*>(&Qw[(long)r32 * DM + d0 * 16 + hi * 8]);
  const float nb_ref = kbh[q0 + wid * QBLK + r32];
  int T0 = 0;
  {
    const int tc = 2 * ((lane & 31) + 1);
    const bool valid = (lane < 32) && (tc <= NT - 4);
    const float bk = valid ? kbh[64 * tc - 1] : 0.f, bq = kbh[q0];
    const bool dead = valid && (bk < bq - 150.0f - 2.0f * sbound);
    T0 = 2 * __popcll(__ballot(dead)); }
  T0 = __builtin_amdgcn_readfirstlane(T0);
  const bf16* ksrc = Kh + (long)lane * DM + wid * 8;
  const bf16* vsrc = Vh + (long)(16 * (wid & 3) + (lane >> 2)) * DM + (wid >> 2) * 32 + (lane & 3) * 8;
  const u32x4* asrc = kb16h + lane;
  const unsigned kdst = lds0 + LDS_K + wid * 1024, adst = lds0 + LDS_K + 8192, vdst = lds0 + LDS_V + wid * 1024;
#define DMA_K(t, slot) do { glds16(ksrc + (long)(t) * KVBLK * DM, (unsigned)__builtin_amdgcn_readfirstlane(kdst + KOFF(slot))); \
                            if (wid == 0) glds16(asrc + (long)(t) * KVBLK, (unsigned)__builtin_amdgcn_readfirstlane(adst + KOFF(slot))); } while (0)
#define DMA_V(t, slot) glds16(vsrc + (long)(t) * KVBLK * DM, (unsigned)__builtin_amdgcn_readfirstlane(vdst + (slot)))
  const lds_cptr shm3 = (lds_cptr)shm; const lds_cptr kp0 = shm3 + LDS_K + hi * 1024 + r32 * 16; const lds_cptr ka0 = shm3 + LDS_K + 8192 + r32 * 16;
  const lds_cptr vp0 = shm3 + LDS_V + ((lane >> 4) & 1) * 32 + (lane & 3) * 8 + (4 * hi + ((lane & 15) >> 2)) * 64;
  const int vb0 = (int)(lds0 + LDS_V) + ((lane >> 4) & 1) * 32 + (lane & 3) * 8 + (4 * hi + ((lane & 15) >> 2)) * 64;
  bf16x8 kf[8], ka[2];
#define ALOAD(sl) do { ka[0] = *(const __attribute__((address_space(3))) bf16x8*)(ka0 + KOFF(sl)); ka[1] = *(const __attribute__((address_space(3))) bf16x8*)(ka0 + KOFF(sl) + 512); } while (0)
  DMA_K(T0, 0); DMA_V(T0, 0); DMA_K(T0 + 1, SLOTB);
  const short one = hi ? (short)0 : (short)0x3F80;
  bf16x8 qa = (bf16x8){one, one, one, 0, 0, 0, 0, 0}; asm volatile("" : "+v"(qa));
  float l_reg = 0.f; f32x16 o[2]; o[0] = f32x16{}; o[1] = f32x16{};
  const int qrel = wid * QBLK + r32;
  f32x16 negm; { const float nb = -(nb_ref + fmaxf(sbound - 40.0f, 0.0f));
    _Pragma("unroll") for (int r = 0; r < 16; ++r) negm[r] = nb; } asm volatile("" : "+v"(negm));
#define CMASK(P0, P1, t) do { int jb_ = (t) - (NT - 4); if (jb_ >= 0) cmask(P0, P1, jb_, qrel, hi); } while (0)
#define START(P0, P1) do { _Pragma("unroll") for (int r = 0; r < 16; ++r) P0[r] = __builtin_amdgcn_exp2f(P0[r]); } while (0)
#define RESC() do {} while (0)
  f32x16 pA0, pA1, pB0, pB1;
  int sl_prev = 0, sl_cur = 0, sl_next = SLOTB;
#define ROT() do { sl_prev = sl_cur; sl_cur = sl_next; sl_next = (sl_next == (NSLOT - 1) * SLOTB) ? 0 : sl_next + SLOTB; } while (0)
  DMA_K(T0 + 2, 2 * SLOTB);
  WB(5, 3);
  { kload8(kf, kp0); ALOAD(0);
    pA0 = __builtin_amdgcn_mfma_f32_32x32x16_bf16(kf[0], qr[0], negm, 0, 0, 0); pA1 = __builtin_amdgcn_mfma_f32_32x32x16_bf16(kf[1], qr[0], negm, 0, 0, 0);
    pA0 = __builtin_amdgcn_mfma_f32_32x32x16_bf16(kf[2], qr[1], pA0, 0, 0, 0);  pA1 = __builtin_amdgcn_mfma_f32_32x32x16_bf16(kf[3], qr[1], pA1, 0, 0, 0);
    pA0 = __builtin_amdgcn_mfma_f32_32x32x16_bf16(kf[4], qr[2], pA0, 0, 0, 0);  pA1 = __builtin_amdgcn_mfma_f32_32x32x16_bf16(kf[5], qr[2], pA1, 0, 0, 0);
    pA0 = __builtin_amdgcn_mfma_f32_32x32x16_bf16(kf[6], qr[3], pA0, 0, 0, 0);  pA1 = __builtin_amdgcn_mfma_f32_32x32x16_bf16(kf[7], qr[3], pA1, 0, 0, 0);
    pA0 = __builtin_amdgcn_mfma_f32_32x32x16_bf16(ka[0], qa, pA0, 0, 0, 0);     pA1 = __builtin_amdgcn_mfma_f32_32x32x16_bf16(ka[1], qa, pA1, 0, 0, 0); }
  asm volatile("s_nop 15\n\ts_nop 7" : "+v"(pA0), "+v"(pA1)); CMASK(pA0, pA1, T0);
  START(pA0, pA1);
  _Pragma("unroll") for (int r = 0; r < 16; ++r) pA1[r] = __builtin_amdgcn_exp2f(pA1[r]);
  WAIT_BAR(0);
  DMA_K(T0 + 3, 0); DMA_V(T0 + 1, SLOTB);
  ROT();
  kload8(kf, kp0 + KOFF(sl_cur)); ALOAD(sl_cur);
  WB(3, 2);
  s16x4 vlo[8], vhi[8]; u32x4 pw0, pw1, pw2, pw3;
#define PKW(P, B) cvtpk_s(P[B], P[B + 1])
#define PAF(k) __builtin_bit_cast(bf16x8, pw##k)
#define VFR(i) (bf16x8){vlo[i][0], vlo[i][1], vlo[i][2], vlo[i][3], vhi[i][0], vhi[i][1], vhi[i][2], vhi[i][3]}
#define PIN(x) asm volatile("" : "+v"(x))
#define MX3(a, b, c) __builtin_fmaxf(__builtin_fmaxf((a), (b)), (c))
#define GAPA(MF, A0, A1, A2, A3, W0, W1, PW) do { MF; sacc += A0; sacc += A1; sacc += A2; sacc += A3; PIN(sacc); W0; W1; PIN(PW); SBAR(); } while (0)
#define EX(v) __builtin_amdgcn_exp2f(v)
#define GAPB(MF, X, B) do { MF; X[B] = EX(X[B]); X[B + 1] = EX(X[B + 1]); X[B + 2] = EX(X[B + 2]); X[B + 3] = EX(X[B + 3]); PIN(X); SBAR(); } while (0)
#define VRD(i) do { vlo[i] = vtr(vp_ + (((i) >> 2) * 4096 + ((i) & 3) * 1024)); vhi[i] = vtr(vp_ + (((i) >> 2) * 4096 + ((i) & 3) * 1024 + 512)); } while (0)
#define KRD(G, j) do { if (G) { kload2(kf, kp0 + KOFF(sl_next), j); SBAR(); } } while (0)
#define KRDA(G) do { if (G) { ALOAD(sl_next); SBAR(); } } while (0)
#define STEP(C0, C1, P0, P1, t, GK, GV, GL) do { SBAR(); \
    const lds_cptr vp_ = vp0 + sl_prev; \
    VRD(0); SBAR(); float sacc = (P0[0] + P0[1]); \
    GAPA(C0 = __builtin_amdgcn_mfma_f32_32x32x16_bf16(kf[0], qr[0], negm, 0, 0, 0), P0[2], P0[3], P0[4], P0[5],     pw0[0] = PKW(P0, 0), pw0[1] = PKW(P0, 2), pw0); \
    VRD(4); SBAR(); GAPA(C1 = __builtin_amdgcn_mfma_f32_32x32x16_bf16(kf[1], qr[0], negm, 0, 0, 0), P0[6], P0[7], P0[8], P0[9],     pw0[2] = PKW(P0, 4), pw0[3] = PKW(P0, 6), pw0); \
    VRD(1); SBAR(); GAPA(C0 = __builtin_amdgcn_mfma_f32_32x32x16_bf16(kf[2], qr[1], C0, 0, 0, 0),   P0[10], P0[11], P0[12], P0[13], pw1[0] = PKW(P0, 8), pw1[1] = PKW(P0, 10), pw1); \
    VRD(5); SBAR(); GAPA(C1 = __builtin_amdgcn_mfma_f32_32x32x16_bf16(kf[3], qr[1], C1, 0, 0, 0),   P0[14], P0[15], P1[0], P1[1],   pw1[2] = PKW(P0, 12), pw1[3] = PKW(P0, 14), pw1); \
    VRD(2); SBAR(); GAPA(C0 = __builtin_amdgcn_mfma_f32_32x32x16_bf16(kf[4], qr[2], C0, 0, 0, 0),   P1[2], P1[3], P1[4], P1[5],     pw2[0] = PKW(P1, 0), pw2[1] = PKW(P1, 2), pw2); \
    VRD(6); SBAR(); GAPA(C1 = __builtin_amdgcn_mfma_f32_32x32x16_bf16(kf[5], qr[2], C1, 0, 0, 0),   P1[6], P1[7], P1[8], P1[9],     pw2[2] = PKW(P1, 4), pw2[3] = PKW(P1, 6), pw2); \
    VRD(3); SBAR(); GAPA(C0 = __builtin_amdgcn_mfma_f32_32x32x16_bf16(kf[6], qr[3], C0, 0, 0, 0),   P1[10], P1[11], P1[12], P1[13], pw3[0] = PKW(P1, 8), pw3[1] = PKW(P1, 10), pw3); \
    VRD(7); SBAR(); GAPA(C1 = __builtin_amdgcn_mfma_f32_32x32x16_bf16(kf[7], qr[3], C1, 0, 0, 0),   P1[14], P1[15], 0.f, 0.f,       pw3[2] = PKW(P1, 12), pw3[3] = PKW(P1, 14), pw3); \
    C0 = __builtin_amdgcn_mfma_f32_32x32x16_bf16(ka[0], qa, C0, 0, 0, 0); C1 = __builtin_amdgcn_mfma_f32_32x32x16_bf16(ka[1], qa, C1, 0, 0, 0); SBAR(); \
    l_reg += sacc; \
    if (GK) { DMA_K((t) + 3, sl_cur); } if (GV) { DMA_V((t) + 1, sl_next); } \
    CMASK(C0, C1, t); \
    SBAR(); \
    GAPB(o[0] = __builtin_amdgcn_mfma_f32_32x32x16_bf16(PAF(0), VFR(0), o[0], 0, 0, 0), C0, 0); \
    GAPB(o[1] = __builtin_amdgcn_mfma_f32_32x32x16_bf16(PAF(0), VFR(4), o[1], 0, 0, 0), C0, 4); \
    KRD(GL, 0); GAPB(o[0] = __builtin_amdgcn_mfma_f32_32x32x16_bf16(PAF(1), VFR(1), o[0], 0, 0, 0), C0, 8); \
    KRD(GL, 1); GAPB(o[1] = __builtin_amdgcn_mfma_f32_32x32x16_bf16(PAF(1), VFR(5), o[1], 0, 0, 0), C0, 12); \
    KRD(GL, 2); GAPB(o[0] = __builtin_amdgcn_mfma_f32_32x32x16_bf16(PAF(2), VFR(2), o[0], 0, 0, 0), C1, 0); \
    KRD(GL, 3); GAPB(o[1] = __builtin_amdgcn_mfma_f32_32x32x16_bf16(PAF(2), VFR(6), o[1], 0, 0, 0), C1, 4); \
    KRDA(GL); GAPB(o[0] = __builtin_amdgcn_mfma_f32_32x32x16_bf16(PAF(3), VFR(3), o[0], 0, 0, 0), C1, 8); \
    GAPB(o[1] = __builtin_amdgcn_mfma_f32_32x32x16_bf16(PAF(3), VFR(7), o[1], 0, 0, 0), C1, 12); \
    } while (0)
  int t = T0 + 1;
#undef CMASK
#define CMASK(P0, P1, t) do {} while (0)
  for (; t + 5 < NT; t += 2) {
    STEP(pB0, pB1, pA0, pA1, t, true, true, true);     WB(3, 2); RESC(); ROT();
    STEP(pA0, pA1, pB0, pB1, t + 1, true, true, true); WB(3, 2); RESC(); ROT();
  }
#undef CMASK
#define CMASK(P0, P1, t) do { int jb_ = (t) - (NT - 4); if (jb_ >= 0) cmask(P0, P1, jb_, qrel, hi); } while (0)
#define ENDW(tt) do { if ((tt) + 3 < NT) { WB(3, 2); } else if ((tt) + 2 < NT) { WAIT_BAR(1); } else { WAIT_BAR(0); } } while (0)
  for (; t + 1 < NT; t += 2) {
    STEP(pB0, pB1, pA0, pA1, t, (t + 3 < NT), (t + 1 < NT), (t + 1 < NT));         ENDW(t);     RESC(); ROT();
    STEP(pA0, pA1, pB0, pB1, t + 1, (t + 4 < NT), (t + 2 < NT), (t + 2 < NT));     ENDW(t + 1); RESC(); ROT();
  }
  STEP(pB0, pB1, pA0, pA1, NT - 1, false, false, false); RESC();
  { float sacc = pB0[0] + pB0[1]; _Pragma("unroll") for (int r = 2; r < 16; ++r) sacc += pB0[r]; _Pragma("unroll") for (int r = 0; r < 16; ++r) sacc += pB1[r]; l_reg += sacc;
    pw0 = (u32x4){PKW(pB0, 0), PKW(pB0, 2), PKW(pB0, 4), PKW(pB0, 6)}; pw1 = (u32x4){PKW(pB0, 8), PKW(pB0, 10), PKW(pB0, 12), PKW(pB0, 14)};
    pw2 = (u32x4){PKW(pB1, 0), PKW(pB1, 2), PKW(pB1, 4), PKW(pB1, 6)}; pw3 = (u32x4){PKW(pB1, 8), PKW(pB1, 10), PKW(pB1, 12), PKW(pB1, 14)};
    SBAR(); pvd(o, vb0 + sl_cur, PAF(0), PAF(1), PAF(2), PAF(3)); }
  unsigned nxq = 0u; if (tid == 0) nxq = atomicAdd(qc, 1u);
  { auto rr = __builtin_amdgcn_permlane32_swap(__float_as_uint(l_reg), __float_as_uint(l_reg), false, false); l_reg = __uint_as_float(rr[0]) + __uint_as_float(rr[1]); }
  if (hi == 0) wsf[32 + r32] = l_reg; asm volatile("s_waitcnt lgkmcnt(0)" ::: "memory");
  float rli[16];
#pragma unroll
  for (int r = 0; r < 16; ++r) rli[r] = __builtin_amdgcn_rcpf(wsf[32 + crow(r, hi)]);
  bf16* Ow = O + (rowbase + q0 + wid * QBLK) * OPITCH + (8 + h) * D;
  { __attribute__((address_space(3))) bf16* stg = (__attribute__((address_space(3))) bf16*)(shm + LDS_OST) + wid * 2048;
#pragma unroll
    for (int r = 0; r < 16; ++r) { const int orow = crow(r, hi);
#pragma unroll
      for (int d0 = 0; d0 < 2; ++d0) stg[orow * 64 + d0 * 32 + r32] = (bf16)(cvtpk_s(o[d0][r] * rli[r], 0.f) & 0xffffu); }
    asm volatile("s_waitcnt lgkmcnt(0)" ::: "memory");
#pragma unroll
    for (int i = 0; i < 4; ++i) { const int row = i * 8 + (lane >> 3), ch = lane & 7; const u32x4 v = *(const __attribute__((address_space(3))) u32x4*)(stg + row * 64 + ch * 8); *(u32x4*)(Ow + (long)row * OPITCH + ch * 8) = v; } }
  if (tid == 0) *qslot = nxq;
  asm volatile("s_waitcnt lgkmcnt(0)\n\ts_barrier" ::: "memory");
#undef DMA_K
#undef DMA_V
#undef ALOAD
#undef CMASK
#undef START
#undef RESC
#undef ROT
#undef PKW
#undef PAF
#undef VFR
#undef PIN
#undef MX3
#undef GAPA
#undef GAPB
#undef EX
#undef VRD
#undef KRD
#undef KRDA
#undef STEP
#undef ENDW
}
#undef KOFF
#undef SBAR
#undef WAIT_BAR
}
constexpr int NWAVES = 8;
constexpr int BATCH = 8, SEQ = 4096, D = 1024, FF = 2816, M = BATCH * SEQ, NMOD = 9 * D, INW = 3080, NQKV = 3072;
constexpr float EPS = 1e-6f, LOG2E = 1.4426950408889634f;
constexpr size_t MiB = 1u << 20;
constexpr size_t WS_MOD = 0, WS_LF = 1 * MiB, WS_KB = 2 * MiB, WS_CTL = 3 * MiB, WS_W1GU = 4 * MiB, WS_W1D = 16 * MiB, WS_W2GU = 22 * MiB, WS_W2D = 34 * MiB, WS_WIN = 40 * MiB, WS_WO = 46 * MiB, WS_KB16 = 48 * MiB,
                 WS_H = 64 * MiB, WS_ACT = 128 * MiB, WS_X1 = 320 * MiB, WS_END = 384 * MiB;
constexpr int RING_BYTES = 131072, MISC_OFF = RING_BYTES + 320, LDS_BYTES = 147456;
static_assert(att::L_BYTES <= RING_BYTES && fox::LDS_BYTES <= RING_BYTES, "attention LDS");
#define LAS __attribute__((address_space(3)))
typedef unsigned short bf16;
typedef unsigned v4u __attribute__((ext_vector_type(4)));
typedef unsigned v2u __attribute__((ext_vector_type(2)));
typedef float f32x4 __attribute__((ext_vector_type(4)));
__device__ __forceinline__ unsigned f2bf(float f) { unsigned u = __builtin_bit_cast(unsigned, f); return (u + 0x7fffu + ((u >> 16) & 1u)) >> 16; }
__device__ __forceinline__ unsigned pk2(float lo, float hi) { return f2bf(lo) | (f2bf(hi) << 16); }
__device__ __forceinline__ float wave_sum(float v) {
#pragma unroll
    for (int o = 1; o < 64; o <<= 1) v += __shfl_xor(v, o);
    return v;
}
struct Params {
    const float *x, *c, *w_mod, *b_mod, *g_ffn1, *w1_gate, *w1_up, *w1_down, *g_mix, *w_in, *b_f, *g_q, *g_k, *w_o, *g_ffn2, *w2_gate, *w2_up, *w2_down;
    float* out; unsigned char* ws;
};
__device__ __forceinline__ void transpose_item(const float* W, int K, int ldw, bf16* WT, int k0, int n0, int dst_n0, float scale, LAS float* scr, int lane) {
#pragma unroll
    for (int i = 0; i < 32; ++i) { const int kk = 2 * i + (lane >> 5); scr[kk * 33 + (lane & 31)] = W[(size_t)(k0 + kk) * ldw + n0 + (lane & 31)] * scale; }
    asm volatile("s_waitcnt lgkmcnt(0)" ::: "memory");
    const int c = lane & 7;
#pragma unroll
    for (int j = 0; j < 4; ++j) { const int n = (lane >> 3) + 8 * j; const LAS float* s = scr + (8 * c) * 33 + n;
        v4u o; o.x = pk2(s[0 * 33], s[1 * 33]); o.y = pk2(s[2 * 33], s[3 * 33]); o.z = pk2(s[4 * 33], s[5 * 33]); o.w = pk2(s[6 * 33], s[7 * 33]);
        *(v4u*)(WT + (size_t)(dst_n0 + n) * K + k0 + 8 * c) = o; }
    asm volatile("s_waitcnt lgkmcnt(0)" ::: "memory");
}
__device__ __forceinline__ int dst_row_block(int mode, int n0) {
    if (mode == 1) return 256 * (n0 >> 7) + (n0 & 127);
    if (mode == 2) return 256 * (n0 >> 7) + 128 + (n0 & 127);
    if (mode == 3) { const int pn = n0 >> 8, wc = (n0 >> 6) & 3, bj = (n0 >> 5) & 1; return 256 * pn + 128 * bj + 32 * wc; }
    return n0;
}
__device__ __forceinline__ void convert_matrix(const float* W, int K, int ldw, int N, bf16* WT, int mode, int& base, int gw, int NGW, LAS float* scr, int lane) {
    const int nblk = N / 32, items = (K / 64) * nblk;
    const float scale = (mode == 1) ? -1.4426950408889634f : (mode == 2) ? -0.6931471805599453f : 1.0f;
    int first = (gw - base % NGW + NGW) % NGW;
    for (int it = first; it < items; it += NGW) { const int kb = it / nblk, nb = it % nblk; transpose_item(W, K, ldw, WT, 64 * kb, 32 * nb, dst_row_block(mode, 32 * nb), scale, scr, lane); }
    base += items;
}
__device__ __forceinline__ void mod_item(const Params& p, int nb, LAS unsigned char* lds, int tid) {
    LAS float* sc = (LAS float*)lds;
    LAS float* red = (LAS float*)(lds + 32768);
    for (int i = tid; i < 8192; i += 512) { const int k = i >> 3, b = i & 7; const float v = p.c[b * D + k]; sc[i] = v / (1.0f + __expf(-v)); }
    __syncthreads();
    const int kg = tid >> 5, cgp = tid & 31; const int col = nb * 128 + 4 * cgp;
    f32x4 acc[8];
#pragma unroll
    for (int b = 0; b < 8; ++b) acc[b] = (f32x4){0.f, 0.f, 0.f, 0.f};
#pragma unroll 8
    for (int kk = 0; kk < 64; ++kk) { const int k = kg * 64 + kk; const f32x4 w = *(const f32x4*)(p.w_mod + (size_t)k * NMOD + col);
        const f32x4 s0 = *(const LAS f32x4*)(sc + k * 8), s1 = *(const LAS f32x4*)(sc + k * 8 + 4);
        acc[0] += w * s0[0]; acc[1] += w * s0[1]; acc[2] += w * s0[2]; acc[3] += w * s0[3]; acc[4] += w * s1[0]; acc[5] += w * s1[1]; acc[6] += w * s1[2]; acc[7] += w * s1[3]; }
#pragma unroll
    for (int b = 0; b < 8; ++b) *(LAS f32x4*)(red + (kg * 8 + b) * 128 + 4 * cgp) = acc[b];
    __syncthreads();
    for (int o = tid; o < 1024; o += 512) { const int b = o >> 7, cc = o & 127; float s = p.b_mod[nb * 128 + cc];
#pragma unroll
        for (int g = 0; g < 16; ++g) s += red[(g * 8 + b) * 128 + cc];
        ((float*)(p.ws + WS_MOD))[b * NMOD + nb * 128 + cc] = s; }
    __syncthreads();
}
template <bool FOXF, bool XB16>
__device__ __forceinline__ void norm_phase(const Params& p, const void* X, const float* g, int sh_off, int sc_off, bf16* H, LAS unsigned char* lds, int gw, int NGW, int lane, int tid) {
    LAS float* wf = (LAS float*)lds;
    if (FOXF) { for (int i = tid; i < 8192; i += 512) wf[i] = p.w_in[(size_t)(i >> 3) * INW + NQKV + (i & 7)]; __syncthreads(); }
    const float* mod = (const float*)(p.ws + WS_MOD);
    for (int m0 = gw * 16; m0 < M; m0 += NGW * 16) {
    const int b = m0 / SEQ;
    f32x4 a[4], sh[4];
#pragma unroll
    for (int j = 0; j < 4; ++j) { const int col = 4 * lane + 256 * j; const f32x4 gv = *(const f32x4*)(g + col), sv = *(const f32x4*)(mod + (size_t)b * NMOD + sc_off + col);
        a[j] = gv * (sv + 1.0f); sh[j] = *(const f32x4*)(mod + (size_t)b * NMOD + sh_off + col); }
    for (int r4 = 0; r4 < 16; r4 += 4) {
        v2u rb[4][4]; f32x4 rf[4][4];
#pragma unroll
        for (int q = 0; q < 4; ++q)
#pragma unroll
            for (int j = 0; j < 4; ++j) {
                if (XB16) rb[q][j] = *(const v2u*)((const bf16*)X + (size_t)(m0 + r4 + q) * D + 4 * lane + 256 * j);
                else rf[q][j] = *(const f32x4*)((const float*)X + (size_t)(m0 + r4 + q) * D + 4 * lane + 256 * j); }
#pragma unroll
        for (int q = 0; q < 4; ++q) { const int m = m0 + r4 + q;
        f32x4 v[4]; float ss = 0.f;
#pragma unroll
        for (int j = 0; j < 4; ++j) {
            if (XB16) { const v2u w = rb[q][j]; v[j] = (f32x4){__uint_as_float(w.x << 16), __uint_as_float(w.x & 0xffff0000u), __uint_as_float(w.y << 16), __uint_as_float(w.y & 0xffff0000u)}; }
            else v[j] = rf[q][j];
            ss += (v[j].x * v[j].x + v[j].y * v[j].y) + (v[j].z * v[j].z + v[j].w * v[j].w); }
        const float rstd = __builtin_amdgcn_rsqf(wave_sum(ss) * (1.0f / D) + EPS);
#pragma unroll
        for (int j = 0; j < 4; ++j) { v[j] = v[j] * rstd * a[j] + sh[j];
            v2u o; o.x = pk2(v[j].x, v[j].y); o.y = pk2(v[j].z, v[j].w); *(v2u*)(H + (size_t)m * D + 4 * lane + 256 * j) = o; }
        if (FOXF) { float f[8];
#pragma unroll
            for (int qq = 0; qq < 8; ++qq) f[qq] = 0.f;
#pragma unroll
            for (int j = 0; j < 4; ++j)
#pragma unroll
                for (int e_ = 0; e_ < 4; ++e_) { const LAS float* wr = wf + (4 * lane + 256 * j + e_) * 8; const f32x4 w0 = *(const LAS f32x4*)wr, w1 = *(const LAS f32x4*)(wr + 4); const float hv = v[j][e_];
                    f[0] += hv * w0[0]; f[1] += hv * w0[1]; f[2] += hv * w0[2]; f[3] += hv * w0[3]; f[4] += hv * w1[0]; f[5] += hv * w1[1]; f[6] += hv * w1[2]; f[7] += hv * w1[3]; }
#pragma unroll
            for (int i = 0; i < 4; ++i) { const float snd = (lane & 1) ? f[i] : f[i + 4], kp = (lane & 1) ? f[i + 4] : f[i]; f[i] = kp + __shfl_xor(snd, 1); }
#pragma unroll
            for (int i = 0; i < 2; ++i) { const float snd = (lane & 2) ? f[i] : f[i + 2], kp = (lane & 2) ? f[i + 2] : f[i]; f[i] = kp + __shfl_xor(snd, 2); }
            { const float snd = (lane & 4) ? f[0] : f[1], kp = (lane & 4) ? f[1] : f[0]; f[0] = kp + __shfl_xor(snd, 4); }
            f[0] += __shfl_xor(f[0], 8); f[0] += __shfl_xor(f[0], 16); f[0] += __shfl_xor(f[0], 32);
            const int jidx = ((lane >> 2) & 1) + 2 * ((lane >> 1) & 1) + 4 * (lane & 1);
            if (lane < 8) { const float z = f[0] + p.b_f[jidx]; const float ls = fminf(z, 0.f) - log1pf(__expf(-fabsf(z))); ((float*)(p.ws + WS_LF))[(size_t)m * 8 + jidx] = ls; } }
        }
    }
    }
}
__device__ __forceinline__ void cumsum_item(const Params& p, int bh, LAS unsigned char* lds, int tid, int lane, int wave) {
    const float* LF = (const float*)(p.ws + WS_LF); float* KB = (float*)(p.ws + WS_KB);
    LAS float* wt = (LAS float*)lds;
    const int b = bh >> 3, h = bh & 7, s0 = tid * 8;
    float v[8]; float run = 0.f;
#pragma unroll
    for (int i = 0; i < 8; ++i) { run += LF[((size_t)b * SEQ + s0 + i) * 8 + h]; v[i] = run; }
    float inc = run;
    for (int o = 1; o < 64; o <<= 1) { const float t = __shfl_up(inc, o); if (lane >= o) inc += t; }
    if (lane == 63) wt[wave] = inc;
    __syncthreads();
    float pre = inc - run;
    for (int w = 0; w < wave; ++w) pre += wt[w];
    v4u* KB16 = (v4u*)(p.ws + WS_KB16);
#pragma unroll
    for (int i = 0; i < 8; ++i) { const float bv = -(pre + v[i]) * LOG2E; KB[(size_t)bh * SEQ + s0 + i] = bv;
        const unsigned h_ = f2bf(bv); const float r1 = bv - __uint_as_float(h_ << 16); const unsigned m_ = f2bf(r1); const float r2 = r1 - __uint_as_float(m_ << 16); const unsigned l_ = f2bf(r2);
        KB16[(size_t)bh * SEQ + s0 + i] = (v4u){h_ | (m_ << 16), l_, 0u, 0u}; }
    __syncthreads();
}

typedef __attribute__((address_space(1))) unsigned gu32;
#define XB_TMO      128
#define XB_XCNT(j)  (256  + 64 * (j))
#define XB_XSUB(j)  (1280 + 64 * (j))
#define XB_XGEN(j)  (2304 + 64 * (j))
#define XB_TOP      3328
#define XB_TOPGEN   3392
#define XCD_BAR_WORDS 3456
#define XB_SPIN_CAP (1u << 18)

__device__ __forceinline__ unsigned xb_ld(unsigned* p)              { return __hip_atomic_load(p, __ATOMIC_RELAXED, __HIP_MEMORY_SCOPE_AGENT); }
__device__ __forceinline__ unsigned xb_add(unsigned* p, unsigned v) { return __hip_atomic_fetch_add(p, v, __ATOMIC_RELAXED, __HIP_MEMORY_SCOPE_AGENT); }
__device__ __forceinline__ unsigned xb_xcc_id() { return (unsigned)__builtin_amdgcn_s_getreg((3 << 11) | 20) & 0xFu; }
#define XB_SPIN(cond, bar) do { unsigned _sp = 0; while (cond) { __builtin_amdgcn_s_sleep(1); \
    if ((++_sp & 255u) == 0u) { if (xb_ld(&(bar)[XB_TMO])) break; if (_sp > XB_SPIN_CAP) { atomicAdd(&(bar)[XB_TMO], 1u); break; } } } } while (0)

struct XcdBarrier {
    unsigned* bar; unsigned x;
    volatile LAS unsigned* st;
};

__device__ __forceinline__ XcdBarrier xcd_barrier_post(unsigned* bar, volatile LAS unsigned* st) {
    XcdBarrier b; b.bar = bar; b.x = xb_xcc_id(); b.st = st;
    if (threadIdx.x == 0) (void)xb_add(&bar[XB_XCNT(b.x)], 1u);
    return b;
}
__device__ __forceinline__ void xcd_barrier_complete(unsigned* bar, unsigned x, unsigned& nloc, unsigned& nx) {
    const unsigned G = gridDim.x * gridDim.y * gridDim.z;
    unsigned sum, cnt, mine, sp = 0u;
    for (;;) {
        sum = 0u; cnt = 0u; mine = 0u;
#pragma unroll
        for (unsigned j = 0; j < 16; ++j) { const unsigned c = xb_ld(&bar[XB_XCNT(j)]); sum += c; cnt += (c > 0u) ? 1u : 0u; mine = (j == x) ? c : mine; }
        if (sum == G) break;
        __builtin_amdgcn_s_sleep(1);
        if ((++sp & 255u) == 0u) { if (xb_ld(&bar[XB_TMO])) break; if (sp > XB_SPIN_CAP) { atomicAdd(&bar[XB_TMO], 1u); break; } }
    }
    nloc = mine > 0u ? mine : 1u; nx = cnt > 0u ? cnt : 1u;
}

__device__ __forceinline__ void xcd_barrier(const XcdBarrier& b) {
    asm volatile("s_waitcnt vmcnt(0)" ::: "memory");
    __syncthreads();
    if (threadIdx.x == 0) {
        unsigned* bar = b.bar;
        __builtin_amdgcn_s_waitcnt(0);
        unsigned nloc = b.st[0], nx = b.st[1];
        if (nloc == 0u) { xcd_barrier_complete(bar, b.x, nloc, nx); b.st[0] = nloc; b.st[1] = nx; }
        const unsigned old = xb_add(&bar[XB_XSUB(b.x)], 1u);
        const unsigned gen = old / nloc;
        if (old + 1u == (gen + 1u) * nloc) {
            __builtin_amdgcn_fence(__ATOMIC_RELEASE, "agent");
            asm volatile("s_waitcnt vmcnt(0)" ::: "memory");
            const unsigned og = xb_add(&bar[XB_TOP], 1u);
            const unsigned tg = og / nx;
            if (og + 1u == (tg + 1u) * nx) xb_add(&bar[XB_TOPGEN], 1u);
            else XB_SPIN(xb_ld(&bar[XB_TOPGEN]) == tg, bar);
            __builtin_amdgcn_fence(__ATOMIC_ACQUIRE, "agent");
            xb_add(&bar[XB_XGEN(b.x)], 1u);
            asm volatile("s_waitcnt vmcnt(0)" ::: "memory");
        } else {
            XB_SPIN(xb_ld(&bar[XB_XGEN(b.x)]) == gen, bar);
            __builtin_amdgcn_fence(__ATOMIC_ACQUIRE, "agent");
            asm volatile("s_waitcnt vmcnt(0)" ::: "memory");
        }
    }
    __syncthreads();
}

#ifndef GU_ALIGN
#define GU_ALIGN true
#endif
#ifndef RESID_ALIGN
#define RESID_ALIGN true
#endif
#ifndef FOX_PIPE
#define FOX_PIPE 1
#endif
#ifndef DUP_MISC
#define DUP_MISC 0
#endif
#ifndef DUP_ATT_FOX
#define DUP_ATT_FOX 0
#endif
#ifndef DUP_ATT_SB
#define DUP_ATT_SB 1
#endif
#ifndef DUP_GU
#define DUP_GU 0
#endif
#ifndef DUP_D1
#define DUP_D1 0
#endif
#ifndef DUP_SYNC
#define DUP_SYNC 0
#endif
__global__ void __launch_bounds__(NWAVES * 64, 2) hymba_fwd(Params p) {
    extern __shared__ __attribute__((aligned(16))) unsigned char lds_raw[];
    LAS unsigned char* lds = (LAS unsigned char*)lds_raw;
    cg::grid_group grid = cg::this_grid();
    const int wave = __builtin_amdgcn_readfirstlane((int)threadIdx.x >> 6);
    const int G = gridDim.x, bx = blockIdx.x;
#define FRESH_TID() int tid = threadIdx.x; asm volatile("" : "+v"(tid)); const int lane = tid & 63
    const int vcu = (G % 8 == 0) ? (bx % 8) * (G / 8) + bx / 8 : bx;
    const int gw = vcu * NWAVES + wave, NGW = G * NWAVES;
    unsigned char* ws = p.ws;
    volatile LAS unsigned* MISC = (volatile LAS unsigned*)(lds + MISC_OFF);
    if (threadIdx.x < 32) MISC[threadIdx.x] = 0u;
    unsigned* barw = (unsigned*)(ws + WS_CTL);
    __syncthreads();
    XcdBarrier xbar = xcd_barrier_post(barw, MISC + 8);
    if (ws == nullptr) grid.sync();
    float* mod = (float*)(ws + WS_MOD);
    bf16 *W1GU = (bf16*)(ws + WS_W1GU), *W1D = (bf16*)(ws + WS_W1D), *W2GU = (bf16*)(ws + WS_W2GU), *W2D = (bf16*)(ws + WS_W2D), *WIN = (bf16*)(ws + WS_WIN), *WO = (bf16*)(ws + WS_WO);
    bf16 *H = (bf16*)(ws + WS_H), *ACT = (bf16*)(ws + WS_ACT), *X1 = (bf16*)(ws + WS_X1);

    for (int rep_ = 0; rep_ < 1 + DUP_MISC; ++rep_)
    { FRESH_TID(); for (int nb = bx; nb < NMOD / 128; nb += G) mod_item(p, nb, lds, tid);
      LAS float* scr = (LAS float*)(lds + wave * 16384); int base = 0;
      convert_matrix(p.w1_gate, D, FF, FF, W1GU, 1, base, gw, NGW, scr, lane);
      convert_matrix(p.w1_up, D, FF, FF, W1GU, 2, base, gw, NGW, scr, lane);
      convert_matrix(p.w1_down, FF, D, D, W1D, 0, base, gw, NGW, scr, lane);
      convert_matrix(p.w_in, D, INW, NQKV, WIN, 3, base, gw, NGW, scr, lane);
      convert_matrix(p.w_o, D, D, D, WO, 0, base, gw, NGW, scr, lane);
      convert_matrix(p.w2_gate, D, FF, FF, W2GU, 1, base, gw, NGW, scr, lane);
      convert_matrix(p.w2_up, D, FF, FF, W2GU, 2, base, gw, NGW, scr, lane);
      convert_matrix(p.w2_down, FF, D, D, W2D, 0, base, gw, NGW, scr, lane); }
    xcd_barrier(xbar);
    for (int rep_ = 0; rep_ < 10 * DUP_SYNC; ++rep_) xcd_barrier(xbar);
    for (int rep_ = 0; rep_ < 1 + DUP_MISC; ++rep_)
    { FRESH_TID(); norm_phase<false, false>(p, p.x, p.g_ffn1, 0 * D, 1 * D, H, lds, gw, NGW, lane, tid); }
    xcd_barrier(xbar);
    for (int rep_ = 0; rep_ < 1 + DUP_GU; ++rep_)
    { pg8::Gemm g{H, W1GU, M, 2 * FF, D}; pg8::StaticOrder S; S.init(M, 2 * FF, G, bx); pg8::EpiSwiGLU E{ACT, FF};
      pg8::gemm_phase<pg8::EpiSwiGLU, pg8::StaticOrder, GU_ALIGN, true>(lds, g, S, E); }
    xcd_barrier(xbar);
    for (int rep_ = 0; rep_ < 1 + DUP_D1; ++rep_)
    { pg8::Gemm g{ACT, W1D, M, D, FF}; pg8::StaticOrder S; S.init(M, D, G, bx); pg8::EpiResid<false, true> E{p.x, X1, mod + 2 * D, 0.5f};
      pg8::gemm_phase<pg8::EpiResid<false, true>, pg8::StaticOrder, RESID_ALIGN, true>(lds, g, S, E); }
    xcd_barrier(xbar);
    for (int rep_ = 0; rep_ < 1 + DUP_MISC; ++rep_)
    { FRESH_TID(); norm_phase<true, true>(p, X1, p.g_mix, 3 * D, 4 * D, H, lds, gw, NGW, lane, tid); }
    xcd_barrier(xbar);
    if (bx < 64) { FRESH_TID(); cumsum_item(p, bx, lds, tid, lane, wave); }
    { pg8::Gemm g{H, WIN, M, NQKV, D}; pg8::StaticOrder S; S.init(M, NQKV, G, bx); pg8::EpiQKV E{ACT, p.g_q, p.g_k, 0.125f * LOG2E};
      pg8::gemm_phase<pg8::EpiQKV, pg8::StaticOrder, true, true>(lds, g, S, E); }
    xcd_barrier(xbar);
    { const float* KB = (const float*)(ws + WS_KB); unsigned* qctr = (unsigned*)(ws + WS_CTL + 65536);
      { FRESH_TID(); float a = fabsf(p.g_q[wave * 64 + lane]), c = fabsf(p.g_k[wave * 64 + lane]);
#pragma unroll
        for (int o_ = 1; o_ < 64; o_ <<= 1) { a = fmaxf(a, __shfl_xor(a, o_)); c = fmaxf(c, __shfl_xor(c, o_)); }
        if (lane == 0) MISC[24 + wave] = __float_as_uint(64.0f * 0.125f * LOG2E * a * c * 1.02f + 0.5f); }
      const unsigned home = xbar.x & 7u;
      for (unsigned kq = 0; kq < 8u; ++kq) {
          const unsigned qi = (home + kq) & 7u; unsigned* qc = qctr + 64 * qi;
          if (threadIdx.x == 0) MISC[16] = atomicAdd(qc, 1u);
          __syncthreads();
          for (;;) {
              const unsigned u = MISC[16];
              if (u >= 256u) break;
              const int kind = (u < 128u) ? 1 : 0, v = u & 127, qb = 15 - (v >> 3), b = (int)qi, h = v & 7;
              const float sbound = __uint_as_float(MISC[24 + h]);
              if (kind) fox::fox_unit<8>(b, h, qb, ACT, KB, (const fox::u32x4*)(ws + WS_KB16), sbound, H, lds, qc, MISC + 16);
              else att::attn_unit<false>(b, h, qb, ACT, KB, p.g_q, p.g_k, H, lds, qc, MISC + 16);
          }
          __syncthreads();
      } }
    xcd_barrier(xbar);
    { pg8::Gemm g{H, WO, M, D, D}; pg8::StaticOrder S; S.init(M, D, G, bx); pg8::EpiResid<true, true> E{X1, X1, mod + 5 * D, 1.0f};
      pg8::gemm_phase<pg8::EpiResid<true, true>, pg8::StaticOrder, RESID_ALIGN, true>(lds, g, S, E); }
    xcd_barrier(xbar);
    for (int rep_ = 0; rep_ < 1 + DUP_MISC; ++rep_)
    { FRESH_TID(); norm_phase<false, true>(p, X1, p.g_ffn2, 6 * D, 7 * D, H, lds, gw, NGW, lane, tid); }
    xcd_barrier(xbar);
    { pg8::Gemm g{H, W2GU, M, 2 * FF, D}; pg8::StaticOrder S; S.init(M, 2 * FF, G, bx); pg8::EpiSwiGLU E{ACT, FF};
      pg8::gemm_phase<pg8::EpiSwiGLU, pg8::StaticOrder, GU_ALIGN, true>(lds, g, S, E); }
    xcd_barrier(xbar);
    { pg8::Gemm g{ACT, W2D, M, D, FF}; pg8::StaticOrder S; S.init(M, D, G, bx); pg8::EpiResid<true, false> E{X1, p.out, mod + 8 * D, 0.5f};
      pg8::gemm_phase<pg8::EpiResid<true, false>, pg8::StaticOrder, RESID_ALIGN, true>(lds, g, S, E); }
}

extern "C" void kernel_launch(void* const* d_in, const int* in_sizes, int n_in, void* d_out, int out_size, void* d_ws, size_t ws_size, hipStream_t stream) {
    static int grid = 0;
    if (grid == 0) {
        if (n_in != 18 || in_sizes[0] != M * D || out_size != M * D || ws_size < WS_END) { fprintf(stderr, "kernel_launch: unexpected shapes (n_in %d, in0 %d, out %d, ws %zu)\n", n_in, n_in > 0 ? in_sizes[0] : -1, out_size, ws_size); grid = -1; return; }
        int dev = 0, cus = 0, per_cu = 0;
        (void)hipGetDevice(&dev); (void)hipDeviceGetAttribute(&cus, hipDeviceAttributeMultiprocessorCount, dev);
        if (hipFuncSetAttribute((const void*)hymba_fwd, hipFuncAttributeMaxDynamicSharedMemorySize, LDS_BYTES) != hipSuccess) { fprintf(stderr, "kernel_launch: hipFuncSetAttribute failed\n"); grid = -1; return; }
        if (hipOccupancyMaxActiveBlocksPerMultiprocessor(&per_cu, (const void*)hymba_fwd, NWAVES * 64, LDS_BYTES) != hipSuccess || per_cu < 1) { fprintf(stderr, "kernel_launch: occupancy query says %d\n", per_cu); per_cu = 1; }
        (void)hipGetLastError();
        grid = cus * per_cu;
    }
    if (grid < 0) return;
    if (hipMemsetAsync((char*)d_ws + WS_CTL, 0, 131072, stream) != hipSuccess) { fprintf(stderr, "kernel_launch: memset of control words failed\n"); return; }
    Params p{};
    const float** pp = (const float**)&p;
    for (int i = 0; i < 18; ++i) pp[i] = (const float*)d_in[i];
    p.out = (float*)d_out; p.ws = (unsigned char*)d_ws;
    void* args[] = {&p};
    hipError_t e = hipLaunchCooperativeKernel((const void*)hymba_fwd, dim3(grid), dim3(NWAVES * 64), args, LDS_BYTES, stream);
    if (e != hipSuccess) fprintf(stderr, "cooperative launch failed: %s (grid %d)\n", hipGetErrorString(e), grid);
}
```

```cpp
#include <hip/hip_runtime.h>
#include <hip/hip_cooperative_groups.h>
#include <hip/hip_bf16.h>
#include <cstdio>
#include <cstdint>
#include <cmath>
namespace cg = cooperative_groups;
namespace pg8 {
#define PG8_LAS __attribute__((address_space(3)))
typedef unsigned short bf16_t;
typedef short bf16x8 __attribute__((ext_vector_type(8)));
typedef float f32x4 __attribute__((ext_vector_type(4)));
typedef unsigned u32x4 __attribute__((ext_vector_type(4)));
constexpr int BM = 256, BK = 64, HALF = 128, HTB = HALF * BK * 2  , STAGE_BYTES = 8 * HTB, NXCD = 8, WGM = 4;

__host__ __device__ __forceinline__ int lds_byte(int r, int c) { const int st = (r >> 4) * 2 + (c >> 5), rr = r & 15, cc = c & 31, ob = rr * 64 + cc * 2; return st * 1024 + (ob ^ (((ob >> 9) & 1) << 5)); }
__host__ __device__ __forceinline__ void stage_rc(int b, int& R, int& C) { const int st = b / 1024, sb = b % 1024, swz = sb ^ (((sb >> 9) & 1) << 5); R = (st >> 1) * 16 + swz / 64; C = (st & 1) * 32 + (swz % 64) / 2; }
__host__ __device__ __forceinline__ int perm32(int rho) { const int n = rho >> 4, i = rho & 15; return 8 * (i >> 2) + 4 * n + (i & 3); }

struct Unit { int pm, pn; };
struct Gemm { const bf16_t* A; const bf16_t* Bt; int M, N, K; };

struct StaticOrder {
    int nM, nN, nwg, G, c;
    __host__ __device__ void init(int M, int N, int G_, int c_) { nM = M / BM; nN = N / BM; nwg = nM * nN; G = G_; c = c_; }
    __host__ __device__ bool next(int i, Unit& u) const {
        const long L = (long)i * G + c; if (L >= nwg) return false;
        int wgid = (int)L; { const int q = nwg / NXCD, r = nwg % NXCD, xcd = wgid % NXCD, off = wgid / NXCD; wgid = (xcd < r ? xcd * (q + 1) : r * (q + 1) + (xcd - r) * q) + off; }
        const int nig = WGM * nN, gid = wgid / nig, fm = gid * WGM, gsz = (nM - fm) < WGM ? (nM - fm) : WGM;
        u.pm = fm + ((wgid % nig) % gsz); u.pn = (wgid % nig) / gsz; return true;
    }
    __device__ __forceinline__ void a_ready(const Unit&) const {}
    __device__ __forceinline__ void done(const Unit&) const {}
};

__device__ __forceinline__ unsigned cvt_pk_bf16(float lo, float hi) { unsigned r; asm volatile("v_cvt_pk_bf16_f32 %0, %1, %2" : "=v"(r) : "v"(lo), "v"(hi)); return r; }
typedef float f32x2 __attribute__((ext_vector_type(2)));
typedef unsigned u32x2 __attribute__((ext_vector_type(2)));
__device__ __forceinline__ float fast_rcp(float x) { return __builtin_amdgcn_rcpf(x); }
__device__ __forceinline__ float fast_exp2(float x) { return __builtin_amdgcn_exp2f(x); }
struct EpiSwiGLU {
    static constexpr bool PERM = true, AFTER_DRAIN = false;
    bf16_t* O; int ldc;
    __device__ __forceinline__ void operator()(const f32x4 (&acc)[2][2][4][2], const Unit& u, int wr, int wc, int fr, int fq) const {
        typedef float f32x2v __attribute__((ext_vector_type(2)));
        const int row0 = u.pm * BM + wr * 64 + fr; const int col0 = u.pn * HALF + wc * 32 + 8 * fq;
#pragma unroll
        for (int ai = 0; ai < 2; ++ai)
#pragma unroll
            for (int m = 0; m < 4; ++m) {
                bf16_t* rowp = O + (size_t)(row0 + ai * HALF + m * 16) * ldc + col0;
                f32x2v r[4];
#pragma unroll
                for (int n = 0; n < 2; ++n)
#pragma unroll
                    for (int e = 0; e < 4; e += 2) { const f32x2v a = (f32x2v){acc[ai][0][m][n][e], acc[ai][0][m][n][e + 1]}, up = (f32x2v){acc[ai][1][m][n][e], acc[ai][1][m][n][e + 1]};
                        f32x2v t; t.x = fast_exp2(a.x); t.y = fast_exp2(a.y);
                        const f32x2v den = t + 1.0f; f32x2v rc; rc.x = fast_rcp(den.x); rc.y = fast_rcp(den.y);
                        r[n * 2 + (e >> 1)] = (a * up) * rc; }
                u32x4 w; w.x = cvt_pk_bf16(r[0].x, r[0].y); w.y = cvt_pk_bf16(r[1].x, r[1].y); w.z = cvt_pk_bf16(r[2].x, r[2].y); w.w = cvt_pk_bf16(r[3].x, r[3].y);
                *(u32x4*)rowp = w;
            }
    }
};
__device__ __forceinline__ f32x4 bf2f_lo(u32x2 w) { return (f32x4){__uint_as_float(w.x << 16), __uint_as_float(w.x & 0xffff0000u), __uint_as_float(w.y << 16), __uint_as_float(w.y & 0xffff0000u)}; }
template <bool BIN, bool BOUT> struct EpiResid {
    static constexpr bool PERM = true, AFTER_DRAIN = false;
    const void* base; void* out; const float* gate; float mul;
    __device__ __forceinline__ void operator()(const f32x4 (&acc)[2][2][4][2], const Unit& u, int wr, int wc, int fr, int fq) const {
        const int row0 = u.pm * BM + wr * 64 + fr; const int col0 = u.pn * BM + wc * 32 + 8 * fq;
        const float* grow = gate + (size_t)(u.pm >> 4) * 9216 + col0;
        f32x4 gv[2][2];
#pragma unroll
        for (int bj = 0; bj < 2; ++bj)
#pragma unroll
            for (int n = 0; n < 2; ++n) { const f32x4 g = *(const f32x4*)(grow + bj * HALF + 4 * n); gv[bj][n] = (g + 1.0f) * mul; }
        if (BIN) {
#pragma unroll
            for (int ai = 0; ai < 2; ++ai) {
                u32x4 bw[4][2];
#pragma unroll
                for (int m = 0; m < 4; ++m)
#pragma unroll
                    for (int bj = 0; bj < 2; ++bj) bw[m][bj] = *(const u32x4*)((const bf16_t*)base + (size_t)(row0 + ai * HALF + m * 16) * 1024 + col0 + bj * HALF);
                asm volatile("" ::: "memory");
#pragma unroll
                for (int m = 0; m < 4; ++m) { const size_t off = (size_t)(row0 + ai * HALF + m * 16) * 1024 + col0;
#pragma unroll
                    for (int bj = 0; bj < 2; ++bj) { const u32x4 w_ = bw[m][bj]; const f32x4 b0 = bf2f_lo((u32x2){w_.x, w_.y}), b1 = bf2f_lo((u32x2){w_.z, w_.w});
                        const f32x4 o0 = b0 + gv[bj][0] * acc[ai][bj][m][0], o1 = b1 + gv[bj][1] * acc[ai][bj][m][1];
                        if (BOUT) { u32x4 w; w.x = cvt_pk_bf16(o0[0], o0[1]); w.y = cvt_pk_bf16(o0[2], o0[3]); w.z = cvt_pk_bf16(o1[0], o1[1]); w.w = cvt_pk_bf16(o1[2], o1[3]); *(u32x4*)((bf16_t*)out + off + bj * HALF) = w; }
                        else { *(f32x4*)((float*)out + off + bj * HALF) = o0; *(f32x4*)((float*)out + off + bj * HALF + 4) = o1; } } }
                asm volatile("" ::: "memory");
            }
        } else {
#pragma unroll
            for (int ai = 0; ai < 2; ++ai)
#pragma unroll
                for (int m = 0; m < 4; ++m) { const size_t off = (size_t)(row0 + ai * HALF + m * 16) * 1024 + col0;
#pragma unroll
                    for (int bj = 0; bj < 2; ++bj) { const f32x4 b0 = *(const f32x4*)((const float*)base + off + bj * HALF), b1 = *(const f32x4*)((const float*)base + off + bj * HALF + 4);
                        const f32x4 o0 = b0 + gv[bj][0] * acc[ai][bj][m][0], o1 = b1 + gv[bj][1] * acc[ai][bj][m][1];
                        if (BOUT) { u32x4 w; w.x = cvt_pk_bf16(o0[0], o0[1]); w.y = cvt_pk_bf16(o0[2], o0[3]); w.z = cvt_pk_bf16(o1[0], o1[1]); w.w = cvt_pk_bf16(o1[2], o1[3]); *(u32x4*)((bf16_t*)out + off + bj * HALF) = w; }
                        else { *(f32x4*)((float*)out + off + bj * HALF) = o0; *(f32x4*)((float*)out + off + bj * HALF + 4) = o1; } }
                    if (m & 1) asm volatile("" ::: "memory"); }
        }
    }
};
struct EpiQKV {
    static constexpr bool PERM = true, AFTER_DRAIN = false;
    bf16_t* O; const float* gq; const float* gk; float qscale;
    __device__ __forceinline__ void operator()(const f32x4 (&acc)[2][2][4][2], const Unit& u, int wr, int wc, int fr, int fq) const {
        const int seg = u.pn >> 1, head = (u.pn & 1) * 4 + wc;
        const int row0 = u.pm * BM + wr * 64 + fr; const int col0 = u.pn * BM + wc * 64 + 8 * fq;
        const bool nrm = (seg == 3) || (seg == 4);
        const float sc = (seg == 0 || seg == 3) ? qscale : 1.0f;
        f32x4 gv[2][2];
#pragma unroll
        for (int bj = 0; bj < 2; ++bj)
#pragma unroll
            for (int n = 0; n < 2; ++n) { f32x4 g = (f32x4){1.f, 1.f, 1.f, 1.f};
                if (nrm) g = *(const f32x4*)((seg == 3 ? gq : gk) + head * 64 + bj * 32 + 8 * fq + 4 * n);
                gv[bj][n] = g * sc; }
#pragma unroll
        for (int ai = 0; ai < 2; ++ai)
#pragma unroll
            for (int m = 0; m < 4; ++m) {
                float rs = 1.0f;
                if (nrm) { float ss = 0.f;
#pragma unroll
                    for (int bj = 0; bj < 2; ++bj)
#pragma unroll
                        for (int n = 0; n < 2; ++n) { const f32x4 x = acc[ai][bj][m][n]; ss += (x[0] * x[0] + x[1] * x[1]) + (x[2] * x[2] + x[3] * x[3]); }
                    ss += __shfl_xor(ss, 16); ss += __shfl_xor(ss, 32);
                    rs = __builtin_amdgcn_rsqf(ss * (1.0f / 64.0f) + 1e-6f); }
                bf16_t* rowp = O + (size_t)(row0 + ai * HALF + m * 16) * 3072 + col0;
#pragma unroll
                for (int bj = 0; bj < 2; ++bj) { const f32x4 v0 = acc[ai][bj][m][0] * rs * gv[bj][0], v1 = acc[ai][bj][m][1] * rs * gv[bj][1];
                    u32x4 w; w.x = cvt_pk_bf16(v0[0], v0[1]); w.y = cvt_pk_bf16(v0[2], v0[3]); w.z = cvt_pk_bf16(v1[0], v1[1]); w.w = cvt_pk_bf16(v1[2], v1[3]);
                    *(u32x4*)(rowp + bj * 32) = w; }
            }
    }
};
template <class Epi, class Sched, bool ALIGN_EPI = false, bool SP2 = false>
__device__ __forceinline__ void gemm_phase(PG8_LAS unsigned char* lds, const Gemm g, const Sched& S, const Epi& E) {
    int tid_ = threadIdx.x; asm volatile("" : "+v"(tid_)); const int tid = tid_, wid = __builtin_amdgcn_readfirstlane(tid >> 6), lane = tid & 63, wr = wid >> 2, wc = wid & 3, fr = lane & 15, fq = lane >> 4;
    const int K = g.K, nt = K / BK;
    unsigned voffA[2], voffB[2];
#pragma unroll
    for (int i = 0; i < 2; ++i) { int R, C; stage_rc(tid * 16 + i * 8192, R, C); const int Rb = Epi::PERM ? ((R & ~31) + perm32(R & 31)) : R;
        voffA[i] = (unsigned)(R * K + C) * 2u; voffB[i] = (unsigned)(Rb * K + C) * 2u; }
    const size_t kstep = (size_t)(BK * 2);
    const size_t hstep = (size_t)HALF * K * 2;
    const size_t tstep = 2 * hstep;
    const unsigned ldsw = (unsigned)wid * 1024u;
    const int aoff = lds_byte(wr * 64 + fr, fq * 8), boff = lds_byte(wc * 32 + fr, fq * 8);
#define PG8_SA(b, h) (((b) * 2 + (h)) * HTB)
#define PG8_SB(b, h) ((4 + (b) * 2 + (h)) * HTB)
#define PG8_STAGE(bufoff, gbase, voff) do { _Pragma("unroll") for (int _i = 0; _i < 2; ++_i) \
        __builtin_amdgcn_global_load_lds((const unsigned*)((const char*)(gbase) + (voff)[_i]), (PG8_LAS unsigned*)(lds + (bufoff) + ldsw + _i * 8192), 16, 0, 0); } while (0)
#define PG8_LDA(dst, b, h) do { _Pragma("unroll") for (int m = 0; m < 4; ++m) _Pragma("unroll") for (int k = 0; k < 2; ++k) dst[m][k] = *(const PG8_LAS bf16x8*)(lds + PG8_SA(b, h) + aoff + m * 2048 + k * 1024); } while (0)
#define PG8_LDB(dst, b, h) do { _Pragma("unroll") for (int n = 0; n < 2; ++n) _Pragma("unroll") for (int k = 0; k < 2; ++k) dst[n][k] = *(const PG8_LAS bf16x8*)(lds + PG8_SB(b, h) + boff + n * 2048 + k * 1024); } while (0)
#define PG8_MMA(ai, bj, At, Bt) do { __builtin_amdgcn_s_setprio(1); _Pragma("unroll") for (int m = 0; m < 4; ++m) _Pragma("unroll") for (int n = 0; n < 2; ++n) _Pragma("unroll") for (int k = 0; k < 2; ++k) \
        acc[ai][bj][m][n] = __builtin_amdgcn_mfma_f32_16x16x32_bf16(Bt[n][k], At[m][k], acc[ai][bj][m][n], 0, 0, 0); __builtin_amdgcn_s_setprio(0); } while (0)
#define PG8_WAIT_V(n) asm volatile("s_waitcnt vmcnt(" #n ")" ::: "memory")
#define PG8_WAIT_L(n) asm volatile("s_waitcnt lgkmcnt(" #n ")" ::: "memory")
#define PG8_BAR __builtin_amdgcn_s_barrier()
#define PG8_SCHED __builtin_amdgcn_sched_barrier(0)
    Unit cur, nxt; int ui = 0;
    if (!S.next(0, cur)) return;
    f32x4 acc[2][2][4][2];
#pragma unroll
    for (int a = 0; a < 2; ++a)
#pragma unroll
        for (int b = 0; b < 2; ++b)
#pragma unroll
            for (int m = 0; m < 4; ++m)
#pragma unroll
                for (int n = 0; n < 2; ++n) acc[a][b][m][n] = (f32x4){0.f, 0.f, 0.f, 0.f};
    bf16x8 At[4][2], B0[2][2], B1[2][2];
    const char* cA = (const char*)g.A + (size_t)cur.pm * tstep; const char* cB = (const char*)g.Bt + (size_t)cur.pn * tstep;
    S.a_ready(cur);
    if constexpr (SP2) {
        PG8_STAGE(PG8_SB(0, 0), cB, voffB); PG8_STAGE(PG8_SB(0, 1), cB + hstep, voffB); PG8_STAGE(PG8_SA(0, 0), cA, voffA); PG8_STAGE(PG8_SA(0, 1), cA + hstep, voffA);
        if (wr == 1) PG8_BAR;
        PG8_WAIT_V(2); PG8_BAR;
        PG8_STAGE(PG8_SB(1, 0), cB + kstep, voffB); PG8_STAGE(PG8_SA(1, 0), cA + kstep, voffA); PG8_STAGE(PG8_SB(1, 1), cB + hstep + kstep, voffB);
        PG8_WAIT_V(6); PG8_BAR;
    } else {
        PG8_STAGE(PG8_SB(0, 0), cB, voffB); PG8_STAGE(PG8_SA(0, 0), cA, voffA); PG8_STAGE(PG8_SB(0, 1), cB + hstep, voffB); PG8_STAGE(PG8_SA(0, 1), cA + hstep, voffA);
        if (wr == 1) PG8_BAR;
        PG8_WAIT_V(4); PG8_BAR;
        PG8_STAGE(PG8_SB(1, 0), cB + kstep, voffB); PG8_STAGE(PG8_SA(1, 0), cA + kstep, voffA); PG8_STAGE(PG8_SB(1, 1), cB + hstep + kstep, voffB);
        PG8_WAIT_V(6); PG8_BAR;
    }
    for (;;) {
        const bool has_next = S.next(ui + 1, nxt);
        const char* nA = has_next ? (const char*)g.A + (size_t)nxt.pm * tstep : cA; const char* nB = has_next ? (const char*)g.Bt + (size_t)nxt.pn * tstep : cB;
        for (int t = 0; t < nt; t += 2) {
            const bool last = (t == nt - 2);
            const char* a1 = cA + (size_t)(t + 1) * kstep;
            const char* a2 = last ? nA : cA + (size_t)(t + 2) * kstep; const char* b2 = last ? nB : cB + (size_t)(t + 2) * kstep;
            const char* a3 = a2 + kstep; const char* b3 = b2 + kstep;
            if (last && has_next) S.a_ready(nxt);
            if constexpr (SP2) {
            PG8_LDB(B0, 0, 0); PG8_LDB(B1, 0, 1); PG8_SCHED; PG8_LDA(At, 0, 0); PG8_STAGE(PG8_SA(1, 1), a1 + hstep, voffA);
            PG8_WAIT_V(8); PG8_WAIT_L(0); PG8_BAR; PG8_MMA(0, 0, At, B0); PG8_MMA(0, 1, At, B1); PG8_BAR; PG8_SCHED;
            PG8_LDA(At, 0, 1); PG8_STAGE(PG8_SB(0, 0), b2, voffB); PG8_STAGE(PG8_SB(0, 1), b2 + hstep, voffB); PG8_STAGE(PG8_SA(0, 0), a2, voffA);
            PG8_WAIT_V(8); PG8_WAIT_L(0); PG8_BAR; PG8_MMA(1, 0, At, B0); PG8_MMA(1, 1, At, B1); PG8_BAR; PG8_SCHED;
            PG8_LDB(B0, 1, 0); PG8_LDB(B1, 1, 1); PG8_SCHED; PG8_LDA(At, 1, 0); PG8_STAGE(PG8_SA(0, 1), a2 + hstep, voffA);
            PG8_WAIT_V(8); PG8_WAIT_L(0); PG8_BAR; PG8_MMA(0, 0, At, B0); PG8_MMA(0, 1, At, B1); PG8_BAR; PG8_SCHED;
            PG8_LDA(At, 1, 1); PG8_STAGE(PG8_SB(1, 0), b3, voffB); PG8_STAGE(PG8_SB(1, 1), b3 + hstep, voffB); PG8_STAGE(PG8_SA(1, 0), a3, voffA);
            PG8_WAIT_V(8); PG8_WAIT_L(0); PG8_BAR; PG8_MMA(1, 0, At, B0); PG8_MMA(1, 1, At, B1); PG8_BAR; PG8_SCHED;
            } else {
            PG8_LDB(B0, 0, 0); PG8_SCHED; PG8_LDA(At, 0, 0); PG8_STAGE(PG8_SA(1, 1), a1 + hstep, voffA);
            PG8_WAIT_L(8); PG8_BAR; PG8_WAIT_L(0); PG8_MMA(0, 0, At, B0); PG8_BAR; PG8_SCHED;
            PG8_LDB(B1, 0, 1); PG8_STAGE(PG8_SB(0, 0), b2, voffB);
            PG8_BAR; PG8_WAIT_L(0); PG8_MMA(0, 1, At, B1); PG8_BAR;
            PG8_LDA(At, 0, 1); PG8_STAGE(PG8_SA(0, 0), a2, voffA);
            PG8_BAR; PG8_WAIT_L(0); PG8_MMA(1, 0, At, B0); PG8_BAR; PG8_SCHED;
            PG8_STAGE(PG8_SB(0, 1), b2 + hstep, voffB);
            PG8_WAIT_V(6); PG8_BAR; PG8_MMA(1, 1, At, B1); PG8_BAR;
            PG8_LDB(B0, 1, 0); PG8_SCHED; PG8_LDA(At, 1, 0); PG8_STAGE(PG8_SA(0, 1), a2 + hstep, voffA);
            PG8_WAIT_L(8); PG8_BAR; PG8_WAIT_L(0); PG8_MMA(0, 0, At, B0); PG8_BAR; PG8_SCHED;
            PG8_LDB(B1, 1, 1); PG8_STAGE(PG8_SB(1, 0), b3, voffB);
            PG8_BAR; PG8_WAIT_L(0); PG8_MMA(0, 1, At, B1); PG8_BAR;
            PG8_LDA(At, 1, 1); PG8_STAGE(PG8_SA(1, 0), a3, voffA);
            PG8_BAR; PG8_WAIT_L(0); PG8_MMA(1, 0, At, B0); PG8_BAR; PG8_SCHED;
            PG8_STAGE(PG8_SB(1, 1), b3 + hstep, voffB);
            PG8_WAIT_V(6); PG8_BAR; PG8_MMA(1, 1, At, B1); PG8_BAR;
            }
        }
        if constexpr (ALIGN_EPI) { if (wr == 0) PG8_BAR; }
        if constexpr (!Epi::AFTER_DRAIN) { E(acc, cur, wr, wc, fr, fq); S.done(cur); }
        if (!has_next) break;
#pragma unroll
        for (int a = 0; a < 2; ++a)
#pragma unroll
            for (int b = 0; b < 2; ++b)
#pragma unroll
                for (int m = 0; m < 4; ++m)
#pragma unroll
                    for (int n = 0; n < 2; ++n) acc[a][b][m][n] = (f32x4){0.f, 0.f, 0.f, 0.f};
        cur = nxt; cA = nA; cB = nB; ++ui;
        if constexpr (ALIGN_EPI) { if (wr == 1) PG8_BAR; }
    }
    PG8_WAIT_V(0);
    if constexpr (!ALIGN_EPI) { if (wr == 0) PG8_BAR; }
    PG8_BAR;
    if constexpr (Epi::AFTER_DRAIN) { E.fused(acc, cur, wr, wc, fr, fq, lds, wid, lane); S.done(cur); }
#undef PG8_SA
#undef PG8_SB
#undef PG8_STAGE
#undef PG8_LDA
#undef PG8_LDB
#undef PG8_MMA
#undef PG8_WAIT_V
#undef PG8_WAIT_L
#undef PG8_BAR
#undef PG8_SCHED
}
}
namespace att {
#define ALAS __attribute__((address_space(3)))
using bf16 = unsigned short;
using bf16x8 = __attribute__((ext_vector_type(8))) short;
using s16x4 = __attribute__((ext_vector_type(4))) short;
using f32x16 = __attribute__((ext_vector_type(16))) float;
using f32x4 = __attribute__((ext_vector_type(4))) float;
using u32x4 = __attribute__((ext_vector_type(4))) unsigned;
constexpr int SEQ = 4096, PITCH = 3072, OPITCH = 1024, QB = 256, KVBLK = 64;
constexpr int SLOTB = 8192;
constexpr int L_K = 0, L_V = 4 * SLOTB, L_B = 8 * SLOTB, L_WS = L_B + 512, L_FLAG = L_WS + 8 * 256, L_OST = L_FLAG + 64, L_BYTES = L_OST + 8 * 4096;
__device__ __forceinline__ int crow(int r, int hi) { return (r & 3) + 8 * (r >> 2) + 4 * hi; }
__device__ __forceinline__ void glds16(const void* gsrc, unsigned lds_dst) { unsigned keep;
    asm volatile("s_mov_b32 %0, m0\n\ts_mov_b32 m0, %2\n\ts_nop 0\n\tglobal_load_lds_dwordx4 %1, off\n\ts_mov_b32 m0, %0" : "=&s"(keep) : "v"(gsrc), "s"(lds_dst) : "memory"); }
__device__ __forceinline__ void glds4(const void* gsrc, unsigned lds_dst) { unsigned keep;
    asm volatile("s_mov_b32 %0, m0\n\ts_mov_b32 m0, %2\n\ts_nop 0\n\tglobal_load_lds_dword %1, off\n\ts_mov_b32 m0, %0" : "=&s"(keep) : "v"(gsrc), "s"(lds_dst) : "memory"); }
typedef float f32x2_t __attribute__((ext_vector_type(2))); typedef __bf16 bf16x2_t __attribute__((ext_vector_type(2)));
__device__ __forceinline__ unsigned cvtpk_s(float lo, float hi) { f32x2_t v = {lo, hi}; bf16x2_t b = __builtin_convertvector(v, bf16x2_t); return __builtin_bit_cast(unsigned, b); }
#define AWAIT_BAR() asm volatile("s_waitcnt vmcnt(0) lgkmcnt(0)\n\ts_barrier" ::: "memory")
#define ASBAR() __builtin_amdgcn_sched_barrier(0)
struct VFrag { s16x4 lo[8], hi[8]; };
__device__ __forceinline__ void v_issue(VFrag& f, int vb) {
#pragma unroll
    for (int i = 0; i < 8; ++i) {
        asm volatile("ds_read_b64_tr_b16 %0,%1 offset:%c2" : "=&v"(f.lo[i]) : "v"(vb), "i"((i >> 2) * 4096 + (i & 3) * 1024) : "memory");
        asm volatile("ds_read_b64_tr_b16 %0,%1 offset:%c2" : "=&v"(f.hi[i]) : "v"(vb), "i"((i >> 2) * 4096 + (i & 3) * 1024 + 512) : "memory"); }
}
__device__ __forceinline__ void pv_mma(f32x16* o, VFrag& f, bf16x8 pa0, bf16x8 pa1, bf16x8 pa2, bf16x8 pa3) {
    asm volatile("s_waitcnt lgkmcnt(0)" : "+v"(f.lo[0]), "+v"(f.lo[1]), "+v"(f.lo[2]), "+v"(f.lo[3]), "+v"(f.lo[4]), "+v"(f.lo[5]), "+v"(f.lo[6]), "+v"(f.lo[7]),
                                          "+v"(f.hi[0]), "+v"(f.hi[1]), "+v"(f.hi[2]), "+v"(f.hi[3]), "+v"(f.hi[4]), "+v"(f.hi[5]), "+v"(f.hi[6]), "+v"(f.hi[7]) :: "memory");
#define APK2(k) (bf16x8){f.lo[k][0], f.lo[k][1], f.lo[k][2], f.lo[k][3], f.hi[k][0], f.hi[k][1], f.hi[k][2], f.hi[k][3]}
    o[0] = __builtin_amdgcn_mfma_f32_32x32x16_bf16(pa0, APK2(0), o[0], 0, 0, 0); o[1] = __builtin_amdgcn_mfma_f32_32x32x16_bf16(pa0, APK2(4), o[1], 0, 0, 0);
    o[0] = __builtin_amdgcn_mfma_f32_32x32x16_bf16(pa1, APK2(1), o[0], 0, 0, 0); o[1] = __builtin_amdgcn_mfma_f32_32x32x16_bf16(pa1, APK2(5), o[1], 0, 0, 0);
    o[0] = __builtin_amdgcn_mfma_f32_32x32x16_bf16(pa2, APK2(2), o[0], 0, 0, 0); o[1] = __builtin_amdgcn_mfma_f32_32x32x16_bf16(pa2, APK2(6), o[1], 0, 0, 0);
    o[0] = __builtin_amdgcn_mfma_f32_32x32x16_bf16(pa3, APK2(3), o[0], 0, 0, 0); o[1] = __builtin_amdgcn_mfma_f32_32x32x16_bf16(pa3, APK2(7), o[1], 0, 0, 0);
#undef APK2
}
__device__ __forceinline__ void pv(f32x16* o, int vb, bf16x8 pa0, bf16x8 pa1, bf16x8 pa2, bf16x8 pa3) {
#pragma unroll
    for (int d0 = 0; d0 < 2; ++d0) { s16x4 lo[4], hi[4];
#pragma unroll
        for (int ks = 0; ks < 4; ++ks) {
            asm volatile("ds_read_b64_tr_b16 %0,%1 offset:%c2" : "=&v"(lo[ks]) : "v"(vb), "i"(d0 * 4096 + ks * 1024) : "memory");
            asm volatile("ds_read_b64_tr_b16 %0,%1 offset:%c2" : "=&v"(hi[ks]) : "v"(vb), "i"(d0 * 4096 + ks * 1024 + 512) : "memory"); }
        asm volatile("s_waitcnt lgkmcnt(0)" ::: "memory"); ASBAR();
#define APK(k) (bf16x8){lo[k][0], lo[k][1], lo[k][2], lo[k][3], hi[k][0], hi[k][1], hi[k][2], hi[k][3]}
        o[d0] = __builtin_amdgcn_mfma_f32_32x32x16_bf16(pa0, APK(0), o[d0], 0, 0, 0);
        o[d0] = __builtin_amdgcn_mfma_f32_32x32x16_bf16(pa1, APK(1), o[d0], 0, 0, 0);
        o[d0] = __builtin_amdgcn_mfma_f32_32x32x16_bf16(pa2, APK(2), o[d0], 0, 0, 0);
        o[d0] = __builtin_amdgcn_mfma_f32_32x32x16_bf16(pa3, APK(3), o[d0], 0, 0, 0);
#undef APK
    }
}
#ifndef SB_EARLY_EXIT
#define SB_EARLY_EXIT 1
#endif
#ifndef FOX_SKIP
#define FOX_SKIP 1
#endif
template <bool FOX>
__device__ __forceinline__ void attn_unit(int b, int h, int qb, const bf16* __restrict__ QKV, const float* __restrict__ kbias, const float* __restrict__ gq, const float* __restrict__ gk, bf16* O, ALAS unsigned char* lds, unsigned* qc, volatile ALAS unsigned* qslot) {
    int tid_ = threadIdx.x; asm volatile("" : "+v"(tid_)); const int tid = tid_, lane = tid & 63, r32 = lane & 31, hi = lane >> 5; const int wid = __builtin_amdgcn_readfirstlane(tid >> 6);
    const long rowbase = (long)b * SEQ; const int q0 = qb * QB;
    const int colq = (FOX ? 1536 : 0) + h * 64;
    const bf16* Qw = QKV + (rowbase + q0 + wid * 32) * PITCH + colq;
    const bf16* Kh = QKV + rowbase * PITCH + colq + 512; const bf16* Vh = QKV + rowbase * PITCH + colq + 1024;
    const unsigned lds0 = (unsigned)(uintptr_t)lds;
    ALAS float* wsf = (ALAS float*)(lds + L_WS) + wid * 64;
    ALAS unsigned* flags = (ALAS unsigned*)(lds + L_FLAG);
    const int kpos = lane, khi = (kpos >> 2) & 1, kr = (kpos & 3) + 4 * ((kpos & 31) >> 3), kkey = khi * 32 + (kpos >> 5) * 16 + kr;
    const bf16* ksrc = Kh + (long)kkey * PITCH + wid * 8;
    const int key16 = lane >> 2, vhi = (key16 >> 2) & 1, vj = (key16 & 3) + 4 * (key16 >> 3), vkey = vhi * 32 + (wid & 3) * 8 + vj;
    const bf16* vsrc = Vh + (long)vkey * PITCH + (wid >> 2) * 32 + (lane & 3) * 8;
    const float* bsrc = kbias + ((long)(b * 8 + h)) * SEQ + lane;
    const unsigned kdst = lds0 + L_K + wid * 1024, vdst = lds0 + L_V + wid * 1024, bdst = lds0 + L_B;
#define ADMA(t, slot) do { glds16(ksrc + (long)(t) * KVBLK * PITCH, (unsigned)__builtin_amdgcn_readfirstlane(kdst + (slot) * SLOTB)); \
                           glds16(vsrc + (long)(t) * KVBLK * PITCH, (unsigned)__builtin_amdgcn_readfirstlane(vdst + (slot) * SLOTB)); \
                           if (FOX && wid == 0) glds4(bsrc + (t) * KVBLK, (unsigned)__builtin_amdgcn_readfirstlane(bdst + (slot) * 256)); } while (0)
    const int vb0 = (int)(lds0 + L_V) + ((lane >> 4) & 1) * 32 + (lane & 3) * 8 + (4 * hi + ((lane & 15) >> 2)) * 64;
    const int NT = (q0 + QB) / KVBLK;
    if (lane == 0) flags[wid] = 0u;
    float sbound = 0.f;
    if (FOX && FOX_SKIP) { float a = fabsf(gq[h * 64 + lane]), c = fabsf(gk[h * 64 + lane]);
#pragma unroll
        for (int o_ = 1; o_ < 64; o_ <<= 1) { a = fmaxf(a, __shfl_xor(a, o_)); c = fmaxf(c, __shfl_xor(c, o_)); }
        sbound = 64.0f * 0.125f * 1.4426950408889634f * a * c * 1.02f + 0.5f; }
    if (FOX) { ADMA(NT - 1, 0); } else { ADMA(NT - 1, (NT - 1) & 3); ADMA(NT - 2, (NT - 2) & 3); ADMA(NT - 3, (NT - 3) & 3); }
    bf16x8 qr[4];
#pragma unroll
    for (int d0 = 0; d0 < 4; ++d0) qr[d0] = *reinterpret_cast<const bf16x8*>(&Qw[(long)r32 * PITCH + d0 * 16 + hi * 8]);
    f32x16 o[2]; o[0] = f32x16{}; o[1] = f32x16{};
    float m_run = -1e30f, l_run = 0.f, Rp = 1.0f;
    const int qpos = q0 + wid * 32 + r32;
    const int qlast = q0 + wid * 32 + 31;
    for (int it = 0; it < NT; ++it) {
        int t, slot;
        if (FOX) { t = NT - 1 - it; slot = it & 1; } else { t = (wid < 4) ? NT - 3 - it : NT - 1 - it; slot = t & 3; }
        AWAIT_BAR();
        if (FOX ? FOX_SKIP : SB_EARLY_EXIT) {
            const u32x4 f0 = *(ALAS const u32x4*)(flags), f1 = *(ALAS const u32x4*)(flags + 4);
            if ((f0.x & f0.y & f0.z & f0.w & f1.x & f1.y & f1.z & f1.w) != 0u) break;
        }
        if (FOX) { if (it + 1 < NT) ADMA(t - 1, slot ^ 1); }
        else { const int tn = NT - 4 - it; if (tn >= 0) ADMA(tn, tn & 3); if (t < 0) { if (lane == 0) flags[wid] = 1u; continue; } }
        if (KVBLK * t > qlast) continue;
        const bool band = (KVBLK * t + KVBLK - 1 > q0 + wid * 32 - (FOX ? 0 : 1));
        f32x16 p0, p1;
        if (FOX) { const ALAS f32x4* bp = (const ALAS f32x4*)(lds + L_B + slot * 256 + hi * 128);
            const f32x4 c0 = bp[0], c1 = bp[1], c2 = bp[2], c3 = bp[3], c4 = bp[4], c5 = bp[5], c6 = bp[6], c7 = bp[7];
            p0 = (f32x16){c0[0], c0[1], c0[2], c0[3], c1[0], c1[1], c1[2], c1[3], c2[0], c2[1], c2[2], c2[3], c3[0], c3[1], c3[2], c3[3]};
            p1 = (f32x16){c4[0], c4[1], c4[2], c4[3], c5[0], c5[1], c5[2], c5[3], c6[0], c6[1], c6[2], c6[3], c7[0], c7[1], c7[2], c7[3]};
        } else { p0 = f32x16{}; p1 = f32x16{}; }
        VFrag vf; v_issue(vf, vb0 + slot * SLOTB);
        { const ALAS unsigned char* kp = lds + L_K + slot * SLOTB + hi * 1024 + r32 * 16;
#pragma unroll
          for (int d0 = 0; d0 < 4; ++d0) { const bf16x8 b0 = *(const ALAS bf16x8*)(kp + d0 * 2048), b1 = *(const ALAS bf16x8*)(kp + d0 * 2048 + 512);
              p0 = __builtin_amdgcn_mfma_f32_32x32x16_bf16(b0, qr[d0], p0, 0, 0, 0); p1 = __builtin_amdgcn_mfma_f32_32x32x16_bf16(b1, qr[d0], p1, 0, 0, 0); } }
        const int kbase = KVBLK * t + hi * 32;
        if (FOX) {
            if (band) {
#pragma unroll
                for (int r = 0; r < 16; ++r) { if (kbase + r > qpos) p0[r] = -INFINITY; if (kbase + 16 + r > qpos) p1[r] = -INFINITY; } }
            float mx = fmaxf(p0[0], p1[0]);
#pragma unroll
            for (int r = 1; r < 16; ++r) mx = fmaxf(mx, fmaxf(p0[r], p1[r]));
            { auto rr = __builtin_amdgcn_permlane32_swap(__float_as_uint(mx), __float_as_uint(mx), false, false); mx = fmaxf(__uint_as_float(rr[0]), __uint_as_float(rr[1])); }
            const float m_new = fmaxf(m_run, mx);
            if (__any(m_new > m_run)) {
                const float alpha = __builtin_amdgcn_exp2f(m_run - m_new); l_run *= alpha; m_run = m_new;
                if (hi == 0) wsf[r32] = alpha;
                asm volatile("s_waitcnt lgkmcnt(0)" ::: "memory");
#pragma unroll
                for (int g = 0; g < 4; ++g) { const f32x4 a = *(const ALAS f32x4*)(wsf + 8 * g + 4 * hi);
#pragma unroll
                    for (int e = 0; e < 4; ++e) { o[0][4 * g + e] *= a[e]; o[1][4 * g + e] *= a[e]; } }
            }
            float sacc = 0.f;
#pragma unroll
            for (int r = 0; r < 16; ++r) { p0[r] = __builtin_amdgcn_exp2f(p0[r] - m_run); p1[r] = __builtin_amdgcn_exp2f(p1[r] - m_run); sacc += p0[r] + p1[r]; }
            l_run += sacc;
            if (FOX_SKIP) {
                const float b0 = *(const ALAS float*)(lds + L_B + slot * 256);
                const bool dead = __all(sbound + b0 - m_run < -150.0f);
                if (lane == 0) flags[wid] = dead ? 1u : 0u; }
        } else {
            float acc = 1.0f;
#pragma unroll
            for (int e = 31; e >= 0; --e) {
                const float tt = __builtin_amdgcn_exp2f(e < 16 ? p0[e] : p1[e - 16]);
                float kp_ = __builtin_amdgcn_rcpf(1.0f + tt);
                if (band) { const bool dead = (kbase + e >= qpos); kp_ = dead ? 1.0f : kp_; }
                const float accn = acc * kp_; const float w = acc - accn; acc = accn;
                if (e < 16) p0[e] = w; else p1[e - 16] = w;
            }
            auto rr = __builtin_amdgcn_permlane32_swap(__float_as_uint(acc), __float_as_uint(acc), false, false);
            const float t_lo = __uint_as_float(rr[0]), t_hi = __uint_as_float(rr[1]);
            const float off = hi ? Rp : Rp * t_hi;
#pragma unroll
            for (int r = 0; r < 16; ++r) { p0[r] *= off; p1[r] *= off; }
            Rp = Rp * t_lo * t_hi;
            if (SB_EARLY_EXIT) { const bool alldead = __all(Rp == 0.0f); if (lane == 0) flags[wid] = alldead ? 1u : 0u; }
        }
        u32x4 pw0, pw1, pw2, pw3;
        pw0 = (u32x4){cvtpk_s(p0[0], p0[1]), cvtpk_s(p0[2], p0[3]), cvtpk_s(p0[4], p0[5]), cvtpk_s(p0[6], p0[7])};
        pw1 = (u32x4){cvtpk_s(p0[8], p0[9]), cvtpk_s(p0[10], p0[11]), cvtpk_s(p0[12], p0[13]), cvtpk_s(p0[14], p0[15])};
        pw2 = (u32x4){cvtpk_s(p1[0], p1[1]), cvtpk_s(p1[2], p1[3]), cvtpk_s(p1[4], p1[5]), cvtpk_s(p1[6], p1[7])};
        pw3 = (u32x4){cvtpk_s(p1[8], p1[9]), cvtpk_s(p1[10], p1[11]), cvtpk_s(p1[12], p1[13]), cvtpk_s(p1[14], p1[15])};
        pv_mma(o, vf, __builtin_bit_cast(bf16x8, pw0), __builtin_bit_cast(bf16x8, pw1), __builtin_bit_cast(bf16x8, pw2), __builtin_bit_cast(bf16x8, pw3));
    }
    unsigned nxq = 0u; if (tid == 0) nxq = atomicAdd(qc, 1u);
    float rli[16];
    if (FOX) {
        { auto rr = __builtin_amdgcn_permlane32_swap(__float_as_uint(l_run), __float_as_uint(l_run), false, false); l_run = __uint_as_float(rr[0]) + __uint_as_float(rr[1]); }
        if (hi == 0) wsf[32 + r32] = l_run;
        asm volatile("s_waitcnt lgkmcnt(0)" ::: "memory");
#pragma unroll
        for (int r = 0; r < 16; ++r) rli[r] = __builtin_amdgcn_rcpf(wsf[32 + crow(r, hi)]);
    } else {
#pragma unroll
        for (int r = 0; r < 16; ++r) rli[r] = 1.0f;
    }
    bf16* Ow = O + (rowbase + q0 + wid * 32) * OPITCH + ((FOX ? 8 : 0) + h) * 64;
    { ALAS bf16* stg = (ALAS bf16*)(lds + L_OST) + wid * 2048;
#pragma unroll
      for (int r = 0; r < 16; ++r) { const int orow = crow(r, hi);
#pragma unroll
          for (int d0 = 0; d0 < 2; ++d0) stg[orow * 64 + d0 * 32 + r32] = (bf16)(cvtpk_s(o[d0][r] * rli[r], 0.f) & 0xffffu); }
      asm volatile("s_waitcnt lgkmcnt(0)" ::: "memory");
#pragma unroll
      for (int i = 0; i < 4; ++i) { const int row = i * 8 + (lane >> 3), ch = lane & 7; const u32x4 v = *(const ALAS u32x4*)(stg + row * 64 + ch * 8); *(u32x4*)(Ow + (long)row * OPITCH + ch * 8) = v; } }
    if (tid == 0) *qslot = nxq;
    asm volatile("s_waitcnt lgkmcnt(0)\n\ts_barrier" ::: "memory");
#undef ADMA
}
#undef AWAIT_BAR
#undef ASBAR
}
namespace fox {
using bf16 = unsigned short;
using bf16x8 = __attribute__((ext_vector_type(8))) short;
using s16x4 = __attribute__((ext_vector_type(4))) short;
using f32x16 = __attribute__((ext_vector_type(16))) float;
using f32x4 = __attribute__((ext_vector_type(4))) float;
using u32x4 = __attribute__((ext_vector_type(4))) unsigned;
constexpr int SEQ = 4096, DM = 3072, OPITCH = 1024, D = 64, NW = 8, QBLK = 32, QB = 256, KVBLK = 64;
__device__ __forceinline__ int crow(int r,int hi){return (r&3)+8*(r>>2)+4*hi;}
#define SBAR() __builtin_amdgcn_sched_barrier(0)
__device__ __forceinline__ void cmask(f32x16&p0,f32x16&p1,int jb,int qrel,int hi){
  const float NEG=-INFINITY; int kb=64*jb+4*hi;
  #pragma unroll
  for(int r=0;r<16;++r){int kv=kb+(r&3)+8*(r>>2); if(kv>qrel)p0[r]=NEG; if(kv+32>qrel)p1[r]=NEG;}
}

__device__ __forceinline__ void glds16(const void*gsrc,unsigned lds_dst){unsigned keep;
  asm volatile("s_mov_b32 %0, m0\n\ts_mov_b32 m0, %2\n\ts_nop 0\n\tglobal_load_lds_dwordx4 %1, off\n\ts_mov_b32 m0, %0":"=&s"(keep):"v"(gsrc),"s"(lds_dst):"memory");}
__device__ __forceinline__ float max3f(float a,float b,float c){float r;asm("v_max3_f32 %0, %1, %2, %3":"=v"(r):"v"(a),"v"(b),"v"(c));return r;}
__device__ __forceinline__ float max2f(float a,float b){float r;asm("v_max_f32_e32 %0, %1, %2":"=v"(r):"v"(a),"v"(b));return r;}
__device__ __forceinline__ float fadd_s(float a,float b){float r;asm("v_add_f32_e32 %0, %1, %2":"=v"(r):"v"(a),"v"(b));return r;}
__device__ __forceinline__ float fsub_s(float a,float b){float r;asm("v_sub_f32_e32 %0, %1, %2":"=v"(r):"v"(a),"v"(b));return r;}
typedef float f32x2_t __attribute__((ext_vector_type(2))); typedef __bf16 bf16x2_t __attribute__((ext_vector_type(2)));
__device__ __forceinline__ unsigned cvtpk_s(float lo,float hi){f32x2_t v={lo,hi};bf16x2_t b=__builtin_convertvector(v,bf16x2_t);return __builtin_bit_cast(unsigned,b);}
#define WAIT_BAR(N) asm volatile("s_waitcnt vmcnt(" #N ") lgkmcnt(0)\n\ts_barrier":::"memory")
typedef __attribute__((address_space(3))) const char* lds_cptr;
typedef short v4i16_t __attribute__((ext_vector_type(4)));
__device__ __forceinline__ void kload8(bf16x8*kf,lds_cptr kp){
  kf[0]=*(const __attribute__((address_space(3))) bf16x8*)(kp);      kf[1]=*(const __attribute__((address_space(3))) bf16x8*)(kp+512);
  kf[2]=*(const __attribute__((address_space(3))) bf16x8*)(kp+2048); kf[3]=*(const __attribute__((address_space(3))) bf16x8*)(kp+2560);
  kf[4]=*(const __attribute__((address_space(3))) bf16x8*)(kp+4096); kf[5]=*(const __attribute__((address_space(3))) bf16x8*)(kp+4608);
  kf[6]=*(const __attribute__((address_space(3))) bf16x8*)(kp+6144); kf[7]=*(const __attribute__((address_space(3))) bf16x8*)(kp+6656);
}
__device__ __forceinline__ void kload2(bf16x8*kf,lds_cptr kp,int j){ kf[2*j]=*(const __attribute__((address_space(3))) bf16x8*)(kp+j*2048); kf[2*j+1]=*(const __attribute__((address_space(3))) bf16x8*)(kp+j*2048+512); }
__device__ __forceinline__ s16x4 vtr(lds_cptr p){ return __builtin_bit_cast(s16x4,__builtin_amdgcn_ds_read_tr16_b64_v4i16((__attribute__((address_space(3))) v4i16_t*)p)); }
__device__ __forceinline__ float rowmax(const f32x16&p0,const f32x16&p1){
  float a=max3f(p0[0],p0[1],p1[0]),b=max3f(p0[2],p0[3],p1[1]);a=max3f(a,p1[2],p1[3]);
  #pragma unroll
  for(int r=4;r<16;r+=4){a=max3f(a,p0[r],p0[r+1]);b=max3f(b,p0[r+2],p0[r+3]);a=max3f(a,p1[r],p1[r+1]);b=max3f(b,p1[r+2],p1[r+3]);}
  const float m=max2f(a,b);
  auto rr=__builtin_amdgcn_permlane32_swap(__float_as_uint(m),__float_as_uint(m),false,false);
  return max2f(__uint_as_float(rr[0]),__uint_as_float(rr[1]));
}

__device__ __forceinline__ void pvd(f32x16* o, int vb, bf16x8 pa0, bf16x8 pa1, bf16x8 pa2, bf16x8 pa3) {
#pragma unroll
  for (int d0 = 0; d0 < 2; ++d0) { s16x4 lo[4], hi[4];
#pragma unroll
    for (int ks = 0; ks < 4; ++ks) {
      asm volatile("ds_read_b64_tr_b16 %0,%1 offset:%c2" : "=&v"(lo[ks]) : "v"(vb), "i"(d0 * 4096 + ks * 1024) : "memory");
      asm volatile("ds_read_b64_tr_b16 %0,%1 offset:%c2" : "=&v"(hi[ks]) : "v"(vb), "i"(d0 * 4096 + ks * 1024 + 512) : "memory"); }
    asm volatile("s_waitcnt lgkmcnt(0)" ::: "memory"); SBAR();
#define PK(k) (bf16x8){lo[k][0], lo[k][1], lo[k][2], lo[k][3], hi[k][0], hi[k][1], hi[k][2], hi[k][3]}
    o[d0] = __builtin_amdgcn_mfma_f32_32x32x16_bf16(pa0, PK(0), o[d0], 0, 0, 0);
    o[d0] = __builtin_amdgcn_mfma_f32_32x32x16_bf16(pa1, PK(1), o[d0], 0, 0, 0);
    o[d0] = __builtin_amdgcn_mfma_f32_32x32x16_bf16(pa2, PK(2), o[d0], 0, 0, 0);
    o[d0] = __builtin_amdgcn_mfma_f32_32x32x16_bf16(pa3, PK(3), o[d0], 0, 0, 0);
#undef PK
  }
}

constexpr int NSLOT = 3, SLOTB = 8192, KSLOTB = 9216;
constexpr int LDS_K = 0, LDS_V = NSLOT * KSLOTB, LDS_WS = LDS_V + NSLOT * SLOTB, LDS_OST = LDS_WS + NW * 64 * 4, LDS_BYTES = LDS_OST + NW * 4096;
#define KOFF(sl) ((sl) + ((sl) >> 3))
#define WB(n0, n1) do { if (wid == 0) { WAIT_BAR(n0); } else { WAIT_BAR(n1); } } while (0)
typedef __attribute__((address_space(3))) unsigned char* lds_ptr;
template <int THRL> __device__ __forceinline__ void fox_unit(int b, int h, int qb, const bf16* __restrict__ QKV, const float* __restrict__ kbias, const u32x4* __restrict__ kb16,
                                                             float sbound, bf16* O, lds_ptr shm, unsigned* qc, volatile __attribute__((address_space(3))) unsigned* qslot) {
  int tid_ = threadIdx.x; asm volatile("" : "+v"(tid_)); const int tid = tid_, lane = tid & 63, r32 = lane & 31, hi = lane >> 5; const int wid = __builtin_amdgcn_readfirstlane(tid >> 6);
  const long rowbase = (long)b * SEQ; const int q0 = qb * QB; const int colq = 1536 + h * D;
  const bf16* Qw = QKV + (rowbase + q0 + wid * QBLK) * DM + colq;
  const bf16* Kh = QKV + rowbase * DM + colq + 512; const bf16* Vh = QKV + rowbase * DM + colq + 1024;
  const float* kbh = kbias + (long)(b * 8 + h) * SEQ; const u32x4* kb16h = kb16 + (long)(b * 8 + h) * SEQ;
  const unsigned lds0 = (unsigned)(uintptr_t)shm;
  __attribute__((address_space(3))) float* wsf = (__attribute__((address_space(3))) float*)(shm + LDS_WS) + wid * 64;
  const int NT = (q0 + QB) / KVBLK;
  bf16x8 qr[4];
#pragma unroll
  for (int d0 = 0; d0 < 4; ++d0) qr[d0] = *reinterpret_cast<const bf16x8*>(&Qw[(long)r32 * DM + d0 * 16 + hi * 8]);
  const float nb_ref = kbh[q0 + wid * QBLK + r32];
  int T0 = 0;
  {
    const int tc = 2 * ((lane & 31) + 1);
    const bool valid = (lane < 32) && (tc <= NT - 4);
    const float bk = valid ? kbh[64 * tc - 1] : 0.f, bq = kbh[q0];
    const bool dead = valid && (bk < bq - 150.0f - 2.0f * sbound);
    T0 = 2 * __popcll(__ballot(dead)); }
  T0 = __builtin_amdgcn_readfirstlane(T0);
  const bf16* ksrc = Kh + (long)lane * DM + wid * 8;
  const bf16* vsrc = Vh + (long)(16 * (wid & 3) + (lane >> 2)) * DM + (wid >> 2) * 32 + (lane & 3) * 8;
  const u32x4* asrc = kb16h + lane;
  const unsigned kdst = lds0 + LDS_K + wid * 1024, adst = lds0 + LDS_K + 8192, vdst = lds0 + LDS_V + wid * 1024;
#define DMA_K(t, slot) do { glds16(ksrc + (long)(t) * KVBLK * DM, (unsigned)__builtin_amdgcn_readfirstlane(kdst + KOFF(slot))); \
                            if (wid == 0) glds16(asrc + (long)(t) * KVBLK, (unsigned)__builtin_amdgcn_readfirstlane(adst + KOFF(slot))); } while (0)
#define DMA_V(t, slot) glds16(vsrc + (long)(t) * KVBLK * DM, (unsigned)__builtin_amdgcn_readfirstlane(vdst + (slot)))
  const lds_cptr shm3 = (lds_cptr)shm; const lds_cptr kp0 = shm3 + LDS_K + hi * 1024 + r32 * 16; const lds_cptr ka0 = shm3 + LDS_K + 8192 + r32 * 16;
  const lds_cptr vp0 = shm3 + LDS_V + ((lane >> 4) & 1) * 32 + (lane & 3) * 8 + (4 * hi + ((lane & 15) >> 2)) * 64;
  const int vb0 = (int)(lds0 + LDS_V) + ((lane >> 4) & 1) * 32 + (lane & 3) * 8 + (4 * hi + ((lane & 15) >> 2)) * 64;
  bf16x8 kf[8], ka[2];
#define ALOAD(sl) do { ka[0] = *(const __attribute__((address_space(3))) bf16x8*)(ka0 + KOFF(sl)); ka[1] = *(const __attribute__((address_space(3))) bf16x8*)(ka0 + KOFF(sl) + 512); } while (0)
  DMA_K(T0, 0); DMA_V(T0, 0); DMA_K(T0 + 1, SLOTB);
  const short one = hi ? (short)0 : (short)0x3F80;
  bf16x8 qa = (bf16x8){one, one, one, 0, 0, 0, 0, 0}; asm volatile("" : "+v"(qa));
  float l_reg = 0.f; f32x16 o[2]; o[0] = f32x16{}; o[1] = f32x16{};
  const int qrel = wid * QBLK + r32;
  f32x16 negm; { const float nb = -(nb_ref + fmaxf(sbound - 40.0f, 0.0f));
    _Pragma("unroll") for (int r = 0; r < 16; ++r) negm[r] = nb; } asm volatile("" : "+v"(negm));
#define CMASK(P0, P1, t) do { int jb_ = (t) - (NT - 4); if (jb_ >= 0) cmask(P0, P1, jb_, qrel, hi); } while (0)
#define START(P0, P1) do { _Pragma("unroll") for (int r = 0; r < 16; ++r) P0[r] = __builtin_amdgcn_exp2f(P0[r]); } while (0)
#define RESC() do {} while (0)
  f32x16 pA0, pA1, pB0, pB1;
  int sl_prev = 0, sl_cur = 0, sl_next = SLOTB;
#define ROT() do { sl_prev = sl_cur; sl_cur = sl_next; sl_next = (sl_next == (NSLOT - 1) * SLOTB) ? 0 : sl_next + SLOTB; } while (0)
  DMA_K(T0 + 2, 2 * SLOTB);
  WB(5, 3);
  { kload8(kf, kp0); ALOAD(0);
    pA0 = __builtin_amdgcn_mfma_f32_32x32x16_bf16(kf[0], qr[0], negm, 0, 0, 0); pA1 = __builtin_amdgcn_mfma_f32_32x32x16_bf16(kf[1], qr[0], negm, 0, 0, 0);
    pA0 = __builtin_amdgcn_mfma_f32_32x32x16_bf16(kf[2], qr[1], pA0, 0, 0, 0);  pA1 = __builtin_amdgcn_mfma_f32_32x32x16_bf16(kf[3], qr[1], pA1, 0, 0, 0);
    pA0 = __builtin_amdgcn_mfma_f32_32x32x16_bf16(kf[4], qr[2], pA0, 0, 0, 0);  pA1 = __builtin_amdgcn_mfma_f32_32x32x16_bf16(kf[5], qr[2], pA1, 0, 0, 0);
    pA0 = __builtin_amdgcn_mfma_f32_32x32x16_bf16(kf[6], qr[3], pA0, 0, 0, 0);  pA1 = __builtin_amdgcn_mfma_f32_32x32x16_bf16(kf[7], qr[3], pA1, 0, 0, 0);
    pA0 = __builtin_amdgcn_mfma_f32_32x32x16_bf16(ka[0], qa, pA0, 0, 0, 0);     pA1 = __builtin_amdgcn_mfma_f32_32x32x16_bf16(ka[1], qa, pA1, 0, 0, 0); }
  asm volatile("s_nop 15\n\ts_nop 7" : "+v"(pA0), "+v"(pA1)); CMASK(pA0, pA1, T0);
  START(pA0, pA1);
  _Pragma("unroll") for (int r = 0; r < 16; ++r) pA1[r] = __builtin_amdgcn_exp2f(pA1[r]);
  WAIT_BAR(0);
  DMA_K(T0 + 3, 0); DMA_V(T0 + 1, SLOTB);
  ROT();
  kload8(kf, kp0 + KOFF(sl_cur)); ALOAD(sl_cur);
  WB(3, 2);
  s16x4 vlo[8], vhi[8]; u32x4 pw0, pw1, pw2, pw3;
#define PKW(P, B) cvtpk_s(P[B], P[B + 1])
#define PAF(k) __builtin_bit_cast(bf16x8, pw##k)
#define VFR(i) (bf16x8){vlo[i][0], vlo[i][1], vlo[i][2], vlo[i][3], vhi[i][0], vhi[i][1], vhi[i][2], vhi[i][3]}
#define PIN(x) asm volatile("" : "+v"(x))
#define MX3(a, b, c) __builtin_fmaxf(__builtin_fmaxf((a), (b)), (c))
#define GAPA(MF, A0, A1, A2, A3, W0, W1, PW) do { MF; sacc += A0; sacc += A1; sacc += A2; sacc += A3; PIN(sacc); W0; W1; PIN(PW); SBAR(); } while (0)
#define EX(v) __builtin_amdgcn_exp2f(v)
#define GAPB(MF, X, B) do { MF; X[B] = EX(X[B]); X[B + 1] = EX(X[B + 1]); X[B + 2] = EX(X[B + 2]); X[B + 3] = EX(X[B + 3]); PIN(X); SBAR(); } while (0)
#define VRD(i) do { vlo[i] = vtr(vp_ + (((i) >> 2) * 4096 + ((i) & 3) * 1024)); vhi[i] = vtr(vp_ + (((i) >> 2) * 4096 + ((i) & 3) * 1024 + 512)); } while (0)
#define KRD(G, j) do { if (G) { kload2(kf, kp0 + KOFF(sl_next), j); SBAR(); } } while (0)
#define KRDA(G) do { if (G) { ALOAD(sl_next); SBAR(); } } while (0)
#define STEP(C0, C1, P0, P1, t, GK, GV, GL) do { SBAR(); \
    const lds_cptr vp_ = vp0 + sl_prev; \
    VRD(0); SBAR(); float sacc = (P0[0] + P0[1]); \
    GAPA(C0 = __builtin_amdgcn_mfma_f32_32x32x16_bf16(kf[0], qr[0], negm, 0, 0, 0), P0[2], P0[3], P0[4], P0[5],     pw0[0] = PKW(P0, 0), pw0[1] = PKW(P0, 2), pw0); \
    VRD(4); SBAR(); GAPA(C1 = __builtin_amdgcn_mfma_f32_32x32x16_bf16(kf[1], qr[0], negm, 0, 0, 0), P0[6], P0[7], P0[8], P0[9],     pw0[2] = PKW(P0, 4), pw0[3] = PKW(P0, 6), pw0); \
    VRD(1); SBAR(); GAPA(C0 = __builtin_amdgcn_mfma_f32_32x32x16_bf16(kf[2], qr[1], C0, 0, 0, 0),   P0[10], P0[11], P0[12], P0[13], pw1[0] = PKW(P0, 8), pw1[1] = PKW(P0, 10), pw1); \
    VRD(5); SBAR(); GAPA(C1 = __builtin_amdgcn_mfma_f32_32x32x16_bf16(kf[3], qr[1], C1, 0, 0, 0),   P0[14], P0[15], P1[0], P1[1],   pw1[2] = PKW(P0, 12), pw1[3] = PKW(P0, 14), pw1); \
    VRD(2); SBAR(); GAPA(C0 = __builtin_amdgcn_mfma_f32_32x32x16_bf16(kf[4], qr[2], C0, 0, 0, 0),   P1[2], P1[3], P1[4], P1[5],     pw2[0] = PKW(P1, 0), pw2[1] = PKW(P1, 2), pw2); \
    VRD(6); SBAR(); GAPA(C1 = __builtin_amdgcn_mfma_f32_32x32x16_bf16(kf[5], qr[2], C1, 0, 0, 0),   P1[6], P1[7], P1[8], P1[9],     pw2[2] = PKW(P1, 4), pw2[3] = PKW(P1, 6), pw2); \
    VRD(3); SBAR(); GAPA(C0 = __builtin_amdgcn_mfma_f32_32x32x16_bf16(kf[6], qr[3], C0, 0, 0, 0),   P1[10], P1[11], P1[12], P1[13], pw3[0] = PKW(P1, 8), pw3[1] = PKW(P1, 10), pw3); \
    VRD(7); SBAR(); GAPA(C1 = __builtin_amdgcn_mfma_f32_32x32x16_bf16(kf[7], qr[3], C1, 0, 0, 0),   P1[14], P1[15], 0.f, 0.f,       pw3[2] = PKW(P1, 12), pw3[3] = PKW(P1, 14), pw3); \
    C0 = __builtin_amdgcn_mfma_f32_32x32x16_bf16(ka[0], qa, C0, 0, 0, 0); C1 = __builtin_amdgcn_mfma_f32_32x32x16_bf16(ka[1], qa, C1, 0, 0, 0); SBAR(); \
    l_reg += sacc; \
    if (GK) { DMA_K((t) + 3, sl_cur); } if (GV) { DMA_V((t) + 1, sl_next); } \
    CMASK(C0, C1, t); \
    SBAR(); \
    GAPB(o[0] = __builtin_amdgcn_mfma_f32_32x32x16_bf16(PAF(0), VFR(0), o[0], 0, 0, 0), C0, 0); \
    GAPB(o[1] = __builtin_amdgcn_mfma_f32_32x32x16_bf16(PAF(0), VFR(4), o[1], 0, 0, 0), C0, 4); \
    KRD(GL, 0); GAPB(o[0] = __builtin_amdgcn_mfma_f32_32x32x16_bf16(PAF(1), VFR(1), o[0], 0, 0, 0), C0, 8); \
    KRD(GL, 1); GAPB(o[1] = __builtin_amdgcn_mfma_f32_32x32x16_bf16(PAF(1), VFR(5), o[1], 0, 0, 0), C0, 12); \
    KRD(GL, 2); GAPB(o[0] = __builtin_amdgcn_mfma_f32_32x32x16_bf16(PAF(2), VFR(2), o[0], 0, 0, 0), C1, 0); \
    KRD(GL, 3); GAPB(o[1] = __builtin_amdgcn_mfma_f32_32x32x16_bf16(PAF(2), VFR(6), o[1], 0, 0, 0), C1, 4); \
    KRDA(GL); GAPB(o[0] = __builtin_amdgcn_mfma_f32_32x32x16_bf16(PAF(3), VFR(3), o[0], 0, 0, 0), C1, 8); \
    GAPB(o[1] = __builtin_amdgcn_mfma_f32_32x32x16_bf16(PAF(3), VFR(7), o[1], 0, 0, 0), C1, 12); \
    } while (0)
  int t = T0 + 1;
#undef CMASK
#define CMASK(P0, P1, t) do {} while (0)
  for (; t + 5 < NT; t += 2) {
    STEP(pB0, pB1, pA0, pA1, t, true, true, true);     WB(3, 2); RESC(); ROT();
    STEP(pA0, pA1, pB0, pB1, t + 1, true, true, true); WB(3, 2); RESC(); ROT();
  }
#undef CMASK
#define CMASK(P0, P1, t) do { int jb_ = (t) - (NT - 4); if (jb_ >= 0) cmask(P0, P1, jb_, qrel, hi); } while (0)
#define ENDW(tt) do { if ((tt) + 3 < NT) { WB(3, 2); } else if ((tt) + 2 < NT) { WAIT_BAR(1); } else { WAIT_BAR(0); } } while (0)
  for (; t + 1 < NT; t += 2) {
    STEP(pB0, pB1, pA0, pA1, t, (t + 3 < NT), (t + 1 < NT), (t + 1 < NT));         ENDW(t);     RESC(); ROT();
    STEP(pA0, pA1, pB0, pB1, t + 1, (t + 4 < NT), (t + 2 < NT), (t + 2 < NT));     ENDW(t + 1); RESC(); ROT();
  }
  STEP(pB0, pB1, pA0, pA1, NT - 1, false, false, false); RESC();
  { float sacc = pB0[0] + pB0[1]; _Pragma("unroll") for (int r = 2; r < 16; ++r) sacc += pB0[r]; _Pragma("unroll") for (int r = 0; r < 16; ++r) sacc += pB1[r]; l_reg += sacc;
    pw0 = (u32x4){PKW(pB0, 0), PKW(pB0, 2), PKW(pB0, 4), PKW(pB0, 6)}; pw1 = (u32x4){PKW(pB0, 8), PKW(pB0, 10), PKW(pB0, 12), PKW(pB0, 14)};
    pw2 = (u32x4){PKW(pB1, 0), PKW(pB1, 2), PKW(pB1, 4), PKW(pB1, 6)}; pw3 = (u32x4){PKW(pB1, 8), PKW(pB1, 10), PKW(pB1, 12), PKW(pB1, 14)};
    SBAR(); pvd(o, vb0 + sl_cur, PAF(0), PAF(1), PAF(2), PAF(3)); }
  unsigned nxq = 0u; if (tid == 0) nxq = atomicAdd(qc, 1u);
  { auto rr = __builtin_amdgcn_permlane32_swap(__float_as_uint(l_reg), __float_as_uint(l_reg), false, false); l_reg = __uint_as_float(rr[0]) + __uint_as_float(rr[1]); }
  if (hi == 0) wsf[32 + r32] = l_reg; asm volatile("s_waitcnt lgkmcnt(0)" ::: "memory");
  float rli[16];
#pragma unroll
  for (int r = 0; r < 16; ++r) rli[r] = __builtin_amdgcn_rcpf(wsf[32 + crow(r, hi)]);
  bf16* Ow = O + (rowbase + q0 + wid * QBLK) * OPITCH + (8 + h) * D;
  { __attribute__((address_space(3))) bf16* stg = (__attribute__((address_space(3))) bf16*)(shm + LDS_OST) + wid * 2048;
#pragma unroll
    for (int r = 0; r < 16; ++r) { const int orow = crow(r, hi);
#pragma unroll
      for (int d0 = 0; d0 < 2; ++d0) stg[orow * 64 + d0 * 32 + r32] = (bf16)(cvtpk_s(o[d0][r] * rli[r], 0.f) & 0xffffu); }
    asm volatile("s_waitcnt lgkmcnt(0)" ::: "memory");
#pragma unroll
    for (int i = 0; i < 4; ++i) { const int row = i * 8 + (lane >> 3), ch = lane & 7; const u32x4 v = *(const __attribute__((address_space(3))) u32x4*)(stg + row * 64 + ch * 8); *(u32x4*)(Ow + (long)row * OPITCH + ch * 8) = v; } }
  if (tid == 0) *qslot = nxq;
  asm volatile("s_waitcnt lgkmcnt(0)\n\ts_barrier" ::: "memory");
#undef DMA_K
#undef DMA_V
#undef ALOAD
#undef CMASK
#undef START
#undef RESC
#undef ROT
#undef PKW
#undef PAF
#undef VFR
#undef PIN
#undef MX3
#undef GAPA
#undef GAPB
#undef EX
#undef VRD
#undef KRD
#undef KRDA
#undef STEP
#undef ENDW
}
#undef KOFF
#undef SBAR
#undef WAIT_BAR
}
constexpr int NWAVES = 8;
constexpr int BATCH = 8, SEQ = 4096, D = 1024, FF = 2816, M = BATCH * SEQ, NMOD = 9 * D, INW = 3080, NQKV = 3072;
constexpr float EPS = 1e-6f, LOG2E = 1.4426950408889634f;
constexpr size_t MiB = 1u << 20;
constexpr size_t WS_MOD = 0, WS_LF = 1 * MiB, WS_KB = 2 * MiB, WS_CTL = 3 * MiB, WS_W1GU = 4 * MiB, WS_W1D = 16 * MiB, WS_W2GU = 22 * MiB, WS_W2D = 34 * MiB, WS_WIN = 40 * MiB, WS_WO = 46 * MiB, WS_KB16 = 48 * MiB,
                 WS_H = 64 * MiB, WS_ACT = 128 * MiB, WS_X1 = 320 * MiB, WS_END = 384 * MiB;
constexpr int RING_BYTES = 131072, MISC_OFF = RING_BYTES + 320, LDS_BYTES = 147456;
static_assert(att::L_BYTES <= RING_BYTES && fox::LDS_BYTES <= RING_BYTES, "attention LDS");
#define LAS __attribute__((address_space(3)))
typedef unsigned short bf16;
typedef unsigned v4u __attribute__((ext_vector_type(4)));
typedef unsigned v2u __attribute__((ext_vector_type(2)));
typedef float f32x4 __attribute__((ext_vector_type(4)));
__device__ __forceinline__ unsigned f2bf(float f) { unsigned u = __builtin_bit_cast(unsigned, f); return (u + 0x7fffu + ((u >> 16) & 1u)) >> 16; }
__device__ __forceinline__ unsigned pk2(float lo, float hi) { return f2bf(lo) | (f2bf(hi) << 16); }
__device__ __forceinline__ float wave_sum(float v) {
#pragma unroll
    for (int o = 1; o < 64; o <<= 1) v += __shfl_xor(v, o);
    return v;
}
struct Params {
    const float *x, *c, *w_mod, *b_mod, *g_ffn1, *w1_gate, *w1_up, *w1_down, *g_mix, *w_in, *b_f, *g_q, *g_k, *w_o, *g_ffn2, *w2_gate, *w2_up, *w2_down;
    float* out; unsigned char* ws;
};
__device__ __forceinline__ void transpose_item(const float* W, int K, int ldw, bf16* WT, int k0, int n0, int dst_n0, float scale, LAS float* scr, int lane) {
#pragma unroll
    for (int i = 0; i < 32; ++i) { const int kk = 2 * i + (lane >> 5); scr[kk * 33 + (lane & 31)] = W[(size_t)(k0 + kk) * ldw + n0 + (lane & 31)] * scale; }
    asm volatile("s_waitcnt lgkmcnt(0)" ::: "memory");
    const int c = lane & 7;
#pragma unroll
    for (int j = 0; j < 4; ++j) { const int n = (lane >> 3) + 8 * j; const LAS float* s = scr + (8 * c) * 33 + n;
        v4u o; o.x = pk2(s[0 * 33], s[1 * 33]); o.y = pk2(s[2 * 33], s[3 * 33]); o.z = pk2(s[4 * 33], s[5 * 33]); o.w = pk2(s[6 * 33], s[7 * 33]);
        *(v4u*)(WT + (size_t)(dst_n0 + n) * K + k0 + 8 * c) = o; }
    asm volatile("s_waitcnt lgkmcnt(0)" ::: "memory");
}
__device__ __forceinline__ int dst_row_block(int mode, int n0) {
    if (mode == 1) return 256 * (n0 >> 7) + (n0 & 127);
    if (mode == 2) return 256 * (n0 >> 7) + 128 + (n0 & 127);
    if (mode == 3) { const int pn = n0 >> 8, wc = (n0 >> 6) & 3, bj = (n0 >> 5) & 1; return 256 * pn + 128 * bj + 32 * wc; }
    return n0;
}
__device__ __forceinline__ void convert_matrix(const float* W, int K, int ldw, int N, bf16* WT, int mode, int& base, int gw, int NGW, LAS float* scr, int lane) {
    const int nblk = N / 32, items = (K / 64) * nblk;
    const float scale = (mode == 1) ? -1.4426950408889634f : (mode == 2) ? -0.6931471805599453f : 1.0f;
    int first = (gw - base % NGW + NGW) % NGW;
    for (int it = first; it < items; it += NGW) { const int kb = it / nblk, nb = it % nblk; transpose_item(W, K, ldw, WT, 64 * kb, 32 * nb, dst_row_block(mode, 32 * nb), scale, scr, lane); }
    base += items;
}
__device__ __forceinline__ void mod_item(const Params& p, int nb, LAS unsigned char* lds, int tid) {
    LAS float* sc = (LAS float*)lds;
    LAS float* red = (LAS float*)(lds + 32768);
    for (int i = tid; i < 8192; i += 512) { const int k = i >> 3, b = i & 7; const float v = p.c[b * D + k]; sc[i] = v / (1.0f + __expf(-v)); }
    __syncthreads();
    const int kg = tid >> 5, cgp = tid & 31; const int col = nb * 128 + 4 * cgp;
    f32x4 acc[8];
#pragma unroll
    for (int b = 0; b < 8; ++b) acc[b] = (f32x4){0.f, 0.f, 0.f, 0.f};
#pragma unroll 8
    for (int kk = 0; kk < 64; ++kk) { const int k = kg * 64 + kk; const f32x4 w = *(const f32x4*)(p.w_mod + (size_t)k * NMOD + col);
        const f32x4 s0 = *(const LAS f32x4*)(sc + k * 8), s1 = *(const LAS f32x4*)(sc + k * 8 + 4);
        acc[0] += w * s0[0]; acc[1] += w * s0[1]; acc[2] += w * s0[2]; acc[3] += w * s0[3]; acc[4] += w * s1[0]; acc[5] += w * s1[1]; acc[6] += w * s1[2]; acc[7] += w * s1[3]; }
#pragma unroll
    for (int b = 0; b < 8; ++b) *(LAS f32x4*)(red + (kg * 8 + b) * 128 + 4 * cgp) = acc[b];
    __syncthreads();
    for (int o = tid; o < 1024; o += 512) { const int b = o >> 7, cc = o & 127; float s = p.b_mod[nb * 128 + cc];
#pragma unroll
        for (int g = 0; g < 16; ++g) s += red[(g * 8 + b) * 128 + cc];
        ((float*)(p.ws + WS_MOD))[b * NMOD + nb * 128 + cc] = s; }
    __syncthreads();
}
template <bool FOXF, bool XB16>
__device__ __forceinline__ void norm_phase(const Params& p, const void* X, const float* g, int sh_off, int sc_off, bf16* H, LAS unsigned char* lds, int gw, int NGW, int lane, int tid) {
    LAS float* wf = (LAS float*)lds;
    if (FOXF) { for (int i = tid; i < 8192; i += 512) wf[i] = p.w_in[(size_t)(i >> 3) * INW + NQKV + (i & 7)]; __syncthreads(); }
    const float* mod = (const float*)(p.ws + WS_MOD);
    for (int m0 = gw * 16; m0 < M; m0 += NGW * 16) {
    const int b = m0 / SEQ;
    f32x4 a[4], sh[4];
#pragma unroll
    for (int j = 0; j < 4; ++j) { const int col = 4 * lane + 256 * j; const f32x4 gv = *(const f32x4*)(g + col), sv = *(const f32x4*)(mod + (size_t)b * NMOD + sc_off + col);
        a[j] = gv * (sv + 1.0f); sh[j] = *(const f32x4*)(mod + (size_t)b * NMOD + sh_off + col); }
    for (int r4 = 0; r4 < 16; r4 += 4) {
        v2u rb[4][4]; f32x4 rf[4][4];
#pragma unroll
        for (int q = 0; q < 4; ++q)
#pragma unroll
            for (int j = 0; j < 4; ++j) {
                if (XB16) rb[q][j] = *(const v2u*)((const bf16*)X + (size_t)(m0 + r4 + q) * D + 4 * lane + 256 * j);
                else rf[q][j] = *(const f32x4*)((const float*)X + (size_t)(m0 + r4 + q) * D + 4 * lane + 256 * j); }
#pragma unroll
        for (int q = 0; q < 4; ++q) { const int m = m0 + r4 + q;
        f32x4 v[4]; float ss = 0.f;
#pragma unroll
        for (int j = 0; j < 4; ++j) {
            if (XB16) { const v2u w = rb[q][j]; v[j] = (f32x4){__uint_as_float(w.x << 16), __uint_as_float(w.x & 0xffff0000u), __uint_as_float(w.y << 16), __uint_as_float(w.y & 0xffff0000u)}; }
            else v[j] = rf[q][j];
            ss += (v[j].x * v[j].x + v[j].y * v[j].y) + (v[j].z * v[j].z + v[j].w * v[j].w); }
        const float rstd = __builtin_amdgcn_rsqf(wave_sum(ss) * (1.0f / D) + EPS);
#pragma unroll
        for (int j = 0; j < 4; ++j) { v[j] = v[j] * rstd * a[j] + sh[j];
            v2u o; o.x = pk2(v[j].x, v[j].y); o.y = pk2(v[j].z, v[j].w); *(v2u*)(H + (size_t)m * D + 4 * lane + 256 * j) = o; }
        if (FOXF) { float f[8];
#pragma unroll
            for (int qq = 0; qq < 8; ++qq) f[qq] = 0.f;
#pragma unroll
            for (int j = 0; j < 4; ++j)
#pragma unroll
                for (int e_ = 0; e_ < 4; ++e_) { const LAS float* wr = wf + (4 * lane + 256 * j + e_) * 8; const f32x4 w0 = *(const LAS f32x4*)wr, w1 = *(const LAS f32x4*)(wr + 4); const float hv = v[j][e_];
                    f[0] += hv * w0[0]; f[1] += hv * w0[1]; f[2] += hv * w0[2]; f[3] += hv * w0[3]; f[4] += hv * w1[0]; f[5] += hv * w1[1]; f[6] += hv * w1[2]; f[7] += hv * w1[3]; }
#pragma unroll
            for (int i = 0; i < 4; ++i) { const float snd = (lane & 1) ? f[i] : f[i + 4], kp = (lane & 1) ? f[i + 4] : f[i]; f[i] = kp + __shfl_xor(snd, 1); }
#pragma unroll
            for (int i = 0; i < 2; ++i) { const float snd = (lane & 2) ? f[i] : f[i + 2], kp = (lane & 2) ? f[i + 2] : f[i]; f[i] = kp + __shfl_xor(snd, 2); }
            { const float snd = (lane & 4) ? f[0] : f[1], kp = (lane & 4) ? f[1] : f[0]; f[0] = kp + __shfl_xor(snd, 4); }
            f[0] += __shfl_xor(f[0], 8); f[0] += __shfl_xor(f[0], 16); f[0] += __shfl_xor(f[0], 32);
            const int jidx = ((lane >> 2) & 1) + 2 * ((lane >> 1) & 1) + 4 * (lane & 1);
            if (lane < 8) { const float z = f[0] + p.b_f[jidx]; const float ls = fminf(z, 0.f) - log1pf(__expf(-fabsf(z))); ((float*)(p.ws + WS_LF))[(size_t)m * 8 + jidx] = ls; } }
        }
    }
    }
}
__device__ __forceinline__ void cumsum_item(const Params& p, int bh, LAS unsigned char* lds, int tid, int lane, int wave) {
    const float* LF = (const float*)(p.ws + WS_LF); float* KB = (float*)(p.ws + WS_KB);
    LAS float* wt = (LAS float*)lds;
    const int b = bh >> 3, h = bh & 7, s0 = tid * 8;
    float v[8]; float run = 0.f;
#pragma unroll
    for (int i = 0; i < 8; ++i) { run += LF[((size_t)b * SEQ + s0 + i) * 8 + h]; v[i] = run; }
    float inc = run;
    for (int o = 1; o < 64; o <<= 1) { const float t = __shfl_up(inc, o); if (lane >= o) inc += t; }
    if (lane == 63) wt[wave] = inc;
    __syncthreads();
    float pre = inc - run;
    for (int w = 0; w < wave; ++w) pre += wt[w];
    v4u* KB16 = (v4u*)(p.ws + WS_KB16);
#pragma unroll
    for (int i = 0; i < 8; ++i) { const float bv = -(pre + v[i]) * LOG2E; KB[(size_t)bh * SEQ + s0 + i] = bv;
        const unsigned h_ = f2bf(bv); const float r1 = bv - __uint_as_float(h_ << 16); const unsigned m_ = f2bf(r1); const float r2 = r1 - __uint_as_float(m_ << 16); const unsigned l_ = f2bf(r2);
        KB16[(size_t)bh * SEQ + s0 + i] = (v4u){h_ | (m_ << 16), l_, 0u, 0u}; }
    __syncthreads();
}

typedef __attribute__((address_space(1))) unsigned gu32;
#define XB_TMO      128
#define XB_XCNT(j)  (256  + 64 * (j))
#define XB_XSUB(j)  (1280 + 64 * (j))
#define XB_XGEN(j)  (2304 + 64 * (j))
#define XB_TOP      3328
#define XB_TOPGEN   3392
#define XCD_BAR_WORDS 3456
#define XB_SPIN_CAP (1u << 18)

__device__ __forceinline__ unsigned xb_ld(unsigned* p)              { return __hip_atomic_load(p, __ATOMIC_RELAXED, __HIP_MEMORY_SCOPE_AGENT); }
__device__ __forceinline__ unsigned xb_add(unsigned* p, unsigned v) { return __hip_atomic_fetch_add(p, v, __ATOMIC_RELAXED, __HIP_MEMORY_SCOPE_AGENT); }
__device__ __forceinline__ unsigned xb_xcc_id() { return (unsigned)__builtin_amdgcn_s_getreg((3 << 11) | 20) & 0xFu; }
#define XB_SPIN(cond, bar) do { unsigned _sp = 0; while (cond) { __builtin_amdgcn_s_sleep(1); \
    if ((++_sp & 255u) == 0u) { if (xb_ld(&(bar)[XB_TMO])) break; if (_sp > XB_SPIN_CAP) { atomicAdd(&(bar)[XB_TMO], 1u); break; } } } } while (0)

struct XcdBarrier {
    unsigned* bar; unsigned x;
    volatile LAS unsigned* st;
};

__device__ __forceinline__ XcdBarrier xcd_barrier_post(unsigned* bar, volatile LAS unsigned* st) {
    XcdBarrier b; b.bar = bar; b.x = xb_xcc_id(); b.st = st;
    if (threadIdx.x == 0) (void)xb_add(&bar[XB_XCNT(b.x)], 1u);
    return b;
}
__device__ __forceinline__ void xcd_barrier_complete(unsigned* bar, unsigned x, unsigned& nloc, unsigned& nx) {
    const unsigned G = gridDim.x * gridDim.y * gridDim.z;
    unsigned sum, cnt, mine, sp = 0u;
    for (;;) {
        sum = 0u; cnt = 0u; mine = 0u;
#pragma unroll
        for (unsigned j = 0; j < 16; ++j) { const unsigned c = xb_ld(&bar[XB_XCNT(j)]); sum += c; cnt += (c > 0u) ? 1u : 0u; mine = (j == x) ? c : mine; }
        if (sum == G) break;
        __builtin_amdgcn_s_sleep(1);
        if ((++sp & 255u) == 0u) { if (xb_ld(&bar[XB_TMO])) break; if (sp > XB_SPIN_CAP) { atomicAdd(&bar[XB_TMO], 1u); break; } }
    }
    nloc = mine > 0u ? mine : 1u; nx = cnt > 0u ? cnt : 1u;
}

__device__ __forceinline__ void xcd_barrier(const XcdBarrier& b) {
    asm volatile("s_waitcnt vmcnt(0)" ::: "memory");
    __syncthreads();
    if (threadIdx.x == 0) {
        unsigned* bar = b.bar;
        __builtin_amdgcn_s_waitcnt(0);
        unsigned nloc = b.st[0], nx = b.st[1];
        if (nloc == 0u) { xcd_barrier_complete(bar, b.x, nloc, nx); b.st[0] = nloc; b.st[1] = nx; }
        const unsigned old = xb_add(&bar[XB_XSUB(b.x)], 1u);
        const unsigned gen = old / nloc;
        if (old + 1u == (gen + 1u) * nloc) {
            __builtin_amdgcn_fence(__ATOMIC_RELEASE, "agent");
            asm volatile("s_waitcnt vmcnt(0)" ::: "memory");
            const unsigned og = xb_add(&bar[XB_TOP], 1u);
            const unsigned tg = og / nx;
            if (og + 1u == (tg + 1u) * nx) xb_add(&bar[XB_TOPGEN], 1u);
            else XB_SPIN(xb_ld(&bar[XB_TOPGEN]) == tg, bar);
            __builtin_amdgcn_fence(__ATOMIC_ACQUIRE, "agent");
            xb_add(&bar[XB_XGEN(b.x)], 1u);
            asm volatile("s_waitcnt vmcnt(0)" ::: "memory");
        } else {
            XB_SPIN(xb_ld(&bar[XB_XGEN(b.x)]) == gen, bar);
            __builtin_amdgcn_fence(__ATOMIC_ACQUIRE, "agent");
            asm volatile("s_waitcnt vmcnt(0)" ::: "memory");
        }
    }
    __syncthreads();
}

#ifndef GU_ALIGN
#define GU_ALIGN true
#endif
#ifndef RESID_ALIGN
#define RESID_ALIGN true
#endif
#ifndef FOX_PIPE
#define FOX_PIPE 1
#endif
#ifndef DUP_MISC
#define DUP_MISC 0
#endif
#ifndef DUP_ATT_FOX
#define DUP_ATT_FOX 0
#endif
#ifndef DUP_ATT_SB
#define DUP_ATT_SB 1
#endif
#ifndef DUP_GU
#define DUP_GU 0
#endif
#ifndef DUP_D1
#define DUP_D1 0
#endif
#ifndef DUP_SYNC
#define DUP_SYNC 0
#endif
__global__ void __launch_bounds__(NWAVES * 64, 2) hymba_fwd(Params p) {
    extern __shared__ __attribute__((aligned(16))) unsigned char lds_raw[];
    LAS unsigned char* lds = (LAS unsigned char*)lds_raw;
    cg::grid_group grid = cg::this_grid();
    const int wave = __builtin_amdgcn_readfirstlane((int)threadIdx.x >> 6);
    const int G = gridDim.x, bx = blockIdx.x;
#define FRESH_TID() int tid = threadIdx.x; asm volatile("" : "+v"(tid)); const int lane = tid & 63
    const int vcu = (G % 8 == 0) ? (bx % 8) * (G / 8) + bx / 8 : bx;
    const int gw = vcu * NWAVES + wave, NGW = G * NWAVES;
    unsigned char* ws = p.ws;
    volatile LAS unsigned* MISC = (volatile LAS unsigned*)(lds + MISC_OFF);
    if (threadIdx.x < 32) MISC[threadIdx.x] = 0u;
    unsigned* barw = (unsigned*)(ws + WS_CTL);
    __syncthreads();
    XcdBarrier xbar = xcd_barrier_post(barw, MISC + 8);
    if (ws == nullptr) grid.sync();
    float* mod = (float*)(ws + WS_MOD);
    bf16 *W1GU = (bf16*)(ws + WS_W1GU), *W1D = (bf16*)(ws + WS_W1D), *W2GU = (bf16*)(ws + WS_W2GU), *W2D = (bf16*)(ws + WS_W2D), *WIN = (bf16*)(ws + WS_WIN), *WO = (bf16*)(ws + WS_WO);
    bf16 *H = (bf16*)(ws + WS_H), *ACT = (bf16*)(ws + WS_ACT), *X1 = (bf16*)(ws + WS_X1);

    for (int rep_ = 0; rep_ < 1 + DUP_MISC; ++rep_)
    { FRESH_TID(); for (int nb = bx; nb < NMOD / 128; nb += G) mod_item(p, nb, lds, tid);
      LAS float* scr = (LAS float*)(lds + wave * 16384); int base = 0;
      convert_matrix(p.w1_gate, D, FF, FF, W1GU, 1, base, gw, NGW, scr, lane);
      convert_matrix(p.w1_up, D, FF, FF, W1GU, 2, base, gw, NGW, scr, lane);
      convert_matrix(p.w1_down, FF, D, D, W1D, 0, base, gw, NGW, scr, lane);
      convert_matrix(p.w_in, D, INW, NQKV, WIN, 3, base, gw, NGW, scr, lane);
      convert_matrix(p.w_o, D, D, D, WO, 0, base, gw, NGW, scr, lane);
      convert_matrix(p.w2_gate, D, FF, FF, W2GU, 1, base, gw, NGW, scr, lane);
      convert_matrix(p.w2_up, D, FF, FF, W2GU, 2, base, gw, NGW, scr, lane);
      convert_matrix(p.w2_down, FF, D, D, W2D, 0, base, gw, NGW, scr, lane); }
    xcd_barrier(xbar);
    for (int rep_ = 0; rep_ < 10 * DUP_SYNC; ++rep_) xcd_barrier(xbar);
    for (int rep_ = 0; rep_ < 1 + DUP_MISC; ++rep_)
    { FRESH_TID(); norm_phase<false, false>(p, p.x, p.g_ffn1, 0 * D, 1 * D, H, lds, gw, NGW, lane, tid); }
    xcd_barrier(xbar);
    for (int rep_ = 0; rep_ < 1 + DUP_GU; ++rep_)
    { pg8::Gemm g{H, W1GU, M, 2 * FF, D}; pg8::StaticOrder S; S.init(M, 2 * FF, G, bx); pg8::EpiSwiGLU E{ACT, FF};
      pg8::gemm_phase<pg8::EpiSwiGLU, pg8::StaticOrder, GU_ALIGN, true>(lds, g, S, E); }
    xcd_barrier(xbar);
    for (int rep_ = 0; rep_ < 1 + DUP_D1; ++rep_)
    { pg8::Gemm g{ACT, W1D, M, D, FF}; pg8::StaticOrder S; S.init(M, D, G, bx); pg8::EpiResid<false, true> E{p.x, X1, mod + 2 * D, 0.5f};
      pg8::gemm_phase<pg8::EpiResid<false, true>, pg8::StaticOrder, RESID_ALIGN, true>(lds, g, S, E); }
    xcd_barrier(xbar);
    for (int rep_ = 0; rep_ < 1 + DUP_MISC; ++rep_)
    { FRESH_TID(); norm_phase<true, true>(p, X1, p.g_mix, 3 * D, 4 * D, H, lds, gw, NGW, lane, tid); }
    xcd_barrier(xbar);
    if (bx < 64) { FRESH_TID(); cumsum_item(p, bx, lds, tid, lane, wave); }
    { pg8::Gemm g{H, WIN, M, NQKV, D}; pg8::StaticOrder S; S.init(M, NQKV, G, bx); pg8::EpiQKV E{ACT, p.g_q, p.g_k, 0.125f * LOG2E};
      pg8::gemm_phase<pg8::EpiQKV, pg8::StaticOrder, true, true>(lds, g, S, E); }
    xcd_barrier(xbar);
    { const float* KB = (const float*)(ws + WS_KB); unsigned* qctr = (unsigned*)(ws + WS_CTL + 65536);
      { FRESH_TID(); float a = fabsf(p.g_q[wave * 64 + lane]), c = fabsf(p.g_k[wave * 64 + lane]);
#pragma unroll
        for (int o_ = 1; o_ < 64; o_ <<= 1) { a = fmaxf(a, __shfl_xor(a, o_)); c = fmaxf(c, __shfl_xor(c, o_)); }
        if (lane == 0) MISC[24 + wave] = __float_as_uint(64.0f * 0.125f * LOG2E * a * c * 1.02f + 0.5f); }
      const unsigned home = xbar.x & 7u;
      for (unsigned kq = 0; kq < 8u; ++kq) {
          const unsigned qi = (home + kq) & 7u; unsigned* qc = qctr + 64 * qi;
          if (threadIdx.x == 0) MISC[16] = atomicAdd(qc, 1u);
          __syncthreads();
          for (;;) {
              const unsigned u = MISC[16];
              if (u >= 256u) break;
              const int kind = (u < 128u) ? 1 : 0, v = u & 127, qb = 15 - (v >> 3), b = (int)qi, h = v & 7;
              const float sbound = __uint_as_float(MISC[24 + h]);
              if (kind) fox::fox_unit<8>(b, h, qb, ACT, KB, (const fox::u32x4*)(ws + WS_KB16), sbound, H, lds, qc, MISC + 16);
              else att::attn_unit<false>(b, h, qb, ACT, KB, p.g_q, p.g_k, H, lds, qc, MISC + 16);
          }
          __syncthreads();
      } }
    xcd_barrier(xbar);
    { pg8::Gemm g{H, WO, M, D, D}; pg8::StaticOrder S; S.init(M, D, G, bx); pg8::EpiResid<true, true> E{X1, X1, mod + 5 * D, 1.0f};
      pg8::gemm_phase<pg8::EpiResid<true, true>, pg8::StaticOrder, RESID_ALIGN, true>(lds, g, S, E); }
    xcd_barrier(xbar);
    for (int rep_ = 0; rep_ < 1 + DUP_MISC; ++rep_)
    { FRESH_TID(); norm_phase<false, true>(p, X1, p.g_ffn2, 6 * D, 7 * D, H, lds, gw, NGW, lane, tid); }
    xcd_barrier(xbar);
    { pg8::Gemm g{H, W2GU, M, 2 * FF, D}; pg8::StaticOrder S; S.init(M, 2 * FF, G, bx); pg8::EpiSwiGLU E{ACT, FF};
      pg8::gemm_phase<pg8::EpiSwiGLU, pg8::StaticOrder, GU_ALIGN, true>(lds, g, S, E); }
    xcd_barrier(xbar);
    { pg8::Gemm g{ACT, W2D, M, D, FF}; pg8::StaticOrder S; S.init(M, D, G, bx); pg8::EpiResid<true, false> E{X1, p.out, mod + 8 * D, 0.5f};
      pg8::gemm_phase<pg8::EpiResid<true, false>, pg8::StaticOrder, RESID_ALIGN, true>(lds, g, S, E); }
}

extern "C" void kernel_launch(void* const* d_in, const int* in_sizes, int n_in, void* d_out, int out_size, void* d_ws, size_t ws_size, hipStream_t stream) {
    static int grid = 0;
    if (grid == 0) {
        if (n_in != 18 || in_sizes[0] != M * D || out_size != M * D || ws_size < WS_END) { fprintf(stderr, "kernel_launch: unexpected shapes (n_in %d, in0 %d, out %d, ws %zu)\n", n_in, n_in > 0 ? in_sizes[0] : -1, out_size, ws_size); grid = -1; return; }
        int dev = 0, cus = 0, per_cu = 0;
        (void)hipGetDevice(&dev); (void)hipDeviceGetAttribute(&cus, hipDeviceAttributeMultiprocessorCount, dev);
        if (hipFuncSetAttribute((const void*)hymba_fwd, hipFuncAttributeMaxDynamicSharedMemorySize, LDS_BYTES) != hipSuccess) { fprintf(stderr, "kernel_launch: hipFuncSetAttribute failed\n"); grid = -1; return; }
        if (hipOccupancyMaxActiveBlocksPerMultiprocessor(&per_cu, (const void*)hymba_fwd, NWAVES * 64, LDS_BYTES) != hipSuccess || per_cu < 1) { fprintf(stderr, "kernel_launch: occupancy query says %d\n", per_cu); per_cu = 1; }
        (void)hipGetLastError();
        grid = cus * per_cu;
    }
    if (grid < 0) return;
    if (hipMemsetAsync((char*)d_ws + WS_CTL, 0, 131072, stream) != hipSuccess) { fprintf(stderr, "kernel_launch: memset of control words failed\n"); return; }
    Params p{};
    const float** pp = (const float**)&p;
    for (int i = 0; i < 18; ++i) pp[i] = (const float*)d_in[i];
    p.out = (float*)d_out; p.ws = (unsigned char*)d_ws;
    void* args[] = {&p};
    hipError_t e = hipLaunchCooperativeKernel((const void*)hymba_fwd, dim3(grid), dim3(NWAVES * 64), args, LDS_BYTES, stream);
    if (e != hipSuccess) fprintf(stderr, "cooperative launch failed: %s (grid %d)\n", hipGetErrorString(e), grid);
}
```

```cpp
#include <hip/hip_runtime.h>
#include <hip/hip_cooperative_groups.h>
#include <hip/hip_bf16.h>
#include <cstdio>
#include <cstdint>
#include <cmath>
namespace cg = cooperative_groups;
namespace pg8 {
#define PG8_LAS __attribute__((address_space(3)))
typedef unsigned short bf16_t;
typedef short bf16x8 __attribute__((ext_vector_type(8)));
typedef float f32x4 __attribute__((ext_vector_type(4)));
typedef unsigned u32x4 __attribute__((ext_vector_type(4)));
constexpr int BM = 256, BK = 64, HALF = 128, HTB = HALF * BK * 2  , STAGE_BYTES = 8 * HTB, NXCD = 8, WGM = 4;

__host__ __device__ __forceinline__ int lds_byte(int r, int c) { const int st = (r >> 4) * 2 + (c >> 5), rr = r & 15, cc = c & 31, ob = rr * 64 + cc * 2; return st * 1024 + (ob ^ (((ob >> 9) & 1) << 5)); }
__host__ __device__ __forceinline__ void stage_rc(int b, int& R, int& C) { const int st = b / 1024, sb = b % 1024, swz = sb ^ (((sb >> 9) & 1) << 5); R = (st >> 1) * 16 + swz / 64; C = (st & 1) * 32 + (swz % 64) / 2; }
__host__ __device__ __forceinline__ int perm32(int rho) { const int n = rho >> 4, i = rho & 15; return 8 * (i >> 2) + 4 * n + (i & 3); }

struct Unit { int pm, pn; };
struct Gemm { const bf16_t* A; const bf16_t* Bt; int M, N, K; };

struct StaticOrder {
    int nM, nN, nwg, G, c;
    __host__ __device__ void init(int M, int N, int G_, int c_) { nM = M / BM; nN = N / BM; nwg = nM * nN; G = G_; c = c_; }
    __host__ __device__ bool next(int i, Unit& u) const {
        const long L = (long)i * G + c; if (L >= nwg) return false;
        int wgid = (int)L; { const int q = nwg / NXCD, r = nwg % NXCD, xcd = wgid % NXCD, off = wgid / NXCD; wgid = (xcd < r ? xcd * (q + 1) : r * (q + 1) + (xcd - r) * q) + off; }
        const int nig = WGM * nN, gid = wgid / nig, fm = gid * WGM, gsz = (nM - fm) < WGM ? (nM - fm) : WGM;
        u.pm = fm + ((wgid % nig) % gsz); u.pn = (wgid % nig) / gsz; return true;
    }
    __device__ __forceinline__ void a_ready(const Unit&) const {}
    __device__ __forceinline__ void done(const Unit&) const {}
};

__device__ __forceinline__ unsigned cvt_pk_bf16(float lo, float hi) { unsigned r; asm volatile("v_cvt_pk_bf16_f32 %0, %1, %2" : "=v"(r) : "v"(lo), "v"(hi)); return r; }
typedef float f32x2 __attribute__((ext_vector_type(2)));
typedef unsigned u32x2 __attribute__((ext_vector_type(2)));
__device__ __forceinline__ float fast_rcp(float x) { return __builtin_amdgcn_rcpf(x); }
__device__ __forceinline__ float fast_exp2(float x) { return __builtin_amdgcn_exp2f(x); }
struct EpiSwiGLU {
    static constexpr bool PERM = true, AFTER_DRAIN = false;
    bf16_t* O; int ldc;
    __device__ __forceinline__ void operator()(const f32x4 (&acc)[2][2][4][2], const Unit& u, int wr, int wc, int fr, int fq) const {
        typedef float f32x2v __attribute__((ext_vector_type(2)));
        const int row0 = u.pm * BM + wr * 64 + fr; const int col0 = u.pn * HALF + wc * 32 + 8 * fq;
#pragma unroll
        for (int ai = 0; ai < 2; ++ai)
#pragma unroll
            for (int m = 0; m < 4; ++m) {
                bf16_t* rowp = O + (size_t)(row0 + ai * HALF + m * 16) * ldc + col0;
                f32x2v r[4];
#pragma unroll
                for (int n = 0; n < 2; ++n)
#pragma unroll
                    for (int e = 0; e < 4; e += 2) { const f32x2v a = (f32x2v){acc[ai][0][m][n][e], acc[ai][0][m][n][e + 1]}, up = (f32x2v){acc[ai][1][m][n][e], acc[ai][1][m][n][e + 1]};
                        f32x2v t; t.x = fast_exp2(a.x); t.y = fast_exp2(a.y);
                        const f32x2v den = t + 1.0f; f32x2v rc; rc.x = fast_rcp(den.x); rc.y = fast_rcp(den.y);
                        r[n * 2 + (e >> 1)] = (a * up) * rc; }
                u32x4 w; w.x = cvt_pk_bf16(r[0].x, r[0].y); w.y = cvt_pk_bf16(r[1].x, r[1].y); w.z = cvt_pk_bf16(r[2].x, r[2].y); w.w = cvt_pk_bf16(r[3].x, r[3].y);
                *(u32x4*)rowp = w;
            }
    }
};
__device__ __forceinline__ f32x4 bf2f_lo(u32x2 w) { return (f32x4){__uint_as_float(w.x << 16), __uint_as_float(w.x & 0xffff0000u), __uint_as_float(w.y << 16), __uint_as_float(w.y & 0xffff0000u)}; }
template <bool BIN, bool BOUT> struct EpiResid {
    static constexpr bool PERM = true, AFTER_DRAIN = false;
    const void* base; void* out; const float* gate; float mul;
    __device__ __forceinline__ void operator()(const f32x4 (&acc)[2][2][4][2], const Unit& u, int wr, int wc, int fr, int fq) const {
        const int row0 = u.pm * BM + wr * 64 + fr; const int col0 = u.pn * BM + wc * 32 + 8 * fq;
        const float* grow = gate + (size_t)(u.pm >> 4) * 9216 + col0;
        f32x4 gv[2][2];
#pragma unroll
        for (int bj = 0; bj < 2; ++bj)
#pragma unroll
            for (int n = 0; n < 2; ++n) { const f32x4 g = *(const f32x4*)(grow + bj * HALF + 4 * n); gv[bj][n] = (g + 1.0f) * mul; }
        if (BIN) {
#pragma unroll
            for (int ai = 0; ai < 2; ++ai) {
                u32x4 bw[4][2];
#pragma unroll
                for (int m = 0; m < 4; ++m)
#pragma unroll
                    for (int bj = 0; bj < 2; ++bj) bw[m][bj] = *(const u32x4*)((const bf16_t*)base + (size_t)(row0 + ai * HALF + m * 16) * 1024 + col0 + bj * HALF);
                asm volatile("" ::: "memory");
#pragma unroll
                for (int m = 0; m < 4; ++m) { const size_t off = (size_t)(row0 + ai * HALF + m * 16) * 1024 + col0;
#pragma unroll
                    for (int bj = 0; bj < 2; ++bj) { const u32x4 w_ = bw[m][bj]; const f32x4 b0 = bf2f_lo((u32x2){w_.x, w_.y}), b1 = bf2f_lo((u32x2){w_.z, w_.w});
                        const f32x4 o0 = b0 + gv[bj][0] * acc[ai][bj][m][0], o1 = b1 + gv[bj][1] * acc[ai][bj][m][1];
                        if (BOUT) { u32x4 w; w.x = cvt_pk_bf16(o0[0], o0[1]); w.y = cvt_pk_bf16(o0[2], o0[3]); w.z = cvt_pk_bf16(o1[0], o1[1]); w.w = cvt_pk_bf16(o1[2], o1[3]); *(u32x4*)((bf16_t*)out + off + bj * HALF) = w; }
                        else { *(f32x4*)((float*)out + off + bj * HALF) = o0; *(f32x4*)((float*)out + off + bj * HALF + 4) = o1; } } }
                asm volatile("" ::: "memory");
            }
        } else {
#pragma unroll
            for (int ai = 0; ai < 2; ++ai)
#pragma unroll
                for (int m = 0; m < 4; ++m) { const size_t off = (size_t)(row0 + ai * HALF + m * 16) * 1024 + col0;
#pragma unroll
                    for (int bj = 0; bj < 2; ++bj) { const f32x4 b0 = *(const f32x4*)((const float*)base + off + bj * HALF), b1 = *(const f32x4*)((const float*)base + off + bj * HALF + 4);
                        const f32x4 o0 = b0 + gv[bj][0] * acc[ai][bj][m][0], o1 = b1 + gv[bj][1] * acc[ai][bj][m][1];
                        if (BOUT) { u32x4 w; w.x = cvt_pk_bf16(o0[0], o0[1]); w.y = cvt_pk_bf16(o0[2], o0[3]); w.z = cvt_pk_bf16(o1[0], o1[1]); w.w = cvt_pk_bf16(o1[2], o1[3]); *(u32x4*)((bf16_t*)out + off + bj * HALF) = w; }
                        else { *(f32x4*)((float*)out + off + bj * HALF) = o0; *(f32x4*)((float*)out + off + bj * HALF + 4) = o1; } }
                    if (m & 1) asm volatile("" ::: "memory"); }
        }
    }
};
struct EpiQKV {
    static constexpr bool PERM = true, AFTER_DRAIN = false;
    bf16_t* O; const float* gq; const float* gk; float qscale;
    __device__ __forceinline__ void operator()(const f32x4 (&acc)[2][2][4][2], const Unit& u, int wr, int wc, int fr, int fq) const {
        const int seg = u.pn >> 1, head = (u.pn & 1) * 4 + wc;
        const int row0 = u.pm * BM + wr * 64 + fr; const int col0 = u.pn * BM + wc * 64 + 8 * fq;
        const bool nrm = (seg == 3) || (seg == 4);
        const float sc = (seg == 0 || seg == 3) ? qscale : 1.0f;
        f32x4 gv[2][2];
#pragma unroll
        for (int bj = 0; bj < 2; ++bj)
#pragma unroll
            for (int n = 0; n < 2; ++n) { f32x4 g = (f32x4){1.f, 1.f, 1.f, 1.f};
                if (nrm) g = *(const f32x4*)((seg == 3 ? gq : gk) + head * 64 + bj * 32 + 8 * fq + 4 * n);
                gv[bj][n] = g * sc; }
#pragma unroll
        for (int ai = 0; ai < 2; ++ai)
#pragma unroll
            for (int m = 0; m < 4; ++m) {
                float rs = 1.0f;
                if (nrm) { float ss = 0.f;
#pragma unroll
                    for (int bj = 0; bj < 2; ++bj)
#pragma unroll
                        for (int n = 0; n < 2; ++n) { const f32x4 x = acc[ai][bj][m][n]; ss += (x[0] * x[0] + x[1] * x[1]) + (x[2] * x[2] + x[3] * x[3]); }
                    ss += __shfl_xor(ss, 16); ss += __shfl_xor(ss, 32);
                    rs = __builtin_amdgcn_rsqf(ss * (1.0f / 64.0f) + 1e-6f); }
                bf16_t* rowp = O + (size_t)(row0 + ai * HALF + m * 16) * 3072 + col0;
#pragma unroll
                for (int bj = 0; bj < 2; ++bj) { const f32x4 v0 = acc[ai][bj][m][0] * rs * gv[bj][0], v1 = acc[ai][bj][m][1] * rs * gv[bj][1];
                    u32x4 w; w.x = cvt_pk_bf16(v0[0], v0[1]); w.y = cvt_pk_bf16(v0[2], v0[3]); w.z = cvt_pk_bf16(v1[0], v1[1]); w.w = cvt_pk_bf16(v1[2], v1[3]);
                    *(u32x4*)(rowp + bj * 32) = w; }
            }
    }
};
template <class Epi, class Sched, bool ALIGN_EPI = false, bool SP2 = false>
__device__ __forceinline__ void gemm_phase(PG8_LAS unsigned char* lds, const Gemm g, const Sched& S, const Epi& E) {
    int tid_ = threadIdx.x; asm volatile("" : "+v"(tid_)); const int tid = tid_, wid = __builtin_amdgcn_readfirstlane(tid >> 6), lane = tid & 63, wr = wid >> 2, wc = wid & 3, fr = lane & 15, fq = lane >> 4;
    const int K = g.K, nt = K / BK;
    unsigned voffA[2], voffB[2];
#pragma unroll
    for (int i = 0; i < 2; ++i) { int R, C; stage_rc(tid * 16 + i * 8192, R, C); const int Rb = Epi::PERM ? ((R & ~31) + perm32(R & 31)) : R;
        voffA[i] = (unsigned)(R * K + C) * 2u; voffB[i] = (unsigned)(Rb * K + C) * 2u; }
    const size_t kstep = (size_t)(BK * 2);
    const size_t hstep = (size_t)HALF * K * 2;
    const size_t tstep = 2 * hstep;
    const unsigned ldsw = (unsigned)wid * 1024u;
    const int aoff = lds_byte(wr * 64 + fr, fq * 8), boff = lds_byte(wc * 32 + fr, fq * 8);
#define PG8_SA(b, h) (((b) * 2 + (h)) * HTB)
#define PG8_SB(b, h) ((4 + (b) * 2 + (h)) * HTB)
#define PG8_STAGE(bufoff, gbase, voff) do { _Pragma("unroll") for (int _i = 0; _i < 2; ++_i) \
        __builtin_amdgcn_global_load_lds((const unsigned*)((const char*)(gbase) + (voff)[_i]), (PG8_LAS unsigned*)(lds + (bufoff) + ldsw + _i * 8192), 16, 0, 0); } while (0)
#define PG8_LDA(dst, b, h) do { _Pragma("unroll") for (int m = 0; m < 4; ++m) _Pragma("unroll") for (int k = 0; k < 2; ++k) dst[m][k] = *(const PG8_LAS bf16x8*)(lds + PG8_SA(b, h) + aoff + m * 2048 + k * 1024); } while (0)
#define PG8_LDB(dst, b, h) do { _Pragma("unroll") for (int n = 0; n < 2; ++n) _Pragma("unroll") for (int k = 0; k < 2; ++k) dst[n][k] = *(const PG8_LAS bf16x8*)(lds + PG8_SB(b, h) + boff + n * 2048 + k * 1024); } while (0)
#define PG8_MMA(ai, bj, At, Bt) do { __builtin_amdgcn_s_setprio(1); _Pragma("unroll") for (int m = 0; m < 4; ++m) _Pragma("unroll") for (int n = 0; n < 2; ++n) _Pragma("unroll") for (int k = 0; k < 2; ++k) \
        acc[ai][bj][m][n] = __builtin_amdgcn_mfma_f32_16x16x32_bf16(Bt[n][k], At[m][k], acc[ai][bj][m][n], 0, 0, 0); __builtin_amdgcn_s_setprio(0); } while (0)
#define PG8_WAIT_V(n) asm volatile("s_waitcnt vmcnt(" #n ")" ::: "memory")
#define PG8_WAIT_L(n) asm volatile("s_waitcnt lgkmcnt(" #n ")" ::: "memory")
#define PG8_BAR __builtin_amdgcn_s_barrier()
#define PG8_SCHED __builtin_amdgcn_sched_barrier(0)
    Unit cur, nxt; int ui = 0;
    if (!S.next(0, cur)) return;
    f32x4 acc[2][2][4][2];
#pragma unroll
    for (int a = 0; a < 2; ++a)
#pragma unroll
        for (int b = 0; b < 2; ++b)
#pragma unroll
            for (int m = 0; m < 4; ++m)
#pragma unroll
                for (int n = 0; n < 2; ++n) acc[a][b][m][n] = (f32x4){0.f, 0.f, 0.f, 0.f};
    bf16x8 At[4][2], B0[2][2], B1[2][2];
    const char* cA = (const char*)g.A + (size_t)cur.pm * tstep; const char* cB = (const char*)g.Bt + (size_t)cur.pn * tstep;
    S.a_ready(cur);
    if constexpr (SP2) {
        PG8_STAGE(PG8_SB(0, 0), cB, voffB); PG8_STAGE(PG8_SB(0, 1), cB + hstep, voffB); PG8_STAGE(PG8_SA(0, 0), cA, voffA); PG8_STAGE(PG8_SA(0, 1), cA + hstep, voffA);
        if (wr == 1) PG8_BAR;
        PG8_WAIT_V(2); PG8_BAR;
        PG8_STAGE(PG8_SB(1, 0), cB + kstep, voffB); PG8_STAGE(PG8_SA(1, 0), cA + kstep, voffA); PG8_STAGE(PG8_SB(1, 1), cB + hstep + kstep, voffB);
        PG8_WAIT_V(6); PG8_BAR;
    } else {
        PG8_STAGE(PG8_SB(0, 0), cB, voffB); PG8_STAGE(PG8_SA(0, 0), cA, voffA); PG8_STAGE(PG8_SB(0, 1), cB + hstep, voffB); PG8_STAGE(PG8_SA(0, 1), cA + hstep, voffA);
        if (wr == 1) PG8_BAR;
        PG8_WAIT_V(4); PG8_BAR;
        PG8_STAGE(PG8_SB(1, 0), cB + kstep, voffB); PG8_STAGE(PG8_SA(1, 0), cA + kstep, voffA); PG8_STAGE(PG8_SB(1, 1), cB + hstep + kstep, voffB);
        PG8_WAIT_V(6); PG8_BAR;
    }
    for (;;) {
        const bool has_next = S.next(ui + 1, nxt);
        const char* nA = has_next ? (const char*)g.A + (size_t)nxt.pm * tstep : cA; const char* nB = has_next ? (const char*)g.Bt + (size_t)nxt.pn * tstep : cB;
        for (int t = 0; t < nt; t += 2) {
            const bool last = (t == nt - 2);
            const char* a1 = cA + (size_t)(t + 1) * kstep;
            const char* a2 = last ? nA : cA + (size_t)(t + 2) * kstep; const char* b2 = last ? nB : cB + (size_t)(t + 2) * kstep;
            const char* a3 = a2 + kstep; const char* b3 = b2 + kstep;
            if (last && has_next) S.a_ready(nxt);
            if constexpr (SP2) {
            PG8_LDB(B0, 0, 0); PG8_LDB(B1, 0, 1); PG8_SCHED; PG8_LDA(At, 0, 0); PG8_STAGE(PG8_SA(1, 1), a1 + hstep, voffA);
            PG8_WAIT_V(8); PG8_WAIT_L(0); PG8_BAR; PG8_MMA(0, 0, At, B0); PG8_MMA(0, 1, At, B1); PG8_BAR; PG8_SCHED;
            PG8_LDA(At, 0, 1); PG8_STAGE(PG8_SB(0, 0), b2, voffB); PG8_STAGE(PG8_SB(0, 1), b2 + hstep, voffB); PG8_STAGE(PG8_SA(0, 0), a2, voffA);
            PG8_WAIT_V(8); PG8_WAIT_L(0); PG8_BAR; PG8_MMA(1, 0, At, B0); PG8_MMA(1, 1, At, B1); PG8_BAR; PG8_SCHED;
            PG8_LDB(B0, 1, 0); PG8_LDB(B1, 1, 1); PG8_SCHED; PG8_LDA(At, 1, 0); PG8_STAGE(PG8_SA(0, 1), a2 + hstep, voffA);
            PG8_WAIT_V(8); PG8_WAIT_L(0); PG8_BAR; PG8_MMA(0, 0, At, B0); PG8_MMA(0, 1, At, B1); PG8_BAR; PG8_SCHED;
            PG8_LDA(At, 1, 1); PG8_STAGE(PG8_SB(1, 0), b3, voffB); PG8_STAGE(PG8_SB(1, 1), b3 + hstep, voffB); PG8_STAGE(PG8_SA(1, 0), a3, voffA);
            PG8_WAIT_V(8); PG8_WAIT_L(0); PG8_BAR; PG8_MMA(1, 0, At, B0); PG8_MMA(1, 1, At, B1); PG8_BAR; PG8_SCHED;
            } else {
            PG8_LDB(B0, 0, 0); PG8_SCHED; PG8_LDA(At, 0, 0); PG8_STAGE(PG8_SA(1, 1), a1 + hstep, voffA);
            PG8_WAIT_L(8); PG8_BAR; PG8_WAIT_L(0); PG8_MMA(0, 0, At, B0); PG8_BAR; PG8_SCHED;
            PG8_LDB(B1, 0, 1); PG8_STAGE(PG8_SB(0, 0), b2, voffB);
            PG8_BAR; PG8_WAIT_L(0); PG8_MMA(0, 1, At, B1); PG8_BAR;
            PG8_LDA(At, 0, 1); PG8_STAGE(PG8_SA(0, 0), a2, voffA);
            PG8_BAR; PG8_WAIT_L(0); PG8_MMA(1, 0, At, B0); PG8_BAR; PG8_SCHED;
            PG8_STAGE(PG8_SB(0, 1), b2 + hstep, voffB);
            PG8_WAIT_V(6); PG8_BAR; PG8_MMA(1, 1, At, B1); PG8_BAR;
            PG8_LDB(B0, 1, 0); PG8_SCHED; PG8_LDA(At, 1, 0); PG8_STAGE(PG8_SA(0, 1), a2 + hstep, voffA);
            PG8_WAIT_L(8); PG8_BAR; PG8_WAIT_L(0); PG8_MMA(0, 0, At, B0); PG8_BAR; PG8_SCHED;
            PG8_LDB(B1, 1, 1); PG8_STAGE(PG8_SB(1, 0), b3, voffB);
            PG8_BAR; PG8_WAIT_L(0); PG8_MMA(0, 1, At, B1); PG8_BAR;
            PG8_LDA(At, 1, 1); PG8_STAGE(PG8_SA(1, 0), a3, voffA);
            PG8_BAR; PG8_WAIT_L(0); PG8_MMA(1, 0, At, B0); PG8_BAR; PG8_SCHED;
            PG8_STAGE(PG8_SB(1, 1), b3 + hstep, voffB);
            PG8_WAIT_V(6); PG8_BAR; PG8_MMA(1, 1, At, B1); PG8_BAR;
            }
        }
        if constexpr (ALIGN_EPI) { if (wr == 0) PG8_BAR; }
        if constexpr (!Epi::AFTER_DRAIN) { E(acc, cur, wr, wc, fr, fq); S.done(cur); }
        if (!has_next) break;
#pragma unroll
        for (int a = 0; a < 2; ++a)
#pragma unroll
            for (int b = 0; b < 2; ++b)
#pragma unroll
                for (int m = 0; m < 4; ++m)
#pragma unroll
                    for (int n = 0; n < 2; ++n) acc[a][b][m][n] = (f32x4){0.f, 0.f, 0.f, 0.f};
        cur = nxt; cA = nA; cB = nB; ++ui;
        if constexpr (ALIGN_EPI) { if (wr == 1) PG8_BAR; }
    }
    PG8_WAIT_V(0);
    if constexpr (!ALIGN_EPI) { if (wr == 0) PG8_BAR; }
    PG8_BAR;
    if constexpr (Epi::AFTER_DRAIN) { E.fused(acc, cur, wr, wc, fr, fq, lds, wid, lane); S.done(cur); }
#undef PG8_SA
#undef PG8_SB
#undef PG8_STAGE
#undef PG8_LDA
#undef PG8_LDB
#undef PG8_MMA
#undef PG8_WAIT_V
#undef PG8_WAIT_L
#undef PG8_BAR
#undef PG8_SCHED
}
}
namespace att {
#define ALAS __attribute__((address_space(3)))
using bf16 = unsigned short;
using bf16x8 = __attribute__((ext_vector_type(8))) short;
using s16x4 = __attribute__((ext_vector_type(4))) short;
using f32x16 = __attribute__((ext_vector_type(16))) float;
using f32x4 = __attribute__((ext_vector_type(4))) float;
using u32x4 = __attribute__((ext_vector_type(4))) unsigned;
constexpr int SEQ = 4096, PITCH = 3072, OPITCH = 1024, QB = 256, KVBLK = 64;
constexpr int SLOTB = 8192;
constexpr int L_K = 0, L_V = 4 * SLOTB, L_B = 8 * SLOTB, L_WS = L_B + 512, L_FLAG = L_WS + 8 * 256, L_OST = L_FLAG + 64, L_BYTES = L_OST + 8 * 4096;
__device__ __forceinline__ int crow(int r, int hi) { return (r & 3) + 8 * (r >> 2) + 4 * hi; }
__device__ __forceinline__ void glds16(const void* gsrc, unsigned lds_dst) { unsigned keep;
    asm volatile("s_mov_b32 %0, m0\n\ts_mov_b32 m0, %2\n\ts_nop 0\n\tglobal_load_lds_dwordx4 %1, off\n\ts_mov_b32 m0, %0" : "=&s"(keep) : "v"(gsrc), "s"(lds_dst) : "memory"); }
__device__ __forceinline__ void glds4(const void* gsrc, unsigned lds_dst) { unsigned keep;
    asm volatile("s_mov_b32 %0, m0\n\ts_mov_b32 m0, %2\n\ts_nop 0\n\tglobal_load_lds_dword %1, off\n\ts_mov_b32 m0, %0" : "=&s"(keep) : "v"(gsrc), "s"(lds_dst) : "memory"); }
typedef float f32x2_t __attribute__((ext_vector_type(2))); typedef __bf16 bf16x2_t __attribute__((ext_vector_type(2)));
__device__ __forceinline__ unsigned cvtpk_s(float lo, float hi) { f32x2_t v = {lo, hi}; bf16x2_t b = __builtin_convertvector(v, bf16x2_t); return __builtin_bit_cast(unsigned, b); }
#define AWAIT_BAR() asm volatile("s_waitcnt vmcnt(0) lgkmcnt(0)\n\ts_barrier" ::: "memory")
#define ASBAR() __builtin_amdgcn_sched_barrier(0)
struct VFrag { s16x4 lo[8], hi[8]; };
__device__ __forceinline__ void v_issue(VFrag& f, int vb) {
#pragma unroll
    for (int i = 0; i < 8; ++i) {
        asm volatile("ds_read_b64_tr_b16 %0,%1 offset:%c2" : "=&v"(f.lo[i]) : "v"(vb), "i"((i >> 2) * 4096 + (i & 3) * 1024) : "memory");
        asm volatile("ds_read_b64_tr_b16 %0,%1 offset:%c2" : "=&v"(f.hi[i]) : "v"(vb), "i"((i >> 2) * 4096 + (i & 3) * 1024 + 512) : "memory"); }
}
__device__ __forceinline__ void pv_mma(f32x16* o, VFrag& f, bf16x8 pa0, bf16x8 pa1, bf16x8 pa2, bf16x8 pa3) {
    asm volatile("s_waitcnt lgkmcnt(0)" : "+v"(f.lo[0]), "+v"(f.lo[1]), "+v"(f.lo[2]), "+v"(f.lo[3]), "+v"(f.lo[4]), "+v"(f.lo[5]), "+v"(f.lo[6]), "+v"(f.lo[7]),
                                          "+v"(f.hi[0]), "+v"(f.hi[1]), "+v"(f.hi[2]), "+v"(f.hi[3]), "+v"(f.hi[4]), "+v"(f.hi[5]), "+v"(f.hi[6]), "+v"(f.hi[7]) :: "memory");
#define APK2(k) (bf16x8){f.lo[k][0], f.lo[k][1], f.lo[k][2], f.lo[k][3], f.hi[k][0], f.hi[k][1], f.hi[k][2], f.hi[k][3]}
    o[0] = __builtin_amdgcn_mfma_f32_32x32x16_bf16(pa0, APK2(0), o[0], 0, 0, 0); o[1] = __builtin_amdgcn_mfma_f32_32x32x16_bf16(pa0, APK2(4), o[1], 0, 0, 0);
    o[0] = __builtin_amdgcn_mfma_f32_32x32x16_bf16(pa1, APK2(1), o[0], 0, 0, 0); o[1] = __builtin_amdgcn_mfma_f32_32x32x16_bf16(pa1, APK2(5), o[1], 0, 0, 0);
    o[0] = __builtin_amdgcn_mfma_f32_32x32x16_bf16(pa2, APK2(2), o[0], 0, 0, 0); o[1] = __builtin_amdgcn_mfma_f32_32x32x16_bf16(pa2, APK2(6), o[1], 0, 0, 0);
    o[0] = __builtin_amdgcn_mfma_f32_32x32x16_bf16(pa3, APK2(3), o[0], 0, 0, 0); o[1] = __builtin_amdgcn_mfma_f32_32x32x16_bf16(pa3, APK2(7), o[1], 0, 0, 0);
#undef APK2
}
__device__ __forceinline__ void pv(f32x16* o, int vb, bf16x8 pa0, bf16x8 pa1, bf16x8 pa2, bf16x8 pa3) {
#pragma unroll
    for (int d0 = 0; d0 < 2; ++d0) { s16x4 lo[4], hi[4];
#pragma unroll
        for (int ks = 0; ks < 4; ++ks) {
            asm volatile("ds_read_b64_tr_b16 %0,%1 offset:%c2" : "=&v"(lo[ks]) : "v"(vb), "i"(d0 * 4096 + ks * 1024) : "memory");
            asm volatile("ds_read_b64_tr_b16 %0,%1 offset:%c2" : "=&v"(hi[ks]) : "v"(vb), "i"(d0 * 4096 + ks * 1024 + 512) : "memory"); }
        asm volatile("s_waitcnt lgkmcnt(0)" ::: "memory"); ASBAR();
#define APK(k) (bf16x8){lo[k][0], lo[k][1], lo[k][2], lo[k][3], hi[k][0], hi[k][1], hi[k][2], hi[k][3]}
        o[d0] = __builtin_amdgcn_mfma_f32_32x32x16_bf16(pa0, APK(0), o[d0], 0, 0, 0);
        o[d0] = __builtin_amdgcn_mfma_f32_32x32x16_bf16(pa1, APK(1), o[d0], 0, 0, 0);
        o[d0] = __builtin_amdgcn_mfma_f32_32x32x16_bf16(pa2, APK(2), o[d0], 0, 0, 0);
        o[d0] = __builtin_amdgcn_mfma_f32_32x32x16_bf16(pa3, APK(3), o[d0], 0, 0, 0);
#undef APK
    }
}
#ifndef SB_EARLY_EXIT
#define SB_EARLY_EXIT 1
#endif
#ifndef FOX_SKIP
#define FOX_SKIP 1
#endif
template <bool FOX>
__device__ __forceinline__ void attn_unit(int b, int h, int qb, const bf16* __restrict__ QKV, const float* __restrict__ kbias, const float* __restrict__ gq, const float* __restrict__ gk, bf16* O, ALAS unsigned char* lds, unsigned* qc, volatile ALAS unsigned* qslot) {
    int tid_ = threadIdx.x; asm volatile("" : "+v"(tid_)); const int tid = tid_, lane = tid & 63, r32 = lane & 31, hi = lane >> 5; const int wid = __builtin_amdgcn_readfirstlane(tid >> 6);
    const long rowbase = (long)b * SEQ; const int q0 = qb * QB;
    const int colq = (FOX ? 1536 : 0) + h * 64;
    const bf16* Qw = QKV + (rowbase + q0 + wid * 32) * PITCH + colq;
    const bf16* Kh = QKV + rowbase * PITCH + colq + 512; const bf16* Vh = QKV + rowbase * PITCH + colq + 1024;
    const unsigned lds0 = (unsigned)(uintptr_t)lds;
    ALAS float* wsf = (ALAS float*)(lds + L_WS) + wid * 64;
    ALAS unsigned* flags = (ALAS unsigned*)(lds + L_FLAG);
    const int kpos = lane, khi = (kpos >> 2) & 1, kr = (kpos & 3) + 4 * ((kpos & 31) >> 3), kkey = khi * 32 + (kpos >> 5) * 16 + kr;
    const bf16* ksrc = Kh + (long)kkey * PITCH + wid * 8;
    const int key16 = lane >> 2, vhi = (key16 >> 2) & 1, vj = (key16 & 3) + 4 * (key16 >> 3), vkey = vhi * 32 + (wid & 3) * 8 + vj;
    const bf16* vsrc = Vh + (long)vkey * PITCH + (wid >> 2) * 32 + (lane & 3) * 8;
    const float* bsrc = kbias + ((long)(b * 8 + h)) * SEQ + lane;
    const unsigned kdst = lds0 + L_K + wid * 1024, vdst = lds0 + L_V + wid * 1024, bdst = lds0 + L_B;
#define ADMA(t, slot) do { glds16(ksrc + (long)(t) * KVBLK * PITCH, (unsigned)__builtin_amdgcn_readfirstlane(kdst + (slot) * SLOTB)); \
                           glds16(vsrc + (long)(t) * KVBLK * PITCH, (unsigned)__builtin_amdgcn_readfirstlane(vdst + (slot) * SLOTB)); \
                           if (FOX && wid == 0) glds4(bsrc + (t) * KVBLK, (unsigned)__builtin_amdgcn_readfirstlane(bdst + (slot) * 256)); } while (0)
    const int vb0 = (int)(lds0 + L_V) + ((lane >> 4) & 1) * 32 + (lane & 3) * 8 + (4 * hi + ((lane & 15) >> 2)) * 64;
    const int NT = (q0 + QB) / KVBLK;
    if (lane == 0) flags[wid] = 0u;
    float sbound = 0.f;
    if (FOX && FOX_SKIP) { float a = fabsf(gq[h * 64 + lane]), c = fabsf(gk[h * 64 + lane]);
#pragma unroll
        for (int o_ = 1; o_ < 64; o_ <<= 1) { a = fmaxf(a, __shfl_xor(a, o_)); c = fmaxf(c, __shfl_xor(c, o_)); }
        sbound = 64.0f * 0.125f * 1.4426950408889634f * a * c * 1.02f + 0.5f; }
    if (FOX) { ADMA(NT - 1, 0); } else { ADMA(NT - 1, (NT - 1) & 3); ADMA(NT - 2, (NT - 2) & 3); ADMA(NT - 3, (NT - 3) & 3); }
    bf16x8 qr[4];
#pragma unroll
    for (int d0 = 0; d0 < 4; ++d0) qr[d0] = *reinterpret_cast<const bf16x8*>(&Qw[(long)r32 * PITCH + d0 * 16 + hi * 8]);
    f32x16 o[2]; o[0] = f32x16{}; o[1] = f32x16{};
    float m_run = -1e30f, l_run = 0.f, Rp = 1.0f;
    const int qpos = q0 + wid * 32 + r32;
    const int qlast = q0 + wid * 32 + 31;
    for (int it = 0; it < NT; ++it) {
        int t, slot;
        if (FOX) { t = NT - 1 - it; slot = it & 1; } else { t = (wid < 4) ? NT - 3 - it : NT - 1 - it; slot = t & 3; }
        AWAIT_BAR();
        if (FOX ? FOX_SKIP : SB_EARLY_EXIT) {
            const u32x4 f0 = *(ALAS const u32x4*)(flags), f1 = *(ALAS const u32x4*)(flags + 4);
            if ((f0.x & f0.y & f0.z & f0.w & f1.x & f1.y & f1.z & f1.w) != 0u) break;
        }
        if (FOX) { if (it + 1 < NT) ADMA(t - 1, slot ^ 1); }
        else { const int tn = NT - 4 - it; if (tn >= 0) ADMA(tn, tn & 3); if (t < 0) { if (lane == 0) flags[wid] = 1u; continue; } }
        if (KVBLK * t > qlast) continue;
        const bool band = (KVBLK * t + KVBLK - 1 > q0 + wid * 32 - (FOX ? 0 : 1));
        f32x16 p0, p1;
        if (FOX) { const ALAS f32x4* bp = (const ALAS f32x4*)(lds + L_B + slot * 256 + hi * 128);
            const f32x4 c0 = bp[0], c1 = bp[1], c2 = bp[2], c3 = bp[3], c4 = bp[4], c5 = bp[5], c6 = bp[6], c7 = bp[7];
            p0 = (f32x16){c0[0], c0[1], c0[2], c0[3], c1[0], c1[1], c1[2], c1[3], c2[0], c2[1], c2[2], c2[3], c3[0], c3[1], c3[2], c3[3]};
            p1 = (f32x16){c4[0], c4[1], c4[2], c4[3], c5[0], c5[1], c5[2], c5[3], c6[0], c6[1], c6[2], c6[3], c7[0], c7[1], c7[2], c7[3]};
        } else { p0 = f32x16{}; p1 = f32x16{}; }
        VFrag vf; v_issue(vf, vb0 + slot * SLOTB);
        { const ALAS unsigned char* kp = lds + L_K + slot * SLOTB + hi * 1024 + r32 * 16;
#pragma unroll
          for (int d0 = 0; d0 < 4; ++d0) { const bf16x8 b0 = *(const ALAS bf16x8*)(kp + d0 * 2048), b1 = *(const ALAS bf16x8*)(kp + d0 * 2048 + 512);
              p0 = __builtin_amdgcn_mfma_f32_32x32x16_bf16(b0, qr[d0], p0, 0, 0, 0); p1 = __builtin_amdgcn_mfma_f32_32x32x16_bf16(b1, qr[d0], p1, 0, 0, 0); } }
        const int kbase = KVBLK * t + hi * 32;
        if (FOX) {
            if (band) {
#pragma unroll
                for (int r = 0; r < 16; ++r) { if (kbase + r > qpos) p0[r] = -INFINITY; if (kbase + 16 + r > qpos) p1[r] = -INFINITY; } }
            float mx = fmaxf(p0[0], p1[0]);
#pragma unroll
            for (int r = 1; r < 16; ++r) mx = fmaxf(mx, fmaxf(p0[r], p1[r]));
            { auto rr = __builtin_amdgcn_permlane32_swap(__float_as_uint(mx), __float_as_uint(mx), false, false); mx = fmaxf(__uint_as_float(rr[0]), __uint_as_float(rr[1])); }
            const float m_new = fmaxf(m_run, mx);
            if (__any(m_new > m_run)) {
                const float alpha = __builtin_amdgcn_exp2f(m_run - m_new); l_run *= alpha; m_run = m_new;
                if (hi == 0) wsf[r32] = alpha;
                asm volatile("s_waitcnt lgkmcnt(0)" ::: "memory");
#pragma unroll
                for (int g = 0; g < 4; ++g) { const f32x4 a = *(const ALAS f32x4*)(wsf + 8 * g + 4 * hi);
#pragma unroll
                    for (int e = 0; e < 4; ++e) { o[0][4 * g + e] *= a[e]; o[1][4 * g + e] *= a[e]; } }
            }
            float sacc = 0.f;
#pragma unroll
            for (int r = 0; r < 16; ++r) { p0[r] = __builtin_amdgcn_exp2f(p0[r] - m_run); p1[r] = __builtin_amdgcn_exp2f(p1[r] - m_run); sacc += p0[r] + p1[r]; }
            l_run += sacc;
            if (FOX_SKIP) {
                const float b0 = *(const ALAS float*)(lds + L_B + slot * 256);
                const bool dead = __all(sbound + b0 - m_run < -150.0f);
                if (lane == 0) flags[wid] = dead ? 1u : 0u; }
        } else {
#pragma unroll
            for (int r = 0; r < 16; ++r) { p0[r] = __builtin_amdgcn_exp2f(p0[r]); p1[r] = __builtin_amdgcn_exp2f(p1[r]); }
            p0 = p0 + 1.0f; p1 = p1 + 1.0f;
#pragma unroll
            for (int r = 0; r < 16; ++r) { p0[r] = __builtin_amdgcn_rcpf(p0[r]); p1[r] = __builtin_amdgcn_rcpf(p1[r]); }
            if (band) {
#pragma unroll
                for (int r = 0; r < 16; ++r) { if (kbase + r >= qpos) p0[r] = 1.0f; if (kbase + 16 + r >= qpos) p1[r] = 1.0f; } }
            float acc = 1.0f;
#pragma unroll
            for (int e = 31; e >= 0; --e) {
                const float kp_ = e < 16 ? p0[e] : p1[e - 16];
                const float accn = acc * kp_; const float w = acc - accn; acc = accn;
                if (e < 16) p0[e] = w; else p1[e - 16] = w;
            }
            auto rr = __builtin_amdgcn_permlane32_swap(__float_as_uint(acc), __float_as_uint(acc), false, false);
            const float t_lo = __uint_as_float(rr[0]), t_hi = __uint_as_float(rr[1]);
            const float off = hi ? Rp : Rp * t_hi;
            p0 = p0 * off; p1 = p1 * off;
            Rp = Rp * t_lo * t_hi;
            if (SB_EARLY_EXIT) { const bool alldead = __all(Rp == 0.0f); if (lane == 0) flags[wid] = alldead ? 1u : 0u; }
        }
        u32x4 pw0, pw1, pw2, pw3;
        pw0 = (u32x4){cvtpk_s(p0[0], p0[1]), cvtpk_s(p0[2], p0[3]), cvtpk_s(p0[4], p0[5]), cvtpk_s(p0[6], p0[7])};
        pw1 = (u32x4){cvtpk_s(p0[8], p0[9]), cvtpk_s(p0[10], p0[11]), cvtpk_s(p0[12], p0[13]), cvtpk_s(p0[14], p0[15])};
        pw2 = (u32x4){cvtpk_s(p1[0], p1[1]), cvtpk_s(p1[2], p1[3]), cvtpk_s(p1[4], p1[5]), cvtpk_s(p1[6], p1[7])};
        pw3 = (u32x4){cvtpk_s(p1[8], p1[9]), cvtpk_s(p1[10], p1[11]), cvtpk_s(p1[12], p1[13]), cvtpk_s(p1[14], p1[15])};
        pv_mma(o, vf, __builtin_bit_cast(bf16x8, pw0), __builtin_bit_cast(bf16x8, pw1), __builtin_bit_cast(bf16x8, pw2), __builtin_bit_cast(bf16x8, pw3));
    }
    unsigned nxq = 0u; if (tid == 0) nxq = atomicAdd(qc, 1u);
    float rli[16];
    if (FOX) {
        { auto rr = __builtin_amdgcn_permlane32_swap(__float_as_uint(l_run), __float_as_uint(l_run), false, false); l_run = __uint_as_float(rr[0]) + __uint_as_float(rr[1]); }
        if (hi == 0) wsf[32 + r32] = l_run;
        asm volatile("s_waitcnt lgkmcnt(0)" ::: "memory");
#pragma unroll
        for (int r = 0; r < 16; ++r) rli[r] = __builtin_amdgcn_rcpf(wsf[32 + crow(r, hi)]);
    } else {
#pragma unroll
        for (int r = 0; r < 16; ++r) rli[r] = 1.0f;
    }
    bf16* Ow = O + (rowbase + q0 + wid * 32) * OPITCH + ((FOX ? 8 : 0) + h) * 64;
    { ALAS bf16* stg = (ALAS bf16*)(lds + L_OST) + wid * 2048;
#pragma unroll
      for (int r = 0; r < 16; ++r) { const int orow = crow(r, hi);
#pragma unroll
          for (int d0 = 0; d0 < 2; ++d0) stg[orow * 64 + d0 * 32 + r32] = (bf16)(cvtpk_s(o[d0][r] * rli[r], 0.f) & 0xffffu); }
      asm volatile("s_waitcnt lgkmcnt(0)" ::: "memory");
#pragma unroll
      for (int i = 0; i < 4; ++i) { const int row = i * 8 + (lane >> 3), ch = lane & 7; const u32x4 v = *(const ALAS u32x4*)(stg + row * 64 + ch * 8); *(u32x4*)(Ow + (long)row * OPITCH + ch * 8) = v; } }
    if (tid == 0) *qslot = nxq;
    asm volatile("s_waitcnt lgkmcnt(0)\n\ts_barrier" ::: "memory");
#undef ADMA
}
#undef AWAIT_BAR
#undef ASBAR
}
namespace fox {
using bf16 = unsigned short;
using bf16x8 = __attribute__((ext_vector_type(8))) short;
using s16x4 = __attribute__((ext_vector_type(4))) short;
using f32x16 = __attribute__((ext_vector_type(16))) float;
using f32x4 = __attribute__((ext_vector_type(4))) float;
using u32x4 = __attribute__((ext_vector_type(4))) unsigned;
constexpr int SEQ = 4096, DM = 3072, OPITCH = 1024, D = 64, NW = 8, QBLK = 32, QB = 256, KVBLK = 64;
__device__ __forceinline__ int crow(int r,int hi){return (r&3)+8*(r>>2)+4*hi;}
#define SBAR() __builtin_amdgcn_sched_barrier(0)
__device__ __forceinline__ void cmask(f32x16&p0,f32x16&p1,int jb,int qrel,int hi){
  const float NEG=-INFINITY; int kb=64*jb+4*hi;
  #pragma unroll
  for(int r=0;r<16;++r){int kv=kb+(r&3)+8*(r>>2); if(kv>qrel)p0[r]=NEG; if(kv+32>qrel)p1[r]=NEG;}
}

__device__ __forceinline__ void glds16(const void*gsrc,unsigned lds_dst){unsigned keep;
  asm volatile("s_mov_b32 %0, m0\n\ts_mov_b32 m0, %2\n\ts_nop 0\n\tglobal_load_lds_dwordx4 %1, off\n\ts_mov_b32 m0, %0":"=&s"(keep):"v"(gsrc),"s"(lds_dst):"memory");}
__device__ __forceinline__ float max3f(float a,float b,float c){float r;asm("v_max3_f32 %0, %1, %2, %3":"=v"(r):"v"(a),"v"(b),"v"(c));return r;}
__device__ __forceinline__ float max2f(float a,float b){float r;asm("v_max_f32_e32 %0, %1, %2":"=v"(r):"v"(a),"v"(b));return r;}
__device__ __forceinline__ float fadd_s(float a,float b){float r;asm("v_add_f32_e32 %0, %1, %2":"=v"(r):"v"(a),"v"(b));return r;}
__device__ __forceinline__ float fsub_s(float a,float b){float r;asm("v_sub_f32_e32 %0, %1, %2":"=v"(r):"v"(a),"v"(b));return r;}
typedef float f32x2_t __attribute__((ext_vector_type(2))); typedef __bf16 bf16x2_t __attribute__((ext_vector_type(2)));
__device__ __forceinline__ unsigned cvtpk_s(float lo,float hi){f32x2_t v={lo,hi};bf16x2_t b=__builtin_convertvector(v,bf16x2_t);return __builtin_bit_cast(unsigned,b);}
#define WAIT_BAR(N) asm volatile("s_waitcnt vmcnt(" #N ") lgkmcnt(0)\n\ts_barrier":::"memory")
typedef __attribute__((address_space(3))) const char* lds_cptr;
typedef short v4i16_t __attribute__((ext_vector_type(4)));
__device__ __forceinline__ void kload8(bf16x8*kf,lds_cptr kp){
  kf[0]=*(const __attribute__((address_space(3))) bf16x8*)(kp);      kf[1]=*(const __attribute__((address_space(3))) bf16x8*)(kp+512);
  kf[2]=*(const __attribute__((address_space(3))) bf16x8*)(kp+2048); kf[3]=*(const __attribute__((address_space(3))) bf16x8*)(kp+2560);
  kf[4]=*(const __attribute__((address_space(3))) bf16x8*)(kp+4096); kf[5]=*(const __attribute__((address_space(3))) bf16x8*)(kp+4608);
  kf[6]=*(const __attribute__((address_space(3))) bf16x8*)(kp+6144); kf[7]=*(const __attribute__((address_space(3))) bf16x8*)(kp+6656);
}
__device__ __forceinline__ void kload2(bf16x8*kf,lds_cptr kp,int j){ kf[2*j]=*(const __attribute__((address_space(3))) bf16x8*)(kp+j*2048); kf[2*j+1]=*(const __attribute__((address_space(3))) bf16x8*)(kp+j*2048+512); }
__device__ __forceinline__ s16x4 vtr(lds_cptr p){ return __builtin_bit_cast(s16x4,__builtin_amdgcn_ds_read_tr16_b64_v4i16((__attribute__((address_space(3))) v4i16_t*)p)); }
__device__ __forceinline__ float rowmax(const f32x16&p0,const f32x16&p1){
  float a=max3f(p0[0],p0[1],p1[0]),b=max3f(p0[2],p0[3],p1[1]);a=max3f(a,p1[2],p1[3]);
  #pragma unroll
  for(int r=4;r<16;r+=4){a=max3f(a,p0[r],p0[r+1]);b=max3f(b,p0[r+2],p0[r+3]);a=max3f(a,p1[r],p1[r+1]);b=max3f(b,p1[r+2],p1[r+3]);}
  const float m=max2f(a,b);
  auto rr=__builtin_amdgcn_permlane32_swap(__float_as_uint(m),__float_as_uint(m),false,false);
  return max2f(__uint_as_float(rr[0]),__uint_as_float(rr[1]));
}

__device__ __forceinline__ void pvd(f32x16* o, int vb, bf16x8 pa0, bf16x8 pa1, bf16x8 pa2, bf16x8 pa3) {
#pragma unroll
  for (int d0 = 0; d0 < 2; ++d0) { s16x4 lo[4], hi[4];
#pragma unroll
    for (int ks = 0; ks < 4; ++ks) {
      asm volatile("ds_read_b64_tr_b16 %0,%1 offset:%c2" : "=&v"(lo[ks]) : "v"(vb), "i"(d0 * 4096 + ks * 1024) : "memory");
      asm volatile("ds_read_b64_tr_b16 %0,%1 offset:%c2" : "=&v"(hi[ks]) : "v"(vb), "i"(d0 * 4096 + ks * 1024 + 512) : "memory"); }
    asm volatile("s_waitcnt lgkmcnt(0)" ::: "memory"); SBAR();
#define PK(k) (bf16x8){lo[k][0], lo[k][1], lo[k][2], lo[k][3], hi[k][0], hi[k][1], hi[k][2], hi[k][3]}
    o[d0] = __builtin_amdgcn_mfma_f32_32x32x16_bf16(pa0, PK(0), o[d0], 0, 0, 0);
    o[d0] = __builtin_amdgcn_mfma_f32_32x32x16_bf16(pa1, PK(1), o[d0], 0, 0, 0);
    o[d0] = __builtin_amdgcn_mfma_f32_32x32x16_bf16(pa2, PK(2), o[d0], 0, 0, 0);
    o[d0] = __builtin_amdgcn_mfma_f32_32x32x16_bf16(pa3, PK(3), o[d0], 0, 0, 0);
#undef PK
  }
}

constexpr int NSLOT = 3, SLOTB = 8192, KSLOTB = 9216;
constexpr int LDS_K = 0, LDS_V = NSLOT * KSLOTB, LDS_WS = LDS_V + NSLOT * SLOTB, LDS_OST = LDS_WS + NW * 64 * 4, LDS_BYTES = LDS_OST + NW * 4096;
#define KOFF(sl) ((sl) + ((sl) >> 3))
#define WB(n0, n1) do { if (wid == 0) { WAIT_BAR(n0); } else { WAIT_BAR(n1); } } while (0)
typedef __attribute__((address_space(3))) unsigned char* lds_ptr;
template <int THRL> __device__ __forceinline__ void fox_unit(int b, int h, int qb, const bf16* __restrict__ QKV, const float* __restrict__ kbias, const u32x4* __restrict__ kb16,
                                                             float sbound, bf16* O, lds_ptr shm, unsigned* qc, volatile __attribute__((address_space(3))) unsigned* qslot) {
  int tid_ = threadIdx.x; asm volatile("" : "+v"(tid_)); const int tid = tid_, lane = tid & 63, r32 = lane & 31, hi = lane >> 5; const int wid = __builtin_amdgcn_readfirstlane(tid >> 6);
  const long rowbase = (long)b * SEQ; const int q0 = qb * QB; const int colq = 1536 + h * D;
  const bf16* Qw = QKV + (rowbase + q0 + wid * QBLK) * DM + colq;
  const bf16* Kh = QKV + rowbase * DM + colq + 512; const bf16* Vh = QKV + rowbase * DM + colq + 1024;
  const float* kbh = kbias + (long)(b * 8 + h) * SEQ; const u32x4* kb16h = kb16 + (long)(b * 8 + h) * SEQ;
  const unsigned lds0 = (unsigned)(uintptr_t)shm;
  __attribute__((address_space(3))) float* wsf = (__attribute__((address_space(3))) float*)(shm + LDS_WS) + wid * 64;
  const int NT = (q0 + QB) / KVBLK;
  bf16x8 qr[4];
#pragma unroll
  for (int d0 = 0; d0 < 4; ++d0) qr[d0] = *reinterpret_cast<const bf16x8*>(&Qw[(long)r32 * DM + d0 * 16 + hi * 8]);
  const float nb_ref = kbh[q0 + wid * QBLK + r32];
  int T0 = 0;
  {
    const int tc = 2 * ((lane & 31) + 1);
    const bool valid = (lane < 32) && (tc <= NT - 4);
    const float bk = valid ? kbh[64 * tc - 1] : 0.f, bq = kbh[q0];
    const bool dead = valid && (bk < bq - 150.0f - 2.0f * sbound);
    T0 = 2 * __popcll(__ballot(dead)); }
  T0 = __builtin_amdgcn_readfirstlane(T0);
  const bf16* ksrc = Kh + (long)lane * DM + wid * 8;
  const bf16* vsrc = Vh + (long)(16 * (wid & 3) + (lane >> 2)) * DM + (wid >> 2) * 32 + (lane & 3) * 8;
  const u32x4* asrc = kb16h + lane;
  const unsigned kdst = lds0 + LDS_K + wid * 1024, adst = lds0 + LDS_K + 8192, vdst = lds0 + LDS_V + wid * 1024;
#define DMA_K(t, slot) do { glds16(ksrc + (long)(t) * KVBLK * DM, (unsigned)__builtin_amdgcn_readfirstlane(kdst + KOFF(slot))); \
                            if (wid == 0) glds16(asrc + (long)(t) * KVBLK, (unsigned)__builtin_amdgcn_readfirstlane(adst + KOFF(slot))); } while (0)
#define DMA_V(t, slot) glds16(vsrc + (long)(t) * KVBLK * DM, (unsigned)__builtin_amdgcn_readfirstlane(vdst + (slot)))
  const lds_cptr shm3 = (lds_cptr)shm; const lds_cptr kp0 = shm3 + LDS_K + hi * 1024 + r32 * 16; const lds_cptr ka0 = shm3 + LDS_K + 8192 + r32 * 16;
  const lds_cptr vp0 = shm3 + LDS_V + ((lane >> 4) & 1) * 32 + (lane & 3) * 8 + (4 * hi + ((lane & 15) >> 2)) * 64;
  const int vb0 = (int)(lds0 + LDS_V) + ((lane >> 4) & 1) * 32 + (lane & 3) * 8 + (4 * hi + ((lane & 15) >> 2)) * 64;
  bf16x8 kf[8], ka[2];
#define ALOAD(sl) do { ka[0] = *(const __attribute__((address_space(3))) bf16x8*)(ka0 + KOFF(sl)); ka[1] = *(const __attribute__((address_space(3))) bf16x8*)(ka0 + KOFF(sl) + 512); } while (0)
  DMA_K(T0, 0); DMA_V(T0, 0); DMA_K(T0 + 1, SLOTB);
  const short one = hi ? (short)0 : (short)0x3F80;
  bf16x8 qa = (bf16x8){one, one, one, 0, 0, 0, 0, 0}; asm volatile("" : "+v"(qa));
  float l_reg = 0.f; f32x16 o[2]; o[0] = f32x16{}; o[1] = f32x16{};
  const int qrel = wid * QBLK + r32;
  f32x16 negm; { const float nb = -(nb_ref + fmaxf(sbound - 40.0f, 0.0f));
    _Pragma("unroll") for (int r = 0; r < 16; ++r) negm[r] = nb; } asm volatile("" : "+v"(negm));
#define CMASK(P0, P1, t) do { int jb_ = (t) - (NT - 4); if (jb_ >= 0) cmask(P0, P1, jb_, qrel, hi); } while (0)
#define START(P0, P1) do { _Pragma("unroll") for (int r = 0; r < 16; ++r) P0[r] = __builtin_amdgcn_exp2f(P0[r]); } while (0)
#define RESC() do {} while (0)
  f32x16 pA0, pA1, pB0, pB1;
  int sl_prev = 0, sl_cur = 0, sl_next = SLOTB;
#define ROT() do { sl_prev = sl_cur; sl_cur = sl_next; sl_next = (sl_next == (NSLOT - 1) * SLOTB) ? 0 : sl_next + SLOTB; } while (0)
  DMA_K(T0 + 2, 2 * SLOTB);
  WB(5, 3);
  { kload8(kf, kp0); ALOAD(0);
    pA0 = __builtin_amdgcn_mfma_f32_32x32x16_bf16(kf[0], qr[0], negm, 0, 0, 0); pA1 = __builtin_amdgcn_mfma_f32_32x32x16_bf16(kf[1], qr[0], negm, 0, 0, 0);
    pA0 = __builtin_amdgcn_mfma_f32_32x32x16_bf16(kf[2], qr[1], pA0, 0, 0, 0);  pA1 = __builtin_amdgcn_mfma_f32_32x32x16_bf16(kf[3], qr[1], pA1, 0, 0, 0);
    pA0 = __builtin_amdgcn_mfma_f32_32x32x16_bf16(kf[4], qr[2], pA0, 0, 0, 0);  pA1 = __builtin_amdgcn_mfma_f32_32x32x16_bf16(kf[5], qr[2], pA1, 0, 0, 0);
    pA0 = __builtin_amdgcn_mfma_f32_32x32x16_bf16(kf[6], qr[3], pA0, 0, 0, 0);  pA1 = __builtin_amdgcn_mfma_f32_32x32x16_bf16(kf[7], qr[3], pA1, 0, 0, 0);
    pA0 = __builtin_amdgcn_mfma_f32_32x32x16_bf16(ka[0], qa, pA0, 0, 0, 0);     pA1 = __builtin_amdgcn_mfma_f32_32x32x16_bf16(ka[1], qa, pA1, 0, 0, 0); }
  asm volatile("s_nop 15\n\ts_nop 7" : "+v"(pA0), "+v"(pA1)); CMASK(pA0, pA1, T0);
  START(pA0, pA1);
  _Pragma("unroll") for (int r = 0; r < 16; ++r) pA1[r] = __builtin_amdgcn_exp2f(pA1[r]);
  WAIT_BAR(0);
  DMA_K(T0 + 3, 0); DMA_V(T0 + 1, SLOTB);
  ROT();
  kload8(kf, kp0 + KOFF(sl_cur)); ALOAD(sl_cur);
  WB(3, 2);
  s16x4 vlo[8], vhi[8]; u32x4 pw0, pw1, pw2, pw3;
#define PKW(P, B) cvtpk_s(P[B], P[B + 1])
#define PAF(k) __builtin_bit_cast(bf16x8, pw##k)
#define VFR(i) (bf16x8){vlo[i][0], vlo[i][1], vlo[i][2], vlo[i][3], vhi[i][0], vhi[i][1], vhi[i][2], vhi[i][3]}
#define PIN(x) asm volatile("" : "+v"(x))
#define MX3(a, b, c) __builtin_fmaxf(__builtin_fmaxf((a), (b)), (c))
#define GAPA(MF, A0, A1, A2, A3, W0, W1, PW) do { MF; sacc += A0; sacc += A1; sacc += A2; sacc += A3; PIN(sacc); W0; W1; PIN(PW); SBAR(); } while (0)
#define EX(v) __builtin_amdgcn_exp2f(v)
#define GAPB(MF, X, B) do { MF; X[B] = EX(X[B]); X[B + 1] = EX(X[B + 1]); X[B + 2] = EX(X[B + 2]); X[B + 3] = EX(X[B + 3]); PIN(X); SBAR(); } while (0)
#define VRD(i) do { vlo[i] = vtr(vp_ + (((i) >> 2) * 4096 + ((i) & 3) * 1024)); vhi[i] = vtr(vp_ + (((i) >> 2) * 4096 + ((i) & 3) * 1024 + 512)); } while (0)
#define KRD(G, j) do { if (G) { kload2(kf, kp0 + KOFF(sl_next), j); SBAR(); } } while (0)
#define KRDA(G) do { if (G) { ALOAD(sl_next); SBAR(); } } while (0)
#define STEP(C0, C1, P0, P1, t, GK, GV, GL) do { SBAR(); \
    const lds_cptr vp_ = vp0 + sl_prev; \
    VRD(0); SBAR(); float sacc = (P0[0] + P0[1]); \
    GAPA(C0 = __builtin_amdgcn_mfma_f32_32x32x16_bf16(kf[0], qr[0], negm, 0, 0, 0), P0[2], P0[3], P0[4], P0[5],     pw0[0] = PKW(P0, 0), pw0[1] = PKW(P0, 2), pw0); \
    VRD(4); SBAR(); GAPA(C1 = __builtin_amdgcn_mfma_f32_32x32x16_bf16(kf[1], qr[0], negm, 0, 0, 0), P0[6], P0[7], P0[8], P0[9],     pw0[2] = PKW(P0, 4), pw0[3] = PKW(P0, 6), pw0); \
    VRD(1); SBAR(); GAPA(C0 = __builtin_amdgcn_mfma_f32_32x32x16_bf16(kf[2], qr[1], C0, 0, 0, 0),   P0[10], P0[11], P0[12], P0[13], pw1[0] = PKW(P0, 8), pw1[1] = PKW(P0, 10), pw1); \
    VRD(5); SBAR(); GAPA(C1 = __builtin_amdgcn_mfma_f32_32x32x16_bf16(kf[3], qr[1], C1, 0, 0, 0),   P0[14], P0[15], P1[0], P1[1],   pw1[2] = PKW(P0, 12), pw1[3] = PKW(P0, 14), pw1); \
    VRD(2); SBAR(); GAPA(C0 = __builtin_amdgcn_mfma_f32_32x32x16_bf16(kf[4], qr[2], C0, 0, 0, 0),   P1[2], P1[3], P1[4], P1[5],     pw2[0] = PKW(P1, 0), pw2[1] = PKW(P1, 2), pw2); \
    VRD(6); SBAR(); GAPA(C1 = __builtin_amdgcn_mfma_f32_32x32x16_bf16(kf[5], qr[2], C1, 0, 0, 0),   P1[6], P1[7], P1[8], P1[9],     pw2[2] = PKW(P1, 4), pw2[3] = PKW(P1, 6), pw2); \
    VRD(3); SBAR(); GAPA(C0 = __builtin_amdgcn_mfma_f32_32x32x16_bf16(kf[6], qr[3], C0, 0, 0, 0),   P1[10], P1[11], P1[12], P1[13], pw3[0] = PKW(P1, 8), pw3[1] = PKW(P1, 10), pw3); \
    VRD(7); SBAR(); GAPA(C1 = __builtin_amdgcn_mfma_f32_32x32x16_bf16(kf[7], qr[3], C1, 0, 0, 0),   P1[14], P1[15], 0.f, 0.f,       pw3[2] = PKW(P1, 12), pw3[3] = PKW(P1, 14), pw3); \
    C0 = __builtin_amdgcn_mfma_f32_32x32x16_bf16(ka[0], qa, C0, 0, 0, 0); C1 = __builtin_amdgcn_mfma_f32_32x32x16_bf16(ka[1], qa, C1, 0, 0, 0); SBAR(); \
    l_reg += sacc; \
    if (GK) { DMA_K((t) + 3, sl_cur); } if (GV) { DMA_V((t) + 1, sl_next); } \
    CMASK(C0, C1, t); \
    SBAR(); \
    GAPB(o[0] = __builtin_amdgcn_mfma_f32_32x32x16_bf16(PAF(0), VFR(0), o[0], 0, 0, 0), C0, 0); \
    GAPB(o[1] = __builtin_amdgcn_mfma_f32_32x32x16_bf16(PAF(0), VFR(4), o[1], 0, 0, 0), C0, 4); \
    KRD(GL, 0); GAPB(o[0] = __builtin_amdgcn_mfma_f32_32x32x16_bf16(PAF(1), VFR(1), o[0], 0, 0, 0), C0, 8); \
    KRD(GL, 1); GAPB(o[1] = __builtin_amdgcn_mfma_f32_32x32x16_bf16(PAF(1), VFR(5), o[1], 0, 0, 0), C0, 12); \
    KRD(GL, 2); GAPB(o[0] = __builtin_amdgcn_mfma_f32_32x32x16_bf16(PAF(2), VFR(2), o[0], 0, 0, 0), C1, 0); \
    KRD(GL, 3); GAPB(o[1] = __builtin_amdgcn_mfma_f32_32x32x16_bf16(PAF(2), VFR(6), o[1], 0, 0, 0), C1, 4); \
    KRDA(GL); GAPB(o[0] = __builtin_amdgcn_mfma_f32_32x32x16_bf16(PAF(3), VFR(3), o[0], 0, 0, 0), C1, 8); \
    GAPB(o[1] = __builtin_amdgcn_mfma_f32_32x32x16_bf16(PAF(3), VFR(7), o[1], 0, 0, 0), C1, 12); \
    } while (0)
  int t = T0 + 1;
#undef CMASK
#define CMASK(P0, P1, t) do {} while (0)
  for (; t + 5 < NT; t += 2) {
    STEP(pB0, pB1, pA0, pA1, t, true, true, true);     WB(3, 2); RESC(); ROT();
    STEP(pA0, pA1, pB0, pB1, t + 1, true, true, true); WB(3, 2); RESC(); ROT();
  }
#undef CMASK
#define CMASK(P0, P1, t) do { int jb_ = (t) - (NT - 4); if (jb_ >= 0) cmask(P0, P1, jb_, qrel, hi); } while (0)
#define ENDW(tt) do { if ((tt) + 3 < NT) { WB(3, 2); } else if ((tt) + 2 < NT) { WAIT_BAR(1); } else { WAIT_BAR(0); } } while (0)
  for (; t + 1 < NT; t += 2) {
    STEP(pB0, pB1, pA0, pA1, t, (t + 3 < NT), (t + 1 < NT), (t + 1 < NT));         ENDW(t);     RESC(); ROT();
    STEP(pA0, pA1, pB0, pB1, t + 1, (t + 4 < NT), (t + 2 < NT), (t + 2 < NT));     ENDW(t + 1); RESC(); ROT();
  }
  STEP(pB0, pB1, pA0, pA1, NT - 1, false, false, false); RESC();
  { float sacc = pB0[0] + pB0[1]; _Pragma("unroll") for (int r = 2; r < 16; ++r) sacc += pB0[r]; _Pragma("unroll") for (int r = 0; r < 16; ++r) sacc += pB1[r]; l_reg += sacc;
    pw0 = (u32x4){PKW(pB0, 0), PKW(pB0, 2), PKW(pB0, 4), PKW(pB0, 6)}; pw1 = (u32x4){PKW(pB0, 8), PKW(pB0, 10), PKW(pB0, 12), PKW(pB0, 14)};
    pw2 = (u32x4){PKW(pB1, 0), PKW(pB1, 2), PKW(pB1, 4), PKW(pB1, 6)}; pw3 = (u32x4){PKW(pB1, 8), PKW(pB1, 10), PKW(pB1, 12), PKW(pB1, 14)};
    SBAR(); pvd(o, vb0 + sl_cur, PAF(0), PAF(1), PAF(2), PAF(3)); }
  unsigned nxq = 0u; if (tid == 0) nxq = atomicAdd(qc, 1u);
  { auto rr = __builtin_amdgcn_permlane32_swap(__float_as_uint(l_reg), __float_as_uint(l_reg), false, false); l_reg = __uint_as_float(rr[0]) + __uint_as_float(rr[1]); }
  if (hi == 0) wsf[32 + r32] = l_reg; asm volatile("s_waitcnt lgkmcnt(0)" ::: "memory");
  float rli[16];
#pragma unroll
  for (int r = 0; r < 16; ++r) rli[r] = __builtin_amdgcn_rcpf(wsf[32 + crow(r, hi)]);
  bf16* Ow = O + (rowbase + q0 + wid * QBLK) * OPITCH + (8 + h) * D;
  { __attribute__((address_space(3))) bf16* stg = (__attribute__((address_space(3))) bf16*)(shm + LDS_OST) + wid * 2048;
#pragma unroll
    for (int r = 0; r < 16; ++r) { const int orow = crow(r, hi);
#pragma unroll
      for (int d0 = 0; d0 < 2; ++d0) stg[orow * 64 + d0 * 32 + r32] = (bf16)(cvtpk_s(o[d0][r] * rli[r], 0.f) & 0xffffu); }
    asm volatile("s_waitcnt lgkmcnt(0)" ::: "memory");
#pragma unroll
    for (int i = 0; i < 4; ++i) { const int row = i * 8 + (lane >> 3), ch = lane & 7; const u32x4 v = *(const __attribute__((address_space(3))) u32x4*)(stg + row * 64 + ch * 8); *(u32x4*)(Ow + (long)row * OPITCH + ch * 8) = v; } }
  if (tid == 0) *qslot = nxq;
  asm volatile("s_waitcnt lgkmcnt(0)\n\ts_barrier" ::: "memory");
#undef DMA_K
#undef DMA_V
#undef ALOAD
#undef CMASK
#undef START
#undef RESC
#undef ROT
#undef PKW
#undef PAF
#undef VFR
#undef PIN
#undef MX3
#undef GAPA
#undef GAPB
#undef EX
#undef VRD
#undef KRD
#undef KRDA
#undef STEP
#undef ENDW
}
#undef KOFF
#undef SBAR
#undef WAIT_BAR
}
constexpr int NWAVES = 8;
constexpr int BATCH = 8, SEQ = 4096, D = 1024, FF = 2816, M = BATCH * SEQ, NMOD = 9 * D, INW = 3080, NQKV = 3072;
constexpr float EPS = 1e-6f, LOG2E = 1.4426950408889634f;
constexpr size_t MiB = 1u << 20;
constexpr size_t WS_MOD = 0, WS_LF = 1 * MiB, WS_KB = 2 * MiB, WS_CTL = 3 * MiB, WS_W1GU = 4 * MiB, WS_W1D = 16 * MiB, WS_W2GU = 22 * MiB, WS_W2D = 34 * MiB, WS_WIN = 40 * MiB, WS_WO = 46 * MiB, WS_KB16 = 48 * MiB,
                 WS_H = 64 * MiB, WS_ACT = 128 * MiB, WS_X1 = 320 * MiB, WS_END = 384 * MiB;
constexpr int RING_BYTES = 131072, MISC_OFF = RING_BYTES + 320, LDS_BYTES = 147456;
static_assert(att::L_BYTES <= RING_BYTES && fox::LDS_BYTES <= RING_BYTES, "attention LDS");
#define LAS __attribute__((address_space(3)))
typedef unsigned short bf16;
typedef unsigned v4u __attribute__((ext_vector_type(4)));
typedef unsigned v2u __attribute__((ext_vector_type(2)));
typedef float f32x4 __attribute__((ext_vector_type(4)));
__device__ __forceinline__ unsigned f2bf(float f) { unsigned u = __builtin_bit_cast(unsigned, f); return (u + 0x7fffu + ((u >> 16) & 1u)) >> 16; }
__device__ __forceinline__ unsigned pk2(float lo, float hi) { return f2bf(lo) | (f2bf(hi) << 16); }
__device__ __forceinline__ float wave_sum(float v) {
#pragma unroll
    for (int o = 1; o < 64; o <<= 1) v += __shfl_xor(v, o);
    return v;
}
struct Params {
    const float *x, *c, *w_mod, *b_mod, *g_ffn1, *w1_gate, *w1_up, *w1_down, *g_mix, *w_in, *b_f, *g_q, *g_k, *w_o, *g_ffn2, *w2_gate, *w2_up, *w2_down;
    float* out; unsigned char* ws;
};
__device__ __forceinline__ void transpose_item(const float* W, int K, int ldw, bf16* WT, int k0, int n0, int dst_n0, float scale, LAS float* scr, int lane) {
#pragma unroll
    for (int i = 0; i < 32; ++i) { const int kk = 2 * i + (lane >> 5); scr[kk * 33 + (lane & 31)] = W[(size_t)(k0 + kk) * ldw + n0 + (lane & 31)] * scale; }
    asm volatile("s_waitcnt lgkmcnt(0)" ::: "memory");
    const int c = lane & 7;
#pragma unroll
    for (int j = 0; j < 4; ++j) { const int n = (lane >> 3) + 8 * j; const LAS float* s = scr + (8 * c) * 33 + n;
        v4u o; o.x = pk2(s[0 * 33], s[1 * 33]); o.y = pk2(s[2 * 33], s[3 * 33]); o.z = pk2(s[4 * 33], s[5 * 33]); o.w = pk2(s[6 * 33], s[7 * 33]);
        *(v4u*)(WT + (size_t)(dst_n0 + n) * K + k0 + 8 * c) = o; }
    asm volatile("s_waitcnt lgkmcnt(0)" ::: "memory");
}
__device__ __forceinline__ int dst_row_block(int mode, int n0) {
    if (mode == 1) return 256 * (n0 >> 7) + (n0 & 127);
    if (mode == 2) return 256 * (n0 >> 7) + 128 + (n0 & 127);
    if (mode == 3) { const int pn = n0 >> 8, wc = (n0 >> 6) & 3, bj = (n0 >> 5) & 1; return 256 * pn + 128 * bj + 32 * wc; }
    return n0;
}
__device__ __forceinline__ void convert_matrix(const float* W, int K, int ldw, int N, bf16* WT, int mode, int& base, int gw, int NGW, LAS float* scr, int lane) {
    const int nblk = N / 32, items = (K / 64) * nblk;
    const float scale = (mode == 1) ? -1.4426950408889634f : (mode == 2) ? -0.6931471805599453f : 1.0f;
    int first = (gw - base % NGW + NGW) % NGW;
    for (int it = first; it < items; it += NGW) { const int kb = it / nblk, nb = it % nblk; transpose_item(W, K, ldw, WT, 64 * kb, 32 * nb, dst_row_block(mode, 32 * nb), scale, scr, lane); }
    base += items;
}
__device__ __forceinline__ void mod_item(const Params& p, int nb, LAS unsigned char* lds, int tid) {
    LAS float* sc = (LAS float*)lds;
    LAS float* red = (LAS float*)(lds + 32768);
    for (int i = tid; i < 8192; i += 512) { const int k = i >> 3, b = i & 7; const float v = p.c[b * D + k]; sc[i] = v / (1.0f + __expf(-v)); }
    __syncthreads();
    const int kg = tid >> 5, cgp = tid & 31; const int col = nb * 128 + 4 * cgp;
    f32x4 acc[8];
#pragma unroll
    for (int b = 0; b < 8; ++b) acc[b] = (f32x4){0.f, 0.f, 0.f, 0.f};
#pragma unroll 8
    for (int kk = 0; kk < 64; ++kk) { const int k = kg * 64 + kk; const f32x4 w = *(const f32x4*)(p.w_mod + (size_t)k * NMOD + col);
        const f32x4 s0 = *(const LAS f32x4*)(sc + k * 8), s1 = *(const LAS f32x4*)(sc + k * 8 + 4);
        acc[0] += w * s0[0]; acc[1] += w * s0[1]; acc[2] += w * s0[2]; acc[3] += w * s0[3]; acc[4] += w * s1[0]; acc[5] += w * s1[1]; acc[6] += w * s1[2]; acc[7] += w * s1[3]; }
#pragma unroll
    for (int b = 0; b < 8; ++b) *(LAS f32x4*)(red + (kg * 8 + b) * 128 + 4 * cgp) = acc[b];
    __syncthreads();
    for (int o = tid; o < 1024; o += 512) { const int b = o >> 7, cc = o & 127; float s = p.b_mod[nb * 128 + cc];
#pragma unroll
        for (int g = 0; g < 16; ++g) s += red[(g * 8 + b) * 128 + cc];
        ((float*)(p.ws + WS_MOD))[b * NMOD + nb * 128 + cc] = s; }
    __syncthreads();
}
template <bool FOXF, bool XB16>
__device__ __forceinline__ void norm_phase(const Params& p, const void* X, const float* g, int sh_off, int sc_off, bf16* H, LAS unsigned char* lds, int gw, int NGW, int lane, int tid) {
    LAS float* wf = (LAS float*)lds;
    if (FOXF) { for (int i = tid; i < 8192; i += 512) wf[i] = p.w_in[(size_t)(i >> 3) * INW + NQKV + (i & 7)]; __syncthreads(); }
    const float* mod = (const float*)(p.ws + WS_MOD);
    for (int m0 = gw * 16; m0 < M; m0 += NGW * 16) {
    const int b = m0 / SEQ;
    f32x4 a[4], sh[4];
#pragma unroll
    for (int j = 0; j < 4; ++j) { const int col = 4 * lane + 256 * j; const f32x4 gv = *(const f32x4*)(g + col), sv = *(const f32x4*)(mod + (size_t)b * NMOD + sc_off + col);
        a[j] = gv * (sv + 1.0f); sh[j] = *(const f32x4*)(mod + (size_t)b * NMOD + sh_off + col); }
    for (int r4 = 0; r4 < 16; r4 += 4) {
        v2u rb[4][4]; f32x4 rf[4][4];
#pragma unroll
        for (int q = 0; q < 4; ++q)
#pragma unroll
            for (int j = 0; j < 4; ++j) {
                if (XB16) rb[q][j] = *(const v2u*)((const bf16*)X + (size_t)(m0 + r4 + q) * D + 4 * lane + 256 * j);
                else rf[q][j] = *(const f32x4*)((const float*)X + (size_t)(m0 + r4 + q) * D + 4 * lane + 256 * j); }
#pragma unroll
        for (int q = 0; q < 4; ++q) { const int m = m0 + r4 + q;
        f32x4 v[4]; float ss = 0.f;
#pragma unroll
        for (int j = 0; j < 4; ++j) {
            if (XB16) { const v2u w = rb[q][j]; v[j] = (f32x4){__uint_as_float(w.x << 16), __uint_as_float(w.x & 0xffff0000u), __uint_as_float(w.y << 16), __uint_as_float(w.y & 0xffff0000u)}; }
            else v[j] = rf[q][j];
            ss += (v[j].x * v[j].x + v[j].y * v[j].y) + (v[j].z * v[j].z + v[j].w * v[j].w); }
        const float rstd = __builtin_amdgcn_rsqf(wave_sum(ss) * (1.0f / D) + EPS);
#pragma unroll
        for (int j = 0; j < 4; ++j) { v[j] = v[j] * rstd * a[j] + sh[j];
            v2u o; o.x = pk2(v[j].x, v[j].y); o.y = pk2(v[j].z, v[j].w); *(v2u*)(H + (size_t)m * D + 4 * lane + 256 * j) = o; }
        if (FOXF) { float f[8];
#pragma unroll
            for (int qq = 0; qq < 8; ++qq) f[qq] = 0.f;
#pragma unroll
            for (int j = 0; j < 4; ++j)
#pragma unroll
                for (int e_ = 0; e_ < 4; ++e_) { const LAS float* wr = wf + (4 * lane + 256 * j + e_) * 8; const f32x4 w0 = *(const LAS f32x4*)wr, w1 = *(const LAS f32x4*)(wr + 4); const float hv = v[j][e_];
                    f[0] += hv * w0[0]; f[1] += hv * w0[1]; f[2] += hv * w0[2]; f[3] += hv * w0[3]; f[4] += hv * w1[0]; f[5] += hv * w1[1]; f[6] += hv * w1[2]; f[7] += hv * w1[3]; }
#pragma unroll
            for (int i = 0; i < 4; ++i) { const float snd = (lane & 1) ? f[i] : f[i + 4], kp = (lane & 1) ? f[i + 4] : f[i]; f[i] = kp + __shfl_xor(snd, 1); }
#pragma unroll
            for (int i = 0; i < 2; ++i) { const float snd = (lane & 2) ? f[i] : f[i + 2], kp = (lane & 2) ? f[i + 2] : f[i]; f[i] = kp + __shfl_xor(snd, 2); }
            { const float snd = (lane & 4) ? f[0] : f[1], kp = (lane & 4) ? f[1] : f[0]; f[0] = kp + __shfl_xor(snd, 4); }
            f[0] += __shfl_xor(f[0], 8); f[0] += __shfl_xor(f[0], 16); f[0] += __shfl_xor(f[0], 32);
            const int jidx = ((lane >> 2) & 1) + 2 * ((lane >> 1) & 1) + 4 * (lane & 1);
            if (lane < 8) { const float z = f[0] + p.b_f[jidx]; const float ls = fminf(z, 0.f) - log1pf(__expf(-fabsf(z))); ((float*)(p.ws + WS_LF))[(size_t)m * 8 + jidx] = ls; } }
        }
    }
    }
}
__device__ __forceinline__ void cumsum_item(const Params& p, int bh, LAS unsigned char* lds, int tid, int lane, int wave) {
    const float* LF = (const float*)(p.ws + WS_LF); float* KB = (float*)(p.ws + WS_KB);
    LAS float* wt = (LAS float*)lds;
    const int b = bh >> 3, h = bh & 7, s0 = tid * 8;
    float v[8]; float run = 0.f;
#pragma unroll
    for (int i = 0; i < 8; ++i) { run += LF[((size_t)b * SEQ + s0 + i) * 8 + h]; v[i] = run; }
    float inc = run;
    for (int o = 1; o < 64; o <<= 1) { const float t = __shfl_up(inc, o); if (lane >= o) inc += t; }
    if (lane == 63) wt[wave] = inc;
    __syncthreads();
    float pre = inc - run;
    for (int w = 0; w < wave; ++w) pre += wt[w];
    v4u* KB16 = (v4u*)(p.ws + WS_KB16);
#pragma unroll
    for (int i = 0; i < 8; ++i) { const float bv = -(pre + v[i]) * LOG2E; KB[(size_t)bh * SEQ + s0 + i] = bv;
        const unsigned h_ = f2bf(bv); const float r1 = bv - __uint_as_float(h_ << 16); const unsigned m_ = f2bf(r1); const float r2 = r1 - __uint_as_float(m_ << 16); const unsigned l_ = f2bf(r2);
        KB16[(size_t)bh * SEQ + s0 + i] = (v4u){h_ | (m_ << 16), l_, 0u, 0u}; }
    __syncthreads();
}

typedef __attribute__((address_space(1))) unsigned gu32;
#define XB_TMO      128
#define XB_XCNT(j)  (256  + 64 * (j))
#define XB_XSUB(j)  (1280 + 64 * (j))
#define XB_XGEN(j)  (2304 + 64 * (j))
#define XB_TOP      3328
#define XB_TOPGEN   3392
#define XCD_BAR_WORDS 3456
#define XB_SPIN_CAP (1u << 18)

__device__ __forceinline__ unsigned xb_ld(unsigned* p)              { return __hip_atomic_load(p, __ATOMIC_RELAXED, __HIP_MEMORY_SCOPE_AGENT); }
__device__ __forceinline__ unsigned xb_add(unsigned* p, unsigned v) { return __hip_atomic_fetch_add(p, v, __ATOMIC_RELAXED, __HIP_MEMORY_SCOPE_AGENT); }
__device__ __forceinline__ unsigned xb_xcc_id() { return (unsigned)__builtin_amdgcn_s_getreg((3 << 11) | 20) & 0xFu; }
#define XB_SPIN(cond, bar) do { unsigned _sp = 0; while (cond) { __builtin_amdgcn_s_sleep(1); \
    if ((++_sp & 255u) == 0u) { if (xb_ld(&(bar)[XB_TMO])) break; if (_sp > XB_SPIN_CAP) { atomicAdd(&(bar)[XB_TMO], 1u); break; } } } } while (0)

struct XcdBarrier {
    unsigned* bar; unsigned x;
    volatile LAS unsigned* st;
};

__device__ __forceinline__ XcdBarrier xcd_barrier_post(unsigned* bar, volatile LAS unsigned* st) {
    XcdBarrier b; b.bar = bar; b.x = xb_xcc_id(); b.st = st;
    if (threadIdx.x == 0) (void)xb_add(&bar[XB_XCNT(b.x)], 1u);
    return b;
}
__device__ __forceinline__ void xcd_barrier_complete(unsigned* bar, unsigned x, unsigned& nloc, unsigned& nx) {
    const unsigned G = gridDim.x * gridDim.y * gridDim.z;
    unsigned sum, cnt, mine, sp = 0u;
    for (;;) {
        sum = 0u; cnt = 0u; mine = 0u;
#pragma unroll
        for (unsigned j = 0; j < 16; ++j) { const unsigned c = xb_ld(&bar[XB_XCNT(j)]); sum += c; cnt += (c > 0u) ? 1u : 0u; mine = (j == x) ? c : mine; }
        if (sum == G) break;
        __builtin_amdgcn_s_sleep(1);
        if ((++sp & 255u) == 0u) { if (xb_ld(&bar[XB_TMO])) break; if (sp > XB_SPIN_CAP) { atomicAdd(&bar[XB_TMO], 1u); break; } }
    }
    nloc = mine > 0u ? mine : 1u; nx = cnt > 0u ? cnt : 1u;
}

__device__ __forceinline__ void xcd_barrier(const XcdBarrier& b) {
    asm volatile("s_waitcnt vmcnt(0)" ::: "memory");
    __syncthreads();
    if (threadIdx.x == 0) {
        unsigned* bar = b.bar;
        __builtin_amdgcn_s_waitcnt(0);
        unsigned nloc = b.st[0], nx = b.st[1];
        if (nloc == 0u) { xcd_barrier_complete(bar, b.x, nloc, nx); b.st[0] = nloc; b.st[1] = nx; }
        const unsigned old = xb_add(&bar[XB_XSUB(b.x)], 1u);
        const unsigned gen = old / nloc;
        if (old + 1u == (gen + 1u) * nloc) {
            __builtin_amdgcn_fence(__ATOMIC_RELEASE, "agent");
            asm volatile("s_waitcnt vmcnt(0)" ::: "memory");
            const unsigned og = xb_add(&bar[XB_TOP], 1u);
            const unsigned tg = og / nx;
            if (og + 1u == (tg + 1u) * nx) xb_add(&bar[XB_TOPGEN], 1u);
            else XB_SPIN(xb_ld(&bar[XB_TOPGEN]) == tg, bar);
            __builtin_amdgcn_fence(__ATOMIC_ACQUIRE, "agent");
            xb_add(&bar[XB_XGEN(b.x)], 1u);
            asm volatile("s_waitcnt vmcnt(0)" ::: "memory");
        } else {
            XB_SPIN(xb_ld(&bar[XB_XGEN(b.x)]) == gen, bar);
            __builtin_amdgcn_fence(__ATOMIC_ACQUIRE, "agent");
            asm volatile("s_waitcnt vmcnt(0)" ::: "memory");
        }
    }
    __syncthreads();
}

#ifndef GU_ALIGN
#define GU_ALIGN true
#endif
#ifndef RESID_ALIGN
#define RESID_ALIGN true
#endif
#ifndef FOX_PIPE
#define FOX_PIPE 1
#endif
#ifndef DUP_MISC
#define DUP_MISC 0
#endif
#ifndef DUP_ATT_FOX
#define DUP_ATT_FOX 0
#endif
#ifndef DUP_ATT_SB
#define DUP_ATT_SB 1
#endif
#ifndef DUP_GU
#define DUP_GU 0
#endif
#ifndef DUP_D1
#define DUP_D1 0
#endif
#ifndef DUP_SYNC
#define DUP_SYNC 0
#endif
typedef const __attribute__((address_space(4))) Params* KArgPtr;
#define GPTR(T, v) ((T*)(__attribute__((address_space(1))) T*)(v))
__device__ __forceinline__ Params load_args() {
#if defined(__HIP_DEVICE_COMPILE__)
    const __attribute__((address_space(4))) unsigned long long* k = (const __attribute__((address_space(4))) unsigned long long*)__builtin_amdgcn_kernarg_segment_ptr(); asm volatile("" : "+s"(k));
    Params r;
    r.x = GPTR(const float, k[0]); r.c = GPTR(const float, k[1]); r.w_mod = GPTR(const float, k[2]); r.b_mod = GPTR(const float, k[3]); r.g_ffn1 = GPTR(const float, k[4]);
    r.w1_gate = GPTR(const float, k[5]); r.w1_up = GPTR(const float, k[6]); r.w1_down = GPTR(const float, k[7]); r.g_mix = GPTR(const float, k[8]); r.w_in = GPTR(const float, k[9]);
    r.b_f = GPTR(const float, k[10]); r.g_q = GPTR(const float, k[11]); r.g_k = GPTR(const float, k[12]); r.w_o = GPTR(const float, k[13]); r.g_ffn2 = GPTR(const float, k[14]);
    r.w2_gate = GPTR(const float, k[15]); r.w2_up = GPTR(const float, k[16]); r.w2_down = GPTR(const float, k[17]); r.out = GPTR(float, k[18]); r.ws = GPTR(unsigned char, k[19]);
    return r;
#else
    return Params{};
#endif
}
#define PHASE_ARGS() const Params p = load_args(); unsigned char* const ws = p.ws; (void)ws
__global__ void __launch_bounds__(NWAVES * 64, 2) hymba_fwd(Params p_unused) {
    extern __shared__ __attribute__((aligned(16))) unsigned char lds_raw[];
    LAS unsigned char* lds = (LAS unsigned char*)lds_raw;
    const int wave = __builtin_amdgcn_readfirstlane((int)threadIdx.x >> 6);
    const int G = gridDim.x, bx = blockIdx.x;
#define FRESH_TID() int tid = threadIdx.x; asm volatile("" : "+v"(tid)); const int lane = tid & 63
    const int vcu = (G % 8 == 0) ? (bx % 8) * (G / 8) + bx / 8 : bx;
    const int gw = vcu * NWAVES + wave, NGW = G * NWAVES;
    volatile LAS unsigned* MISC = (volatile LAS unsigned*)(lds + MISC_OFF);
    if (threadIdx.x < 32) MISC[threadIdx.x] = 0u;
    __syncthreads();
    XcdBarrier xbar;
    { PHASE_ARGS();
      xbar = xcd_barrier_post((unsigned*)(ws + WS_CTL), MISC + 8);
      if (ws == nullptr) cg::this_grid().sync(); }

    { PHASE_ARGS(); FRESH_TID(); for (int nb = bx; nb < NMOD / 128; nb += G) mod_item(p, nb, lds, tid);
      bf16 *W1GU = (bf16*)(ws + WS_W1GU), *W1D = (bf16*)(ws + WS_W1D), *W2GU = (bf16*)(ws + WS_W2GU), *W2D = (bf16*)(ws + WS_W2D), *WIN = (bf16*)(ws + WS_WIN), *WO = (bf16*)(ws + WS_WO);
      LAS float* scr = (LAS float*)(lds + wave * 16384); int base = 0;
      convert_matrix(p.w1_gate, D, FF, FF, W1GU, 1, base, gw, NGW, scr, lane);
      convert_matrix(p.w1_up, D, FF, FF, W1GU, 2, base, gw, NGW, scr, lane);
      convert_matrix(p.w1_down, FF, D, D, W1D, 0, base, gw, NGW, scr, lane);
      convert_matrix(p.w_in, D, INW, NQKV, WIN, 3, base, gw, NGW, scr, lane);
      convert_matrix(p.w_o, D, D, D, WO, 0, base, gw, NGW, scr, lane);
      convert_matrix(p.w2_gate, D, FF, FF, W2GU, 1, base, gw, NGW, scr, lane);
      convert_matrix(p.w2_up, D, FF, FF, W2GU, 2, base, gw, NGW, scr, lane);
      convert_matrix(p.w2_down, FF, D, D, W2D, 0, base, gw, NGW, scr, lane); }
    xcd_barrier(xbar);
    { PHASE_ARGS(); FRESH_TID(); norm_phase<false, false>(p, p.x, p.g_ffn1, 0 * D, 1 * D, (bf16*)(ws + WS_H), lds, gw, NGW, lane, tid); }
    xcd_barrier(xbar);
    { PHASE_ARGS(); pg8::Gemm g{(bf16*)(ws + WS_H), (bf16*)(ws + WS_W1GU), M, 2 * FF, D}; pg8::StaticOrder S; S.init(M, 2 * FF, G, bx); pg8::EpiSwiGLU E{(bf16*)(ws + WS_ACT), FF};
      pg8::gemm_phase<pg8::EpiSwiGLU, pg8::StaticOrder, true, true>(lds, g, S, E); }
    xcd_barrier(xbar);
    { PHASE_ARGS(); pg8::Gemm g{(bf16*)(ws + WS_ACT), (bf16*)(ws + WS_W1D), M, D, FF}; pg8::StaticOrder S; S.init(M, D, G, bx);
      pg8::EpiResid<false, true> E{p.x, ws + WS_X1, (const float*)(ws + WS_MOD) + 2 * D, 0.5f};
      pg8::gemm_phase<pg8::EpiResid<false, true>, pg8::StaticOrder, true, true>(lds, g, S, E); }
    xcd_barrier(xbar);
    { PHASE_ARGS(); FRESH_TID(); norm_phase<true, true>(p, ws + WS_X1, p.g_mix, 3 * D, 4 * D, (bf16*)(ws + WS_H), lds, gw, NGW, lane, tid); }
    xcd_barrier(xbar);
    { PHASE_ARGS(); if (bx < 64) { FRESH_TID(); cumsum_item(p, bx, lds, tid, lane, wave); }
      pg8::Gemm g{(bf16*)(ws + WS_H), (bf16*)(ws + WS_WIN), M, NQKV, D}; pg8::StaticOrder S; S.init(M, NQKV, G, bx); pg8::EpiQKV E{(bf16*)(ws + WS_ACT), p.g_q, p.g_k, 0.125f * LOG2E};
      pg8::gemm_phase<pg8::EpiQKV, pg8::StaticOrder, true, true>(lds, g, S, E); }
    xcd_barrier(xbar);
    { PHASE_ARGS(); const float* KB = (const float*)(ws + WS_KB); unsigned* qctr = (unsigned*)(ws + WS_CTL + 65536); bf16* const ACT = (bf16*)(ws + WS_ACT); bf16* const H = (bf16*)(ws + WS_H);
      { FRESH_TID(); float a = fabsf(p.g_q[wave * 64 + lane]), c = fabsf(p.g_k[wave * 64 + lane]);
#pragma unroll
        for (int o_ = 1; o_ < 64; o_ <<= 1) { a = fmaxf(a, __shfl_xor(a, o_)); c = fmaxf(c, __shfl_xor(c, o_)); }
        if (lane == 0) MISC[24 + wave] = __float_as_uint(64.0f * 0.125f * LOG2E * a * c * 1.02f + 0.5f); }
      const unsigned home = xbar.x & 7u;
      for (unsigned kq = 0; kq < 8u; ++kq) {
          const unsigned qi = (home + kq) & 7u; unsigned* qc = qctr + 64 * qi;
          if (threadIdx.x == 0) MISC[16] = atomicAdd(qc, 1u);
          __syncthreads();
          for (;;) {
              const unsigned u = MISC[16];
              if (u >= 256u) break;
              const int kind = (u < 128u) ? 1 : 0, v = u & 127, qb = 15 - (v >> 3), b = (int)qi, h = v & 7;
              const float sbound = __uint_as_float(MISC[24 + h]);
              if (kind) fox::fox_unit<8>(b, h, qb, ACT, KB, (const fox::u32x4*)(ws + WS_KB16), sbound, H, lds, qc, MISC + 16);
              else att::attn_unit<false>(b, h, qb, ACT, KB, nullptr, nullptr, H, lds, qc, MISC + 16);
          }
          __syncthreads();
      } }
    xcd_barrier(xbar);
    { PHASE_ARGS(); pg8::Gemm g{(bf16*)(ws + WS_H), (bf16*)(ws + WS_WO), M, D, D}; pg8::StaticOrder S; S.init(M, D, G, bx);
      pg8::EpiResid<true, true> E{ws + WS_X1, ws + WS_X1, (const float*)(ws + WS_MOD) + 5 * D, 1.0f};
      pg8::gemm_phase<pg8::EpiResid<true, true>, pg8::StaticOrder, true, true>(lds, g, S, E); }
    xcd_barrier(xbar);
    { PHASE_ARGS(); FRESH_TID(); norm_phase<false, true>(p, ws + WS_X1, p.g_ffn2, 6 * D, 7 * D, (bf16*)(ws + WS_H), lds, gw, NGW, lane, tid); }
    xcd_barrier(xbar);
    { PHASE_ARGS(); pg8::Gemm g{(bf16*)(ws + WS_H), (bf16*)(ws + WS_W2GU), M, 2 * FF, D}; pg8::StaticOrder S; S.init(M, 2 * FF, G, bx); pg8::EpiSwiGLU E{(bf16*)(ws + WS_ACT), FF};
      pg8::gemm_phase<pg8::EpiSwiGLU, pg8::StaticOrder, true, true>(lds, g, S, E); }
    xcd_barrier(xbar);
    { PHASE_ARGS(); pg8::Gemm g{(bf16*)(ws + WS_ACT), (bf16*)(ws + WS_W2D), M, D, FF}; pg8::StaticOrder S; S.init(M, D, G, bx);
      pg8::EpiResid<true, false> E{ws + WS_X1, p.out, (const float*)(ws + WS_MOD) + 8 * D, 0.5f};
      pg8::gemm_phase<pg8::EpiResid<true, false>, pg8::StaticOrder, true, true>(lds, g, S, E); }
}

extern "C" void kernel_launch(void* const* d_in, const int* in_sizes, int n_in, void* d_out, int out_size, void* d_ws, size_t ws_size, hipStream_t stream) {
    static int grid = 0;
    if (grid == 0) {
        if (n_in != 18 || in_sizes[0] != M * D || out_size != M * D || ws_size < WS_END) { fprintf(stderr, "kernel_launch: unexpected shapes (n_in %d, in0 %d, out %d, ws %zu)\n", n_in, n_in > 0 ? in_sizes[0] : -1, out_size, ws_size); grid = -1; return; }
        int dev = 0, cus = 0, per_cu = 0;
        (void)hipGetDevice(&dev); (void)hipDeviceGetAttribute(&cus, hipDeviceAttributeMultiprocessorCount, dev);
        if (hipFuncSetAttribute((const void*)hymba_fwd, hipFuncAttributeMaxDynamicSharedMemorySize, LDS_BYTES) != hipSuccess) { fprintf(stderr, "kernel_launch: hipFuncSetAttribute failed\n"); grid = -1; return; }
        if (hipOccupancyMaxActiveBlocksPerMultiprocessor(&per_cu, (const void*)hymba_fwd, NWAVES * 64, LDS_BYTES) != hipSuccess || per_cu < 1) { fprintf(stderr, "kernel_launch: occupancy query says %d\n", per_cu); per_cu = 1; }
        (void)hipGetLastError();
        grid = cus * per_cu;
    }
    if (grid < 0) return;
    if (hipMemsetAsync((char*)d_ws + WS_CTL, 0, 131072, stream) != hipSuccess) { fprintf(stderr, "kernel_launch: memset of control words failed\n"); return; }
    Params p{};
    const float** pp = (const float**)&p;
    for (int i = 0; i < 18; ++i) pp[i] = (const float*)d_in[i];
    p.out = (float*)d_out; p.ws = (unsigned char*)d_ws;
    void* args[] = {&p};
    hipError_t e = hipLaunchCooperativeKernel((const void*)hymba_fwd, dim3(grid), dim3(NWAVES * 64), args, LDS_BYTES, stream);
    if (e != hipSuccess) fprintf(stderr, "cooperative launch failed: %s (grid %d)\n", hipGetErrorString(e), grid);
}
```
